# Optimizing an MI355X kernel written in HIP

```python
import math
import jax, jax.numpy as jnp
from jax import lax
import numpy as np

D_MODEL = 1024
BATCH = 2
SEQ = 8192
DEPTH = 1

N_META = 16
BLOCK = 128
D_FF = 2816
EPS = 1e-6
NEG_INF = -1e30
MLA_HEADS = 8
MLA_Q_RANK = 256
MLA_KV_RANK = 128
MLA_NOPE_DIM = 64
MLA_ROPE_DIM = 32
MLA_QK_DIM = MLA_NOPE_DIM + MLA_ROPE_DIM
MLA_V_DIM = 64
ROPE_THETA = 10000.0
FOX_HEADS = 8
FOX_HEAD_DIM = 64
D_MIX = MLA_HEADS * MLA_V_DIM + FOX_HEADS * FOX_HEAD_DIM
IN_SPLITS = (MLA_Q_RANK, MLA_KV_RANK, MLA_ROPE_DIM, 3 * FOX_HEADS * FOX_HEAD_DIM, FOX_HEADS)
D_IN = sum(IN_SPLITS)

kernel_name = "hymba_mla_fox_macaron"


def rms_norm(x, g):
    xf = x.astype(jnp.float32)
    y = xf * lax.rsqrt(jnp.mean(xf * xf, axis=-1, keepdims=True) + EPS)
    return (y * g.astype(jnp.float32)).astype(x.dtype)


def swiglu(x, w_gate, w_up, w_down):
    return (jax.nn.silu(x @ w_gate) * (x @ w_up)) @ w_down


def rope(x, pos):
    half = x.shape[-1] // 2
    inv_freq = 1.0 / (ROPE_THETA ** (jnp.arange(half, dtype=jnp.float32) / half))
    ang = pos.astype(jnp.float32)[:, None] * inv_freq[None, :]
    cos = jnp.cos(ang)[None, :, None, :].astype(x.dtype)
    sin = jnp.sin(ang)[None, :, None, :].astype(x.dtype)
    x1, x2 = x[..., :half], x[..., half:]
    return jnp.concatenate([x1 * cos - x2 * sin, x2 * cos + x1 * sin], axis=-1)


def block_causal_attention(q, k, v, scale, key_valid, cum=None):
    L = q.shape[1]
    outs = []
    for i in range(L // BLOCK):
        q0, q1 = i * BLOCK, (i + 1) * BLOCK
        s = jnp.einsum('bqhd,bkhd->bhqk', q[:, q0:q1], k[:, :q1],
                       preferred_element_type=jnp.float32) * scale
        if cum is not None:
            cq = jnp.transpose(cum[:, q0:q1], (0, 2, 1))[:, :, :, None]
            ck = jnp.transpose(cum[:, :q1], (0, 2, 1))[:, :, None, :]
            s = s + (cq - ck)
        q_pos = q0 + jnp.arange(BLOCK)
        k_pos = jnp.arange(q1)
        mask = (k_pos[None, :] <= q_pos[:, None]) & key_valid[None, :q1]
        s = jnp.where(mask[None, None], s, NEG_INF)
        p = jax.nn.softmax(s, axis=-1).astype(v.dtype)
        outs.append(jnp.einsum('bhqk,bkhd->bqhd', p, v[:, :q1]))
    return jnp.concatenate(outs, axis=1)


def hybrid_mixer(u, pos, key_valid, w_in, g_cq, w_uq, g_ckv, w_ukv, g_q_mla, g_k_mla,
                 b_forget, g_q_fox, g_k_fox, w_out):
    B, L, _ = u.shape
    proj = u @ w_in
    offs = [int(o) for o in np.cumsum(IN_SPLITS)[:-1]]
    c_q, c_kv, k_pe, fox_qkv, f_logit = jnp.split(proj, offs, axis=-1)

    q = (rms_norm(c_q, g_cq) @ w_uq).reshape(B, L, MLA_HEADS, MLA_QK_DIM)
    q = rms_norm(q, g_q_mla)
    q = jnp.concatenate([q[..., :MLA_NOPE_DIM], rope(q[..., MLA_NOPE_DIM:], pos)], axis=-1)
    kv = (rms_norm(c_kv, g_ckv) @ w_ukv).reshape(B, L, MLA_HEADS, MLA_NOPE_DIM + MLA_V_DIM)
    k_nope, v = kv[..., :MLA_NOPE_DIM], kv[..., MLA_NOPE_DIM:]
    k_pe_b = jnp.broadcast_to(k_pe[:, :, None, :], (B, L, MLA_HEADS, MLA_ROPE_DIM))
    k = rms_norm(jnp.concatenate([k_nope, k_pe_b], axis=-1), g_k_mla)
    k = jnp.concatenate([k[..., :MLA_NOPE_DIM], rope(k[..., MLA_NOPE_DIM:], pos)], axis=-1)
    o_mla = block_causal_attention(q, k, v, 1.0 / math.sqrt(MLA_QK_DIM), key_valid)

    fq, fk, fv = jnp.split(fox_qkv.reshape(B, L, 3, FOX_HEADS, FOX_HEAD_DIM), 3, axis=2)
    fq = rms_norm(fq[:, :, 0], g_q_fox)
    fk = rms_norm(fk[:, :, 0], g_k_fox)
    fv = fv[:, :, 0]
    log_f = jax.nn.log_sigmoid(f_logit.astype(jnp.float32) + b_forget.astype(jnp.float32))
    cum = jnp.cumsum(log_f, axis=1)
    o_fox = block_causal_attention(fq, fk, fv, 1.0 / math.sqrt(FOX_HEAD_DIM), key_valid, cum)

    o = jnp.concatenate([o_mla.reshape(B, L, MLA_HEADS * MLA_V_DIM),
                         o_fox.reshape(B, L, FOX_HEADS * FOX_HEAD_DIM)], axis=-1)
    return o @ w_out


def setup_inputs(seed: int = 0) -> dict:
    key = jax.random.key(seed)
    ks = jax.random.split(key, 24)
    f32 = jnp.float32

    def nrm(k, shape, fan_in):
        return jax.random.normal(k, shape, f32) * (fan_in ** -0.5)

    def gain(k, n):
        return 1.0 + 0.02 * jax.random.normal(k, (DEPTH, n), f32)

    return {
        "x": jax.random.normal(ks[0], (BATCH, SEQ, D_MODEL), f32),
        "meta_tokens": jax.random.normal(ks[1], (N_META, D_MODEL), f32),
        "g_ffn1": gain(ks[2], D_MODEL),
        "w1_gate": nrm(ks[3], (DEPTH, D_MODEL, D_FF), D_MODEL),
        "w1_up": nrm(ks[4], (DEPTH, D_MODEL, D_FF), D_MODEL),
        "w1_down": nrm(ks[5], (DEPTH, D_FF, D_MODEL), D_FF),
        "g_mix": gain(ks[6], D_MODEL),
        "w_in": nrm(ks[7], (DEPTH, D_MODEL, D_IN), D_MODEL),
        "g_cq": gain(ks[8], MLA_Q_RANK),
        "w_uq": nrm(ks[9], (DEPTH, MLA_Q_RANK, MLA_HEADS * MLA_QK_DIM), MLA_Q_RANK),
        "g_ckv": gain(ks[10], MLA_KV_RANK),
        "w_ukv": nrm(ks[11], (DEPTH, MLA_KV_RANK, MLA_HEADS * (MLA_NOPE_DIM + MLA_V_DIM)), MLA_KV_RANK),
        "g_q_mla": gain(ks[12], MLA_QK_DIM),
        "g_k_mla": gain(ks[13], MLA_QK_DIM),
        "b_forget": jax.random.uniform(ks[14], (DEPTH, FOX_HEADS), f32, 1.0, 4.0),
        "g_q_fox": gain(ks[15], FOX_HEAD_DIM),
        "g_k_fox": gain(ks[16], FOX_HEAD_DIM),
        "w_out": nrm(ks[17], (DEPTH, D_MIX, D_MODEL), D_MIX),
        "g_ffn2": gain(ks[18], D_MODEL),
        "w2_gate": nrm(ks[19], (DEPTH, D_MODEL, D_FF), D_MODEL),
        "w2_up": nrm(ks[20], (DEPTH, D_MODEL, D_FF), D_MODEL),
        "w2_down": nrm(ks[21], (DEPTH, D_FF, D_MODEL), D_FF),
    }


def reference(x, meta_tokens, g_ffn1, w1_gate, w1_up, w1_down, g_mix, w_in, g_cq, w_uq,
              g_ckv, w_ukv, g_q_mla, g_k_mla, b_forget, g_q_fox, g_k_fox, w_out,
              g_ffn2, w2_gate, w2_up, w2_down):
    B = x.shape[0]
    pad = BLOCK - N_META
    meta = jnp.broadcast_to(meta_tokens.astype(x.dtype)[None], (B, N_META, D_MODEL))
    h = jnp.concatenate([jnp.zeros((B, pad, D_MODEL), x.dtype), meta, x], axis=1)
    L = h.shape[1]
    idx = jnp.arange(L)
    key_valid = idx >= pad
    pos = jnp.maximum(idx - pad, 0).astype(jnp.int32)
    for l in range(DEPTH):
        h = h + 0.5 * swiglu(rms_norm(h, g_ffn1[l]), w1_gate[l], w1_up[l], w1_down[l])
        h = h + hybrid_mixer(rms_norm(h, g_mix[l]), pos, key_valid, w_in[l], g_cq[l], w_uq[l],
                             g_ckv[l], w_ukv[l], g_q_mla[l], g_k_mla[l], b_forget[l],
                             g_q_fox[l], g_k_fox[l], w_out[l])
        h = h + 0.5 * swiglu(rms_norm(h, g_ffn2[l]), w2_gate[l], w2_up[l], w2_down[l])
    return h[:, BLOCK:]
```

```cpp
#include <hip/hip_runtime.h>
#include <cstdint>
#include <cstdio>

typedef unsigned short bf16_t;
typedef short bf16x8 __attribute__((ext_vector_type(8)));
typedef float f32x4 __attribute__((ext_vector_type(4)));
typedef unsigned u32x4 __attribute__((ext_vector_type(4)));
typedef unsigned u32x2 __attribute__((ext_vector_type(2)));

constexpr int NB = 2, T = 8192, D = 1024, FF = 2816, M = NB * T, NMETA = 16;
constexpr int PR = 64 + T;
constexpr int NPOS = 16 + T;
constexpr int DQM = 96, DFK = 80, DV = 64;
constexpr float EPS = 1e-6f;
constexpr float LOG2E = 1.4426950408889634f;
constexpr float C2F = 0.125f * LOG2E;
constexpr float C2M = 0.10206207261596577f * LOG2E;

constexpr size_t KiB = 1024, MiB = 1u << 20;
constexpr size_t WS_CTL = 0;
constexpr size_t WS_W1GU = 1 * MiB, WS_W1D = 12 * MiB, WS_W2GU = 18 * MiB, WS_W2D = 29 * MiB, WS_WIN = 35 * MiB, WS_WOUT = 39 * MiB;
constexpr size_t WS_WUQ = 41 * MiB, WS_WUKV = 41 * MiB + 512 * KiB, WS_ROPE = 42 * MiB;
constexpr size_t WS_META = 43 * MiB + 512 * KiB;
constexpr size_t WS_XN = 44 * MiB, WS_CQ = 76 * MiB, WS_CKV = 84 * MiB, WS_KPE = 88 * MiB, WS_LOGF = 90 * MiB, WS_CUM = 90 * MiB + 512 * KiB;
constexpr size_t WS_SSQ1 = 91 * MiB + 256 * KiB, WS_SSQ2 = 92 * MiB + 256 * KiB, WS_SSQCQ = 93 * MiB + 256 * KiB, WS_SSQCKV = 93 * MiB + 512 * KiB, WS_SSQKPE = 93 * MiB + 768 * KiB, WS_SSQQ = 94 * MiB;
constexpr size_t WS_HB = 95 * MiB;
constexpr size_t WS_FQ = 95 * MiB, WS_FK = 111 * MiB + 256 * KiB, WS_FV = 131 * MiB + 512 * KiB, WS_QM = 147 * MiB + 768 * KiB, WS_KM = 172 * MiB, WS_VM = 196 * MiB + 256 * KiB, WS_O = 212 * MiB + 512 * KiB;
constexpr size_t WS_END = 256 * MiB;
static_assert(WS_FQ + (size_t)NB * 8 * PR * 64 * 2 <= WS_FK && WS_FK + (size_t)NB * 8 * PR * DFK * 2 <= WS_FV && WS_FV + (size_t)NB * 8 * PR * 64 * 2 <= WS_QM, "ws map 1");
static_assert(WS_QM + (size_t)NB * 8 * PR * DQM * 2 <= WS_KM && WS_KM + (size_t)NB * 8 * PR * DQM * 2 <= WS_VM && WS_VM + (size_t)NB * 8 * PR * 64 * 2 <= WS_O && WS_O + (size_t)M * D * 2 <= WS_END, "ws map 2");
static_assert(WS_ROPE + (size_t)NPOS * 16 * 8 <= WS_META && WS_CUM + (size_t)NB * 8 * PR * 4 <= WS_SSQ1 && WS_HB + (size_t)M * FF * 2 <= WS_END, "ws map 3");
constexpr size_t MO_XNM = 0, MO_HB = 32 * KiB, MO_H = 128 * KiB, MO_XN = 192 * KiB, MO_SSQ1 = 224 * KiB, MO_CQ = 228 * KiB, MO_SSQCQ = 236 * KiB, MO_CKV = 237 * KiB, MO_SSQCKV = 241 * KiB,
                 MO_KPE = 242 * KiB, MO_SSQKPE = 244 * KiB, MO_LOGF = 245 * KiB, MO_SSQQ = 246 * KiB;

__device__ __forceinline__ float bf2f(bf16_t v) { return __uint_as_float((unsigned)v << 16); }
__device__ __forceinline__ unsigned f2bf(float f) { unsigned u = __float_as_uint(f); return (u + 0x7fffu + ((u >> 16) & 1u)) >> 16; }
__device__ __forceinline__ unsigned pk2(float lo, float hi) { return f2bf(lo) | (f2bf(hi) << 16); }
__device__ __forceinline__ float rsum16(float v) { v += __shfl_xor(v, 1); v += __shfl_xor(v, 2); v += __shfl_xor(v, 4); v += __shfl_xor(v, 8); return v; }
__device__ __forceinline__ float wave_sum(float v) {
#pragma unroll
    for (int o = 1; o < 64; o <<= 1) v += __shfl_xor(v, o);
    return v;
}
__device__ __forceinline__ float sum16f(const float* p) { const f32x4 a = ((const f32x4*)p)[0], b = ((const f32x4*)p)[1], c = ((const f32x4*)p)[2], d = ((const f32x4*)p)[3];
    return ((a[0] + a[1]) + (a[2] + a[3])) + ((b[0] + b[1]) + (b[2] + b[3])) + ((c[0] + c[1]) + (c[2] + c[3])) + ((d[0] + d[1]) + (d[2] + d[3])); }
__device__ __forceinline__ float sum4f(const float* p) { const f32x4 a = *(const f32x4*)p; return (a[0] + a[1]) + (a[2] + a[3]); }
__device__ __forceinline__ float silu_mul(float g, float u) { return g / (1.0f + __expf(-g)) * u; }
__device__ __forceinline__ float log_sigmoid(float x) { return fminf(x, 0.f) - log1pf(__expf(-fabsf(x))); }

__host__ __device__ __forceinline__ int gu_row_gate(int c) { return 256 * (c >> 7) + (c & 127); }
__host__ __device__ __forceinline__ int rope_slot(int dd) { return 8 * ((dd & 15) >> 2) + 4 * (dd >> 4) + (dd & 3); }
__host__ __device__ __forceinline__ int win_row(int s) {
    if (s < 256) return s;
    if (s < 384) return 256 + (s - 256);
    if (s < 416) return 256 + 128 + rope_slot(s - 384);
    if (s < 1952) { const int i = s - 416, which = i >> 9, head = (i & 511) >> 6, d = i & 63; return 256 * (2 + which * 2 + (head >> 2)) + 128 * (d >> 5) + 32 * (head & 3) + (d & 31); }
    return 256 + 160 + (s - 1952);
}
__host__ __device__ __forceinline__ int wuq_row(int s) { const int h = s / 96, d = s % 96;
    if (d < 64) return 256 * (h >> 2) + 128 * (d >> 5) + 32 * (h & 3) + (d & 31);
    return 512 + 128 * (h & 1) + 32 * (h >> 1) + rope_slot(d - 64); }
__host__ __device__ __forceinline__ int wukv_row(int s) { const int h = s >> 7, d = s & 127;
    if (d < 64) return 256 * (h >> 2) + 128 * (d >> 5) + 32 * (h & 3) + (d & 31);
    const int e = d - 64; return 256 * (2 + (h >> 2)) + 128 * (e >> 5) + 32 * (h & 3) + (e & 31); }

struct KArgs { const float* in[22]; float* out; unsigned char* ws; };
struct RowSet {
    int nrows, meta;
    const bf16_t* XN1; const float* base1; bf16_t* HB; float* H; bf16_t* XN; float* SSQ1;
    bf16_t* CQ; float* SSQCQ; bf16_t* CKV; float* SSQCKV; float* KPE; float* SSQKPE; float* LOGF; float* SSQQ;
};
struct Ctx {
    const float *x, *meta, *g_ffn1, *w1g, *w1u, *w1d, *g_mix, *w_in, *g_cq, *w_uq, *g_ckv, *w_ukv, *g_q_mla, *g_k_mla, *b_forget, *g_q_fox, *g_k_fox, *w_out, *g_ffn2, *w2g, *w2u, *w2d;
    float* out; unsigned char* ws;
    bf16_t *W1GU, *W1D, *W2GU, *W2D, *WIN, *WOUT, *WUQ, *WUKV; float* ROPE;
    bf16_t *FQ, *FK, *FV, *QM, *KM, *VM, *O; float* CUM; float* SSQ2; bf16_t* HBmain;
    RowSet main, mt;
};
__device__ __forceinline__ Ctx make_ctx(const KArgs& a) {
    Ctx c;
    c.x = a.in[0]; c.meta = a.in[1]; c.g_ffn1 = a.in[2]; c.w1g = a.in[3]; c.w1u = a.in[4]; c.w1d = a.in[5]; c.g_mix = a.in[6]; c.w_in = a.in[7]; c.g_cq = a.in[8]; c.w_uq = a.in[9]; c.g_ckv = a.in[10];
    c.w_ukv = a.in[11]; c.g_q_mla = a.in[12]; c.g_k_mla = a.in[13]; c.b_forget = a.in[14]; c.g_q_fox = a.in[15]; c.g_k_fox = a.in[16]; c.w_out = a.in[17]; c.g_ffn2 = a.in[18]; c.w2g = a.in[19]; c.w2u = a.in[20]; c.w2d = a.in[21];
    c.out = a.out; c.ws = a.ws; unsigned char* ws = a.ws;
    c.W1GU = (bf16_t*)(ws + WS_W1GU); c.W1D = (bf16_t*)(ws + WS_W1D); c.W2GU = (bf16_t*)(ws + WS_W2GU); c.W2D = (bf16_t*)(ws + WS_W2D); c.WIN = (bf16_t*)(ws + WS_WIN); c.WOUT = (bf16_t*)(ws + WS_WOUT);
    c.WUQ = (bf16_t*)(ws + WS_WUQ); c.WUKV = (bf16_t*)(ws + WS_WUKV); c.ROPE = (float*)(ws + WS_ROPE);
    c.FQ = (bf16_t*)(ws + WS_FQ); c.FK = (bf16_t*)(ws + WS_FK); c.FV = (bf16_t*)(ws + WS_FV); c.QM = (bf16_t*)(ws + WS_QM); c.KM = (bf16_t*)(ws + WS_KM); c.VM = (bf16_t*)(ws + WS_VM); c.O = (bf16_t*)(ws + WS_O);
    c.CUM = (float*)(ws + WS_CUM); c.SSQ2 = (float*)(ws + WS_SSQ2); c.HBmain = (bf16_t*)(ws + WS_HB);
    RowSet& m = c.main; m.nrows = M; m.meta = 0; m.XN1 = (bf16_t*)(ws + WS_XN); m.base1 = c.x; m.HB = (bf16_t*)(ws + WS_HB); m.H = a.out; m.XN = (bf16_t*)(ws + WS_XN); m.SSQ1 = (float*)(ws + WS_SSQ1);
    m.CQ = (bf16_t*)(ws + WS_CQ); m.SSQCQ = (float*)(ws + WS_SSQCQ); m.CKV = (bf16_t*)(ws + WS_CKV); m.SSQCKV = (float*)(ws + WS_SSQCKV); m.KPE = (float*)(ws + WS_KPE); m.SSQKPE = (float*)(ws + WS_SSQKPE);
    m.LOGF = (float*)(ws + WS_LOGF); m.SSQQ = (float*)(ws + WS_SSQQ);
    unsigned char* mw = ws + WS_META; RowSet& t = c.mt; t.nrows = NMETA; t.meta = 1; t.XN1 = (bf16_t*)(mw + MO_XNM); t.base1 = c.meta; t.HB = (bf16_t*)(mw + MO_HB); t.H = (float*)(mw + MO_H); t.XN = (bf16_t*)(mw + MO_XN);
    t.SSQ1 = (float*)(mw + MO_SSQ1); t.CQ = (bf16_t*)(mw + MO_CQ); t.SSQCQ = (float*)(mw + MO_SSQCQ); t.CKV = (bf16_t*)(mw + MO_CKV); t.SSQCKV = (float*)(mw + MO_SSQCKV); t.KPE = (float*)(mw + MO_KPE);
    t.SSQKPE = (float*)(mw + MO_SSQKPE); t.LOGF = (float*)(mw + MO_LOGF); t.SSQQ = (float*)(mw + MO_SSQQ);
    return c;
}
__device__ __forceinline__ size_t arow(int b, int h, int p) { return (size_t)((b * 8 + h) * PR + p); }

template <class MapF>
__device__ __forceinline__ void p0_transpose_item(const float* W, int K, int N, const float* gain, bf16_t* WT, MapF map, float* scr, int item, int lane) {
    const int nblk = (N + 31) / 32, kb = item / nblk, nb = item % nblk, k0 = 64 * kb, n0 = 32 * nb;
    const int nn = n0 + (lane & 31);
#pragma unroll 8
    for (int i = 0; i < 32; ++i) { const int kk = 2 * i + (lane >> 5); float v = 0.f; if (nn < N) { v = W[(size_t)(k0 + kk) * N + nn]; if (gain) v *= gain[k0 + kk]; } scr[kk * 33 + (lane & 31)] = v; }
    asm volatile("s_waitcnt vmcnt(0) lgkmcnt(0)" ::: "memory");
    const int c = lane & 7;
#pragma unroll
    for (int j = 0; j < 4; ++j) { const int n = (lane >> 3) + 8 * j; if (n0 + n < N) { const float* s = scr + (8 * c) * 33 + n;
        u32x4 o; o.x = pk2(s[0 * 33], s[1 * 33]); o.y = pk2(s[2 * 33], s[3 * 33]); o.z = pk2(s[4 * 33], s[5 * 33]); o.w = pk2(s[6 * 33], s[7 * 33]);
        *(u32x4*)(WT + (size_t)map(n0 + n) * K + k0 + 8 * c) = o; } }
    asm volatile("s_waitcnt vmcnt(0) lgkmcnt(0)" ::: "memory");
}
struct MapId { __device__ int operator()(int n) const { return n; } };
struct MapGate { __device__ int operator()(int n) const { return gu_row_gate(n); } };
struct MapUp { __device__ int operator()(int n) const { return gu_row_gate(n) + 128; } };
struct MapWin { __device__ int operator()(int n) const { return win_row(n); } };
struct MapWuq { __device__ int operator()(int n) const { return wuq_row(n); } };
struct MapWukv { __device__ int operator()(int n) const { return wukv_row(n); } };

__device__ __constant__ double INV_FREQ[16] = {1.0, 0.5623413251903491, 0.31622776601683794, 0.1778279410038923, 0.1, 0.05623413251903491, 0.03162277660168379, 0.01778279410038923,
                                               0.01, 0.005623413251903491, 0.0031622776601683794, 0.0017782794100389228, 0.001, 0.0005623413251903491, 0.00031622776601683794, 0.00017782794100389227};
__device__ __forceinline__ void sincos_d(double x, float& s, float& c) {
    const double k = rint(x * 0.15915494309189535); const double r = fma(-k, 6.283185307179586, x) - k * 2.4492935982947064e-16; const double r2 = r * r;
    double ss = 1.0 / 15511210043330985984000000.0, cc = 1.0 / 620448401733239439360000.0;
    const double sf[12] = {1.0 / 25852016738884976640000.0, 1.0 / 51090942171709440000.0, 1.0 / 121645100408832000.0, 1.0 / 355687428096000.0, 1.0 / 1307674368000.0, 1.0 / 6227020800.0, 1.0 / 39916800.0,
                           1.0 / 362880.0, 1.0 / 5040.0, 1.0 / 120.0, 1.0 / 6.0, 1.0};
    const double cf[12] = {1.0 / 1124000727777607680000.0, 1.0 / 2432902008176640000.0, 1.0 / 6402373705728000.0, 1.0 / 20922789888000.0, 1.0 / 87178291200.0, 1.0 / 479001600.0, 1.0 / 3628800.0,
                           1.0 / 40320.0, 1.0 / 720.0, 1.0 / 24.0, 1.0 / 2.0, 1.0};
#pragma unroll
    for (int i = 0; i < 12; ++i) { ss = fma(-ss, r2, sf[i]); cc = fma(-cc, r2, cf[i]); }
    s = (float)(ss * r); c = (float)cc;
}
__device__ __forceinline__ void rms_row_to_bf16(const float* xrow, bf16_t* orow, int lane) {
    const f32x4* xr = (const f32x4*)xrow + lane; f32x4 v[4]; float s = 0.f;
#pragma unroll
    for (int j = 0; j < 4; ++j) { v[j] = xr[64 * j]; s += (v[j].x * v[j].x + v[j].y * v[j].y) + (v[j].z * v[j].z + v[j].w * v[j].w); }
    const float rstd = 1.0f / sqrtf(wave_sum(s) * (1.f / D) + EPS);
    unsigned long long* o8 = (unsigned long long*)orow + lane;
#pragma unroll
    for (int j = 0; j < 4; ++j) o8[64 * j] = (unsigned long long)pk2(v[j].x * rstd, v[j].y * rstd) | ((unsigned long long)pk2(v[j].z * rstd, v[j].w * rstd) << 32);
}
__device__ __forceinline__ void p0_prologue(const Ctx& C, float* scr, int gw, int NGW, int lane) {
    constexpr int I_GU = (D / 64) * (FF / 32), I_DN = (FF / 64) * (D / 32), I_IN = (D / 64) * ((1960 + 31) / 32), I_OUT = (D / 64) * (D / 32), I_UQ = (256 / 64) * (768 / 32), I_UKV = (128 / 64) * (1024 / 32);
    constexpr int NITEMS = 4 * I_GU + 2 * I_DN + I_IN + I_OUT + I_UQ + I_UKV;
    for (int it = gw; it < NITEMS; it += NGW) {
        int r = it;
        if (r < I_GU) { p0_transpose_item(C.w1g, D, FF, C.g_ffn1, C.W1GU, MapGate(), scr, r, lane); continue; } r -= I_GU;
        if (r < I_GU) { p0_transpose_item(C.w1u, D, FF, C.g_ffn1, C.W1GU, MapUp(), scr, r, lane); continue; } r -= I_GU;
        if (r < I_GU) { p0_transpose_item(C.w2g, D, FF, C.g_ffn2, C.W2GU, MapGate(), scr, r, lane); continue; } r -= I_GU;
        if (r < I_GU) { p0_transpose_item(C.w2u, D, FF, C.g_ffn2, C.W2GU, MapUp(), scr, r, lane); continue; } r -= I_GU;
        if (r < I_DN) { p0_transpose_item(C.w1d, FF, D, nullptr, C.W1D, MapId(), scr, r, lane); continue; } r -= I_DN;
        if (r < I_DN) { p0_transpose_item(C.w2d, FF, D, nullptr, C.W2D, MapId(), scr, r, lane); continue; } r -= I_DN;
        if (r < I_IN) { p0_transpose_item(C.w_in, D, 1960, C.g_mix, C.WIN, MapWin(), scr, r, lane); continue; } r -= I_IN;
        if (r < I_OUT) { p0_transpose_item(C.w_out, D, D, nullptr, C.WOUT, MapId(), scr, r, lane); continue; } r -= I_OUT;
        if (r < I_UQ) { p0_transpose_item(C.w_uq, 256, 768, C.g_cq, C.WUQ, MapWuq(), scr, r, lane); continue; } r -= I_UQ;
        p0_transpose_item(C.w_ukv, 128, 1024, C.g_ckv, C.WUKV, MapWukv(), scr, r, lane);
    }
    for (int i = gw * 64 + lane; i < 88 * 128; i += NGW * 64) { const int row = 256 + 168 + i / 128, ch = i % 128; *(u32x4*)(C.WIN + (size_t)row * D + ch * 8) = (u32x4){0u, 0u, 0u, 0u}; }
    for (int m = gw; m < M + NMETA; m += NGW) { if (m < M) rms_row_to_bf16(C.x + (size_t)m * D, (bf16_t*)C.main.XN1 + (size_t)m * D, lane); else rms_row_to_bf16(C.meta + (size_t)(m - M) * D, (bf16_t*)C.mt.XN1 + (size_t)(m - M) * D, lane); }
    for (int i = gw * 64 + lane; i < NPOS * 16; i += NGW * 64) { const int pos = i >> 4, f = i & 15; float s, c; sincos_d((double)pos * INV_FREQ[f], s, c); C.ROPE[2 * i] = c; C.ROPE[2 * i + 1] = s; }
}

template <int NT>
__device__ __forceinline__ void wave_gemm16(const bf16_t* ap, const bf16_t* const (&bp)[NT], int K, f32x4 (&acc)[NT]) {
    for (int k0 = 0; k0 < K; k0 += 32) {
        const bf16x8 a = *(const bf16x8*)(ap + k0);
#pragma unroll
        for (int t = 0; t < NT; ++t) { const bf16x8 b = *(const bf16x8*)(bp[t] + k0); acc[t] = __builtin_amdgcn_mfma_f32_16x16x32_bf16(a, b, acc[t], 0, 0, 0); }
    }
}
__device__ __forceinline__ void task_gateup(const bf16_t* A, const bf16_t* Wgu, const float* ssq, bf16_t* HB, int task, int lane) {
    const int ncb = FF / 16, rg = task / ncb, cb = task % ncb, c = lane & 15, q = lane >> 4, hc = cb * 16 + c;
    const bf16_t* ap = A + (size_t)(rg * 16 + c) * D + 8 * q;
    const bf16_t* g0 = Wgu + (size_t)gu_row_gate(hc) * D + 8 * q;
    const bf16_t* const bp[2] = {g0, g0 + (size_t)128 * D};
    f32x4 acc[2]; acc[0] = (f32x4){0.f, 0.f, 0.f, 0.f}; acc[1] = acc[0];
    wave_gemm16<2>(ap, bp, D, acc);
#pragma unroll
    for (int i = 0; i < 4; ++i) { const int row = rg * 16 + 4 * q + i; const float rs = ssq ? 1.0f / sqrtf(sum16f(ssq + (size_t)row * 16) * (1.f / D) + EPS) : 1.f;
        HB[(size_t)row * FF + hc] = (bf16_t)f2bf(silu_mul(acc[0][i] * rs, acc[1][i] * rs)); }
}
__device__ __forceinline__ void task_down(const bf16_t* A, int K, const bf16_t* Wt, const float* base, float* out, float scale, bf16_t* XN, float* SSQ, int task, int lane) {
    const int rg = task >> 4, cb = task & 15, c = lane & 15, q = lane >> 4;
    const bf16_t* ap = A + (size_t)(rg * 16 + c) * K + 8 * q;
    const bf16_t* b0 = Wt + (size_t)(cb * 64 + c) * K + 8 * q;
    const bf16_t* const bp[4] = {b0, b0 + (size_t)16 * K, b0 + (size_t)32 * K, b0 + (size_t)48 * K};
    f32x4 acc[4];
#pragma unroll
    for (int t = 0; t < 4; ++t) acc[t] = (f32x4){0.f, 0.f, 0.f, 0.f};
    wave_gemm16<4>(ap, bp, K, acc);
#pragma unroll
    for (int i = 0; i < 4; ++i) { const int row = rg * 16 + 4 * q + i; float sq = 0.f;
#pragma unroll
        for (int t = 0; t < 4; ++t) { const size_t o = (size_t)row * D + cb * 64 + t * 16 + c; const float v = base[o] + scale * acc[t][i]; out[o] = v; if (XN) XN[o] = (bf16_t)f2bf(v); sq += v * v; }
        sq = rsum16(sq); if (SSQ && c == 0) SSQ[(size_t)row * 16 + cb] = sq; }
}
__device__ __forceinline__ void task_win(const Ctx& C, const RowSet& R, int task, int lane) {
    const int rg = task / 26, job = task % 26, c = lane & 15, q = lane >> 4;
    const bf16_t* ap = R.XN + (size_t)(rg * 16 + c) * D + 8 * q;
    float rs[4]; int rows[4];
#pragma unroll
    for (int i = 0; i < 4; ++i) { rows[i] = rg * 16 + 4 * q + i; rs[i] = 1.0f / sqrtf(sum16f(R.SSQ1 + (size_t)rows[i] * 16) * (1.f / D) + EPS); }
    if (job == 0) {
        const bf16_t* bp[16];
#pragma unroll
        for (int t = 0; t < 16; ++t) bp[t] = C.WIN + (size_t)win_row(16 * t + c) * D + 8 * q;
        f32x4 acc[16];
#pragma unroll
        for (int t = 0; t < 16; ++t) acc[t] = (f32x4){0.f, 0.f, 0.f, 0.f};
        wave_gemm16<16>(ap, bp, D, acc);
#pragma unroll
        for (int i = 0; i < 4; ++i) { float sq = 0.f;
#pragma unroll
            for (int t = 0; t < 16; ++t) { const float v = acc[t][i] * rs[i]; sq += v * v; R.CQ[(size_t)rows[i] * 256 + 16 * t + c] = (bf16_t)f2bf(v); }
            sq = rsum16(sq); if (c == 0) *(f32x4*)(R.SSQCQ + (size_t)rows[i] * 4) = (f32x4){sq, 0.f, 0.f, 0.f}; }
    } else if (job == 1) {
        const bf16_t* bp[11];
#pragma unroll
        for (int t = 0; t < 10; ++t) bp[t] = C.WIN + (size_t)win_row(256 + 16 * t + c) * D + 8 * q;
        bp[10] = C.WIN + (size_t)(c < 8 ? win_row(1952 + c) : 256 + 168 + c) * D + 8 * q;
        f32x4 acc[11];
#pragma unroll
        for (int t = 0; t < 11; ++t) acc[t] = (f32x4){0.f, 0.f, 0.f, 0.f};
        wave_gemm16<11>(ap, bp, D, acc);
#pragma unroll
        for (int i = 0; i < 4; ++i) { float sq = 0.f, sp = 0.f;
#pragma unroll
            for (int t = 0; t < 8; ++t) { const float v = acc[t][i] * rs[i]; sq += v * v; R.CKV[(size_t)rows[i] * 128 + 16 * t + c] = (bf16_t)f2bf(v); }
#pragma unroll
            for (int t = 8; t < 10; ++t) { const float v = acc[t][i] * rs[i]; sp += v * v; R.KPE[(size_t)rows[i] * 32 + 16 * (t - 8) + c] = v; }
            sq = rsum16(sq); sp = rsum16(sp);
            if (c == 0) { *(f32x4*)(R.SSQCKV + (size_t)rows[i] * 4) = (f32x4){sq, 0.f, 0.f, 0.f}; R.SSQKPE[rows[i]] = sp; }
            if (c < 8) R.LOGF[(size_t)rows[i] * 8 + c] = log_sigmoid(acc[10][i] * rs[i] + C.b_forget[c]); }
    } else {
        const int which = (job - 2) >> 3, h = (job - 2) & 7;
        const bf16_t* bp[4];
#pragma unroll
        for (int t = 0; t < 4; ++t) bp[t] = C.WIN + (size_t)win_row(416 + which * 512 + h * 64 + 16 * t + c) * D + 8 * q;
        f32x4 acc[4];
#pragma unroll
        for (int t = 0; t < 4; ++t) acc[t] = (f32x4){0.f, 0.f, 0.f, 0.f};
        wave_gemm16<4>(ap, bp, D, acc);
#pragma unroll
        for (int i = 0; i < 4; ++i) { float sq = 0.f; float v[4];
#pragma unroll
            for (int t = 0; t < 4; ++t) { v[t] = acc[t][i] * rs[i]; sq += v[t] * v[t]; }
            sq = rsum16(sq); const float r = 1.0f / sqrtf(sq * (1.f / 64.f) + EPS);
            const int row = rows[i]; const int p = R.meta ? 48 + row : 64 + (row & (T - 1)); const int b0 = R.meta ? 0 : row >> 13, b1 = R.meta ? 2 : b0 + 1;
            for (int b = b0; b < b1; ++b) {
#pragma unroll
                for (int t = 0; t < 4; ++t) { const int d = 16 * t + c;
                    if (which == 0) C.FQ[arow(b, h, p) * 64 + d] = (bf16_t)f2bf(v[t] * r * C.g_q_fox[d] * C2F);
                    else if (which == 1) C.FK[arow(b, h, p) * DFK + d] = (bf16_t)f2bf(v[t] * r * C.g_k_fox[d]);
                    else C.FV[arow(b, h, p) * 64 + d] = (bf16_t)f2bf(v[t]); } } }
    }
}
__device__ __forceinline__ void task_uqkv(const Ctx& C, const RowSet& R, int task, int lane) {
    const int rg = task >> 4, job = task & 15, h = job & 7, c = lane & 15, q = lane >> 4;
    int rows[4];
#pragma unroll
    for (int i = 0; i < 4; ++i) rows[i] = rg * 16 + 4 * q + i;
    if (job < 8) {
        const bf16_t* ap = R.CQ + (size_t)(rg * 16 + c) * 256 + 8 * q;
        const bf16_t* bp[6];
#pragma unroll
        for (int t = 0; t < 6; ++t) bp[t] = C.WUQ + (size_t)wuq_row(h * 96 + 16 * t + c) * 256 + 8 * q;
        f32x4 acc[6];
#pragma unroll
        for (int t = 0; t < 6; ++t) acc[t] = (f32x4){0.f, 0.f, 0.f, 0.f};
        wave_gemm16<6>(ap, bp, 256, acc);
#pragma unroll
        for (int i = 0; i < 4; ++i) { const int row = rows[i]; const float rs = 1.0f / sqrtf(sum4f(R.SSQCQ + (size_t)row * 4) * (1.f / 256.f) + EPS);
            float v[6], s0 = 0.f, s1 = 0.f;
#pragma unroll
            for (int t = 0; t < 6; ++t) { v[t] = acc[t][i] * rs; if (t < 4) s0 += v[t] * v[t]; else s1 += v[t] * v[t]; }
            s0 = rsum16(s0); s1 = rsum16(s1);
            if (c == 0) { R.SSQQ[(size_t)row * 16 + 2 * h] = s0; R.SSQQ[(size_t)row * 16 + 2 * h + 1] = s1; }
            const int p = R.meta ? 48 + row : 64 + (row & (T - 1)); const int b0 = R.meta ? 0 : row >> 13, b1 = R.meta ? 2 : b0 + 1;
            const float cs = C.ROPE[(size_t)(p - 48) * 32 + 2 * c], sn = C.ROPE[(size_t)(p - 48) * 32 + 2 * c + 1];
            const float x1 = v[4] * C.g_q_mla[64 + c], x2 = v[5] * C.g_q_mla[80 + c];
            for (int b = b0; b < b1; ++b) { bf16_t* dst = C.QM + arow(b, h, p) * DQM;
#pragma unroll
                for (int t = 0; t < 4; ++t) dst[16 * t + c] = (bf16_t)f2bf(v[t] * C.g_q_mla[16 * t + c]);
                dst[64 + c] = (bf16_t)f2bf(x1 * cs - x2 * sn); dst[80 + c] = (bf16_t)f2bf(x2 * cs + x1 * sn); } }
    } else {
        const bf16_t* ap = R.CKV + (size_t)(rg * 16 + c) * 128 + 8 * q;
        const bf16_t* bp[8];
#pragma unroll
        for (int t = 0; t < 8; ++t) bp[t] = C.WUKV + (size_t)wukv_row(h * 128 + 16 * t + c) * 128 + 8 * q;
        f32x4 acc[8];
#pragma unroll
        for (int t = 0; t < 8; ++t) acc[t] = (f32x4){0.f, 0.f, 0.f, 0.f};
        wave_gemm16<8>(ap, bp, 128, acc);
#pragma unroll
        for (int i = 0; i < 4; ++i) { const int row = rows[i]; const float rs = 1.0f / sqrtf(sum4f(R.SSQCKV + (size_t)row * 4) * (1.f / 128.f) + EPS);
            float v[8], s0 = 0.f;
#pragma unroll
            for (int t = 0; t < 8; ++t) { v[t] = acc[t][i] * rs; if (t < 4) s0 += v[t] * v[t]; }
            s0 = rsum16(s0); const float rk = 1.0f / sqrtf((s0 + R.SSQKPE[row]) * (1.f / 96.f) + EPS);
            const int p = R.meta ? 48 + row : 64 + (row & (T - 1)); const int b0 = R.meta ? 0 : row >> 13, b1 = R.meta ? 2 : b0 + 1;
            const float cs = C.ROPE[(size_t)(p - 48) * 32 + 2 * c], sn = C.ROPE[(size_t)(p - 48) * 32 + 2 * c + 1];
            const float x1 = R.KPE[(size_t)row * 32 + c] * rk * C.g_k_mla[64 + c], x2 = R.KPE[(size_t)row * 32 + 16 + c] * rk * C.g_k_mla[80 + c];
            for (int b = b0; b < b1; ++b) { bf16_t* dk = C.KM + arow(b, h, p) * DQM; bf16_t* dv = C.VM + arow(b, h, p) * 64;
#pragma unroll
                for (int t = 0; t < 4; ++t) { dk[16 * t + c] = (bf16_t)f2bf(v[t] * rk * C.g_k_mla[16 * t + c]); dv[16 * t + c] = (bf16_t)f2bf(v[4 + t]); }
                dk[64 + c] = (bf16_t)f2bf(x1 * cs - x2 * sn); dk[80 + c] = (bf16_t)f2bf(x2 * cs + x1 * sn); } }
    }
}

constexpr int TPB = 256;
__global__ void __launch_bounds__(256) k_p0(KArgs a) {
    __shared__ float scr[4][64 * 33];
    const Ctx C = make_ctx(a); const int lane = threadIdx.x & 63, w = threadIdx.x >> 6;
    p0_prologue(C, scr[w], blockIdx.x * 4 + w, gridDim.x * 4, lane);
}
template <int PH> __global__ void __launch_bounds__(TPB) k_tasks(KArgs a) {
    const Ctx C = make_ctx(a); const int lane = threadIdx.x & 63; const int gw = blockIdx.x * (TPB / 64) + (threadIdx.x >> 6), NGW = gridDim.x * (TPB / 64);
    if (PH == 1) { for (int t = gw; t < (M / 16) * (FF / 16); t += NGW) task_gateup(C.main.XN1, C.W1GU, nullptr, C.main.HB, t, lane);
                   for (int t = gw; t < FF / 16; t += NGW) task_gateup(C.mt.XN1, C.W1GU, nullptr, C.mt.HB, t, lane); }
    if (PH == 2) { for (int t = gw; t < (M / 16) * 16; t += NGW) task_down(C.main.HB, FF, C.W1D, C.main.base1, C.main.H, 0.5f, C.main.XN, C.main.SSQ1, t, lane);
                   for (int t = gw; t < 16; t += NGW) task_down(C.mt.HB, FF, C.W1D, C.mt.base1, C.mt.H, 0.5f, C.mt.XN, C.mt.SSQ1, t, lane); }
    if (PH == 3) { for (int t = gw; t < (M / 16) * 26; t += NGW) task_win(C, C.main, t, lane);
                   for (int t = gw; t < 26; t += NGW) task_win(C, C.mt, t, lane); }
    if (PH == 4) { for (int t = gw; t < (M / 16) * 16; t += NGW) task_uqkv(C, C.main, t, lane);
                   for (int t = gw; t < 16; t += NGW) task_uqkv(C, C.mt, t, lane); }
    if (PH == 6) { for (int t = gw; t < (M / 16) * 16; t += NGW) task_down(C.O, D, C.WOUT, C.out, C.out, 1.0f, C.main.XN, C.SSQ2, t, lane); }
    if (PH == 7) { for (int t = gw; t < (M / 16) * (FF / 16); t += NGW) task_gateup(C.main.XN, C.W2GU, C.SSQ2, C.main.HB, t, lane); }
    if (PH == 8) { for (int t = gw; t < (M / 16) * 16; t += NGW) task_down(C.main.HB, FF, C.W2D, C.out, C.out, 0.5f, nullptr, nullptr, t, lane); }
}
__global__ void __launch_bounds__(64) k_scan(KArgs a) {
    const Ctx C = make_ctx(a); const int lane = threadIdx.x, b = blockIdx.x >> 3, h = blockIdx.x & 7;
    float running = 0.f;
    for (int p0 = 48; p0 < PR; p0 += 64) { const int p = p0 + lane; float lf = 0.f;
        if (p < PR) lf = (p < 64) ? C.mt.LOGF[(p - 48) * 8 + h] : C.main.LOGF[(size_t)(b * T + p - 64) * 8 + h];
        float s = lf;
#pragma unroll
        for (int o = 1; o < 64; o <<= 1) { const float n = __shfl_up(s, o); if (lane >= o) s += n; }
        const float cum = running + s; running += __shfl(s, 63);
        if (p < PR) { C.CUM[arow(b, h, p)] = cum;
            const float cc = -cum * LOG2E; const unsigned hi = f2bf(cc); const float r1 = cc - __uint_as_float(hi << 16); const unsigned mid = f2bf(r1); const float r2 = r1 - __uint_as_float(mid << 16); const unsigned lo = f2bf(r2);
            unsigned* dst = (unsigned*)(C.FK + arow(b, h, p) * DFK + 64); dst[0] = hi | (mid << 16); dst[1] = lo;
#pragma unroll
            for (int j = 2; j < 8; ++j) dst[j] = 0u; } }
    if (lane < 48) { const int p = lane; C.CUM[arow(b, h, p)] = 0.f;
        unsigned* z = (unsigned*)(C.FK + arow(b, h, p) * DFK); for (int j = 0; j < DFK / 2; ++j) z[j] = 0u;
        z = (unsigned*)(C.FV + arow(b, h, p) * 64); for (int j = 0; j < 32; ++j) z[j] = 0u;
        z = (unsigned*)(C.KM + arow(b, h, p) * DQM); for (int j = 0; j < DQM / 2; ++j) z[j] = 0u;
        z = (unsigned*)(C.VM + arow(b, h, p) * 64); for (int j = 0; j < 32; ++j) z[j] = 0u; }
}
__global__ void __launch_bounds__(64) k_attn_naive(KArgs a) {
    const Ctx C = make_ctx(a); const int lane = threadIdx.x; int blk = blockIdx.x; const int tb = blk & 127; blk >>= 7; const int h = blk & 7; blk >>= 3; const int b = blk & 1; const int type = blk >> 1;
    const int t = tb * 64 + lane, p = 64 + t, row = b * T + t;
    float o[64]; float m = -1e30f, l = 0.f;
#pragma unroll
    for (int d = 0; d < 64; ++d) o[d] = 0.f;
    if (type == 0) {
        float qv[96]; const float rq = 1.0f / sqrtf((C.main.SSQQ[(size_t)row * 16 + 2 * h] + C.main.SSQQ[(size_t)row * 16 + 2 * h + 1]) * (1.f / 96.f) + EPS) * C2M;
        const bf16_t* qp = C.QM + arow(b, h, p) * DQM;
#pragma unroll
        for (int d = 0; d < 96; ++d) qv[d] = bf2f(qp[d]) * rq;
        const int pend = 64 + tb * 64 + 63;
        for (int s = 48; s <= pend; ++s) { const bf16_t* kp = C.KM + arow(b, h, s) * DQM; float sc = 0.f;
#pragma unroll
            for (int d = 0; d < 96; ++d) sc += qv[d] * bf2f(kp[d]);
            if (s > p) sc = -1e30f;
            const float mn = fmaxf(m, sc), al = exp2f(m - mn), pe = (s > p) ? 0.f : exp2f(sc - mn); m = mn; l = l * al + pe; const bf16_t* vp = C.VM + arow(b, h, s) * 64;
#pragma unroll
            for (int d = 0; d < 64; ++d) o[d] = o[d] * al + pe * bf2f(vp[d]); }
    } else {
        float qv[64]; const bf16_t* qp = C.FQ + arow(b, h, p) * 64;
#pragma unroll
        for (int d = 0; d < 64; ++d) qv[d] = bf2f(qp[d]);
        const float cq = C.CUM[arow(b, h, p)]; const int pend = 64 + tb * 64 + 63;
        for (int s = 48; s <= pend; ++s) { const bf16_t* kp = C.FK + arow(b, h, s) * DFK; float sc = 0.f;
#pragma unroll
            for (int d = 0; d < 64; ++d) sc += qv[d] * bf2f(kp[d]);
            sc += (cq - C.CUM[arow(b, h, s)]) * LOG2E;
            if (s > p) sc = -1e30f;
            const float mn = fmaxf(m, sc), al = exp2f(m - mn), pe = (s > p) ? 0.f : exp2f(sc - mn); m = mn; l = l * al + pe; const bf16_t* vp = C.FV + arow(b, h, s) * 64;
#pragma unroll
            for (int d = 0; d < 64; ++d) o[d] = o[d] * al + pe * bf2f(vp[d]); }
    }
    const float il = 1.0f / l; bf16_t* op = C.O + (size_t)row * D + type * 512 + h * 64;
#pragma unroll
    for (int d = 0; d < 64; d += 2) *(unsigned*)(op + d) = pk2(o[d] * il, o[d + 1] * il);
}

extern "C" void kernel_launch(void* const* d_in, const int* in_sizes, int n_in, void* d_out, int out_size, void* d_ws, size_t ws_size, hipStream_t stream) {
    if (n_in != 22 || in_sizes[0] != M * D || out_size != M * D || ws_size < WS_END) { fprintf(stderr, "kernel_launch: unexpected shapes (n_in %d, in0 %d, out %d, ws %zu)\n", n_in, n_in > 0 ? in_sizes[0] : -1, out_size, ws_size); return; }
    KArgs a{}; for (int i = 0; i < 22; ++i) a.in[i] = (const float*)d_in[i]; a.out = (float*)d_out; a.ws = (unsigned char*)d_ws;
    k_p0<<<2048, 256, 0, stream>>>(a);
    k_tasks<1><<<2048, TPB, 0, stream>>>(a);
    k_tasks<2><<<2048, TPB, 0, stream>>>(a);
    k_tasks<3><<<2048, TPB, 0, stream>>>(a);
    k_tasks<4><<<2048, TPB, 0, stream>>>(a);
    k_scan<<<16, 64, 0, stream>>>(a);
    k_attn_naive<<<2 * 2 * 8 * 128, 64, 0, stream>>>(a);
    k_tasks<6><<<2048, TPB, 0, stream>>>(a);
    k_tasks<7><<<2048, TPB, 0, stream>>>(a);
    k_tasks<8><<<2048, TPB, 0, stream>>>(a);
}
```

```cpp
#include <hip/hip_runtime.h>
#include <cstdint>
#include <cstdio>
#include <type_traits>

typedef unsigned short bf16_t;
typedef short bf16x8 __attribute__((ext_vector_type(8)));
typedef float f32x4 __attribute__((ext_vector_type(4)));
typedef unsigned u32x4 __attribute__((ext_vector_type(4)));
typedef unsigned u32x2 __attribute__((ext_vector_type(2)));

constexpr int NB = 2, T = 8192, D = 1024, FF = 2816, M = NB * T, NMETA = 16;
constexpr int PR = 64 + T;
constexpr int NPOS = 16 + T;
constexpr int DQM = 96, DFK = 80, DV = 64;
constexpr float EPS = 1e-6f;
constexpr float LOG2E = 1.4426950408889634f;
constexpr float C2F = 0.125f * LOG2E;
constexpr float C2M = 0.10206207261596577f * LOG2E;

constexpr size_t KiB = 1024, MiB = 1u << 20;
constexpr size_t WS_CTL = 0;
constexpr size_t WS_W1GU = 1 * MiB, WS_W1D = 12 * MiB, WS_W2GU = 18 * MiB, WS_W2D = 29 * MiB, WS_WIN = 35 * MiB, WS_WOUT = 39 * MiB;
constexpr size_t WS_WUQ = 41 * MiB, WS_WUKV = 41 * MiB + 512 * KiB, WS_ROPE = 42 * MiB;
constexpr size_t WS_META = 43 * MiB + 512 * KiB;
constexpr size_t WS_XN = 44 * MiB, WS_CQ = 76 * MiB, WS_CKV = 84 * MiB, WS_KPE = 88 * MiB, WS_LOGF = 90 * MiB, WS_CUM = 90 * MiB + 512 * KiB;
constexpr size_t WS_SSQ1 = 91 * MiB + 256 * KiB, WS_SSQ2 = 92 * MiB + 256 * KiB, WS_SSQCQ = 93 * MiB + 256 * KiB, WS_SSQCKV = 93 * MiB + 512 * KiB, WS_SSQKPE = 93 * MiB + 768 * KiB, WS_SSQQ = 94 * MiB;
constexpr size_t WS_HB = 95 * MiB;
constexpr size_t WS_FQ = 95 * MiB, WS_FK = 111 * MiB + 256 * KiB, WS_FV = 131 * MiB + 512 * KiB, WS_QM = 147 * MiB + 768 * KiB, WS_KM = 172 * MiB, WS_VM = 196 * MiB + 256 * KiB, WS_O = 212 * MiB + 512 * KiB;
constexpr size_t WS_END = 256 * MiB;
static_assert(WS_FQ + (size_t)NB * 8 * PR * 64 * 2 <= WS_FK && WS_FK + (size_t)NB * 8 * PR * DFK * 2 <= WS_FV && WS_FV + (size_t)NB * 8 * PR * 64 * 2 <= WS_QM, "ws map 1");
static_assert(WS_QM + (size_t)NB * 8 * PR * DQM * 2 <= WS_KM && WS_KM + (size_t)NB * 8 * PR * DQM * 2 <= WS_VM && WS_VM + (size_t)NB * 8 * PR * 64 * 2 <= WS_O && WS_O + (size_t)M * D * 2 <= WS_END, "ws map 2");
static_assert(WS_ROPE + (size_t)NPOS * 16 * 8 <= WS_META && WS_CUM + (size_t)NB * 8 * PR * 4 <= WS_SSQ1 && WS_HB + (size_t)M * FF * 2 <= WS_END, "ws map 3");
constexpr size_t MO_XNM = 0, MO_HB = 32 * KiB, MO_H = 128 * KiB, MO_XN = 192 * KiB, MO_SSQ1 = 224 * KiB, MO_CQ = 228 * KiB, MO_SSQCQ = 236 * KiB, MO_CKV = 237 * KiB, MO_SSQCKV = 241 * KiB,
                 MO_KPE = 242 * KiB, MO_SSQKPE = 244 * KiB, MO_LOGF = 245 * KiB, MO_SSQQ = 246 * KiB, MO_FKS = 256 * KiB, MO_FVS = 272 * KiB;

__device__ __forceinline__ float bf2f(bf16_t v) { return __uint_as_float((unsigned)v << 16); }
__device__ __forceinline__ unsigned f2bf(float f) { unsigned u = __float_as_uint(f); return (u + 0x7fffu + ((u >> 16) & 1u)) >> 16; }
__device__ __forceinline__ unsigned pk2(float lo, float hi) { return f2bf(lo) | (f2bf(hi) << 16); }
__device__ __forceinline__ float rsum16(float v) { v += __shfl_xor(v, 1); v += __shfl_xor(v, 2); v += __shfl_xor(v, 4); v += __shfl_xor(v, 8); return v; }
__device__ __forceinline__ float wave_sum(float v) {
#pragma unroll
    for (int o = 1; o < 64; o <<= 1) v += __shfl_xor(v, o);
    return v;
}
__device__ __forceinline__ float sum16f(const float* p) { const f32x4 a = ((const f32x4*)p)[0], b = ((const f32x4*)p)[1], c = ((const f32x4*)p)[2], d = ((const f32x4*)p)[3];
    return ((a[0] + a[1]) + (a[2] + a[3])) + ((b[0] + b[1]) + (b[2] + b[3])) + ((c[0] + c[1]) + (c[2] + c[3])) + ((d[0] + d[1]) + (d[2] + d[3])); }
__device__ __forceinline__ float sum4f(const float* p) { const f32x4 a = *(const f32x4*)p; return (a[0] + a[1]) + (a[2] + a[3]); }
__device__ __forceinline__ float silu_mul(float g, float u) { return g / (1.0f + __expf(-g)) * u; }
__device__ __forceinline__ float log_sigmoid(float x) { return fminf(x, 0.f) - 0.6931471805599453f * __builtin_amdgcn_logf(1.0f + __builtin_amdgcn_exp2f(-LOG2E * fabsf(x))); }

__host__ __device__ __forceinline__ int gu_row_gate(int c) { return 256 * (c >> 7) + (c & 127); }
__host__ __device__ __forceinline__ int rope_slot(int dd) { return 8 * ((dd & 15) >> 2) + 4 * (dd >> 4) + (dd & 3); }
__host__ __device__ __forceinline__ int win_row(int s) {
    if (s < 256) return s;
    if (s < 384) return 256 + (s - 256);
    if (s < 416) return 256 + 128 + rope_slot(s - 384);
    if (s < 1952) { const int i = s - 416, which = i >> 9, head = (i & 511) >> 6, d = i & 63; return 256 * (2 + which * 2 + (head >> 2)) + 128 * (d >> 5) + 32 * (head & 3) + (d & 31); }
    return 256 + 160 + (s - 1952);
}
__host__ __device__ __forceinline__ int wuq_row(int s) { const int h = s / 96, d = s % 96;
    if (d < 64) return 256 * (h >> 2) + 128 * (d >> 5) + 32 * (h & 3) + (d & 31);
    return 512 + 128 * (h & 1) + 32 * (h >> 1) + rope_slot(d - 64); }
__host__ __device__ __forceinline__ int wukv_row(int s) { const int h = s >> 7, d = s & 127;
    if (d < 64) return 256 * (h >> 2) + 128 * (d >> 5) + 32 * (h & 3) + (d & 31);
    const int e = d - 64; return 256 * (2 + (h >> 2)) + 128 * (e >> 5) + 32 * (h & 3) + (e & 31); }

struct KArgs { const float* in[22]; float* out; unsigned char* ws; };
struct RowSet {
    int nrows, meta;
    const bf16_t* XN1; const float* base1; bf16_t* HB; float* H; bf16_t* XN; float* SSQ1;
    bf16_t* CQ; float* SSQCQ; bf16_t* CKV; float* SSQCKV; float* KPE; float* SSQKPE; float* LOGF; float* SSQQ;
};
struct Ctx {
    const float *x, *meta, *g_ffn1, *w1g, *w1u, *w1d, *g_mix, *w_in, *g_cq, *w_uq, *g_ckv, *w_ukv, *g_q_mla, *g_k_mla, *b_forget, *g_q_fox, *g_k_fox, *w_out, *g_ffn2, *w2g, *w2u, *w2d;
    float* out; unsigned char* ws;
    bf16_t *W1GU, *W1D, *W2GU, *W2D, *WIN, *WOUT, *WUQ, *WUKV; float* ROPE;
    bf16_t *FQ, *FK, *FV, *QM, *KM, *VM, *O; float* CUM; float* SSQ2; bf16_t *MFK, *MFV;
    RowSet main, mt;
};
__device__ __forceinline__ Ctx make_ctx(const KArgs& a) {
    Ctx c;
    c.x = a.in[0]; c.meta = a.in[1]; c.g_ffn1 = a.in[2]; c.w1g = a.in[3]; c.w1u = a.in[4]; c.w1d = a.in[5]; c.g_mix = a.in[6]; c.w_in = a.in[7]; c.g_cq = a.in[8]; c.w_uq = a.in[9]; c.g_ckv = a.in[10];
    c.w_ukv = a.in[11]; c.g_q_mla = a.in[12]; c.g_k_mla = a.in[13]; c.b_forget = a.in[14]; c.g_q_fox = a.in[15]; c.g_k_fox = a.in[16]; c.w_out = a.in[17]; c.g_ffn2 = a.in[18]; c.w2g = a.in[19]; c.w2u = a.in[20]; c.w2d = a.in[21];
    c.out = a.out; c.ws = a.ws; unsigned char* ws = a.ws;
    c.W1GU = (bf16_t*)(ws + WS_W1GU); c.W1D = (bf16_t*)(ws + WS_W1D); c.W2GU = (bf16_t*)(ws + WS_W2GU); c.W2D = (bf16_t*)(ws + WS_W2D); c.WIN = (bf16_t*)(ws + WS_WIN); c.WOUT = (bf16_t*)(ws + WS_WOUT);
    c.WUQ = (bf16_t*)(ws + WS_WUQ); c.WUKV = (bf16_t*)(ws + WS_WUKV); c.ROPE = (float*)(ws + WS_ROPE);
    c.FQ = (bf16_t*)(ws + WS_FQ); c.FK = (bf16_t*)(ws + WS_FK); c.FV = (bf16_t*)(ws + WS_FV); c.QM = (bf16_t*)(ws + WS_QM); c.KM = (bf16_t*)(ws + WS_KM); c.VM = (bf16_t*)(ws + WS_VM); c.O = (bf16_t*)(ws + WS_O);
    c.CUM = (float*)(ws + WS_CUM); c.SSQ2 = (float*)(ws + WS_SSQ2);
    RowSet& m = c.main; m.nrows = M; m.meta = 0; m.XN1 = (bf16_t*)(ws + WS_XN); m.base1 = c.x; m.HB = (bf16_t*)(ws + WS_HB); m.H = a.out; m.XN = (bf16_t*)(ws + WS_XN); m.SSQ1 = (float*)(ws + WS_SSQ1);
    m.CQ = (bf16_t*)(ws + WS_CQ); m.SSQCQ = (float*)(ws + WS_SSQCQ); m.CKV = (bf16_t*)(ws + WS_CKV); m.SSQCKV = (float*)(ws + WS_SSQCKV); m.KPE = (float*)(ws + WS_KPE); m.SSQKPE = (float*)(ws + WS_SSQKPE);
    m.LOGF = (float*)(ws + WS_LOGF); m.SSQQ = (float*)(ws + WS_SSQQ);
    unsigned char* mw = ws + WS_META; RowSet& t = c.mt; t.nrows = NMETA; t.meta = 1; t.XN1 = (bf16_t*)(mw + MO_XNM); t.base1 = c.meta; t.HB = (bf16_t*)(mw + MO_HB); t.H = (float*)(mw + MO_H); t.XN = (bf16_t*)(mw + MO_XN);
    t.SSQ1 = (float*)(mw + MO_SSQ1); t.CQ = (bf16_t*)(mw + MO_CQ); t.SSQCQ = (float*)(mw + MO_SSQCQ); t.CKV = (bf16_t*)(mw + MO_CKV); t.SSQCKV = (float*)(mw + MO_SSQCKV); t.KPE = (float*)(mw + MO_KPE);
    t.SSQKPE = (float*)(mw + MO_SSQKPE); t.LOGF = (float*)(mw + MO_LOGF); t.SSQQ = (float*)(mw + MO_SSQQ);
    c.MFK = (bf16_t*)(mw + MO_FKS); c.MFV = (bf16_t*)(mw + MO_FVS);
    return c;
}
__device__ __forceinline__ size_t arow(int b, int h, int p) { return (size_t)((b * 8 + h) * PR + p); }
__device__ __forceinline__ size_t kaddr(int b, int h, int p, int d, int DK) { return ((size_t)((b * 8 + h) * PR + (p & ~63))) * DK + (size_t)((d >> 3) * 512 + (p & 63) * 8 + (d & 7)); }
__device__ __forceinline__ size_t vaddr(int b, int h, int p, int d) { return ((size_t)((b * 8 + h) * PR + (p & ~63))) * 64 + (size_t)((d >> 5) * 2048 + (p & 63) * 32 + (d & 31)); }

constexpr int TSCR = 32 * 68;
__device__ __forceinline__ void st_wt(bf16_t* p, bf16_t v) { __hip_atomic_store(p, v, __ATOMIC_RELAXED, __HIP_MEMORY_SCOPE_AGENT); }
__device__ __forceinline__ void st_wt(float* p, float v) { __hip_atomic_store(p, v, __ATOMIC_RELAXED, __HIP_MEMORY_SCOPE_AGENT); }
template <class MapF>
__device__ __forceinline__ void p0_transpose_item(const float* W, int K, int N, const float* gain, bf16_t* WT, MapF map, float* scr_, int item, int lane) {
    asm volatile("" : "+v"(lane));
    unsigned* scr = (unsigned*)scr_;
    const int nblk = (N + 63) / 64, kb = item / nblk, nb = item % nblk, k0 = 64 * kb, n0 = 64 * nb;
    const int x = lane & 15, kr = lane >> 4, nq = n0 + 4 * x;
    f32x4 e[8], o[8];
#pragma unroll
    for (int j = 0; j < 8; ++j) { const int k = k0 + 8 * j + 2 * kr;
        if (nq < N) { e[j] = *(const f32x4*)(W + (size_t)k * N + nq); o[j] = *(const f32x4*)(W + (size_t)(k + 1) * N + nq); } else { e[j] = (f32x4){0.f, 0.f, 0.f, 0.f}; o[j] = e[j]; } }
#pragma unroll
    for (int j = 0; j < 8; ++j) { const int k = k0 + 8 * j + 2 * kr; float ge = 1.f, go = 1.f; if (gain) { ge = gain[k]; go = gain[k + 1]; }
        u32x4 p; p.x = pk2(e[j].x * ge, o[j].x * go); p.y = pk2(e[j].y * ge, o[j].y * go); p.z = pk2(e[j].z * ge, o[j].z * go); p.w = pk2(e[j].w * ge, o[j].w * go);
        *(u32x4*)(scr + (4 * j + kr) * 68 + 4 * x) = p; }
    asm volatile("s_waitcnt vmcnt(0) lgkmcnt(0)" ::: "memory");
    const int c = lane >> 3;
#pragma unroll
    for (int j = 0; j < 8; ++j) { const int n = (lane & 7) + 8 * j; if (n0 + n < N) { const unsigned* t = scr + (4 * c) * 68 + n;
        const u32x4 v = {t[0], t[68], t[136], t[204]};
        *(u32x4*)(WT + (size_t)map(n0 + n) * K + k0 + 8 * c) = v; } }
    asm volatile("s_waitcnt vmcnt(0) lgkmcnt(0)" ::: "memory");
}
struct MapId { __device__ int operator()(int n) const { return n; } };
struct MapGate { __device__ int operator()(int n) const { return gu_row_gate(n); } };
struct MapUp { __device__ int operator()(int n) const { return gu_row_gate(n) + 128; } };
struct MapWin { __device__ int operator()(int n) const { return win_row(n); } };
struct MapWuq { __device__ int operator()(int n) const { return wuq_row(n); } };
struct MapWukv { __device__ int operator()(int n) const { return wukv_row(n); } };

__device__ __constant__ double INV_FREQ[16] = {1.0, 0.5623413251903491, 0.31622776601683794, 0.1778279410038923, 0.1, 0.05623413251903491, 0.03162277660168379, 0.01778279410038923,
                                               0.01, 0.005623413251903491, 0.0031622776601683794, 0.0017782794100389228, 0.001, 0.0005623413251903491, 0.00031622776601683794, 0.00017782794100389227};
__device__ __forceinline__ void sincos_d(double x, float& s, float& c) {
    const double k = rint(x * 0.15915494309189535); const double r = fma(-k, 6.283185307179586, x) - k * 2.4492935982947064e-16; const double r2 = r * r;
    double ss = 1.0 / 15511210043330985984000000.0, cc = 1.0 / 620448401733239439360000.0;
    const double sf[12] = {1.0 / 25852016738884976640000.0, 1.0 / 51090942171709440000.0, 1.0 / 121645100408832000.0, 1.0 / 355687428096000.0, 1.0 / 1307674368000.0, 1.0 / 6227020800.0, 1.0 / 39916800.0,
                           1.0 / 362880.0, 1.0 / 5040.0, 1.0 / 120.0, 1.0 / 6.0, 1.0};
    const double cf[12] = {1.0 / 1124000727777607680000.0, 1.0 / 2432902008176640000.0, 1.0 / 6402373705728000.0, 1.0 / 20922789888000.0, 1.0 / 87178291200.0, 1.0 / 479001600.0, 1.0 / 3628800.0,
                           1.0 / 40320.0, 1.0 / 720.0, 1.0 / 24.0, 1.0 / 2.0, 1.0};
#pragma unroll
    for (int i = 0; i < 12; ++i) { ss = fma(-ss, r2, sf[i]); cc = fma(-cc, r2, cf[i]); }
    s = (float)(ss * r); c = (float)cc;
}
__device__ __forceinline__ void rms_row_to_bf16(const float* xrow, bf16_t* orow, int lane) {
    const f32x4* xr = (const f32x4*)xrow + lane; f32x4 v[4]; float s = 0.f;
#pragma unroll
    for (int j = 0; j < 4; ++j) { v[j] = xr[64 * j]; s += (v[j].x * v[j].x + v[j].y * v[j].y) + (v[j].z * v[j].z + v[j].w * v[j].w); }
    const float rstd = 1.0f / sqrtf(wave_sum(s) * (1.f / D) + EPS);
    unsigned long long* o8 = (unsigned long long*)orow + lane;
#pragma unroll
    for (int j = 0; j < 4; ++j) o8[64 * j] = (unsigned long long)pk2(v[j].x * rstd, v[j].y * rstd) | ((unsigned long long)pk2(v[j].z * rstd, v[j].w * rstd) << 32);
}
__device__ __forceinline__ void rms_row2_to_bf16(const float* x0, const float* x1, bf16_t* o0, bf16_t* o1, int lane) {
    const f32x4* xa = (const f32x4*)x0 + lane; const f32x4* xb = (const f32x4*)x1 + lane; f32x4 va[4], vb[4]; float sa = 0.f, sb = 0.f;
#pragma unroll
    for (int j = 0; j < 4; ++j) { va[j] = xa[64 * j]; vb[j] = xb[64 * j]; }
#pragma unroll
    for (int j = 0; j < 4; ++j) { sa += (va[j].x * va[j].x + va[j].y * va[j].y) + (va[j].z * va[j].z + va[j].w * va[j].w); sb += (vb[j].x * vb[j].x + vb[j].y * vb[j].y) + (vb[j].z * vb[j].z + vb[j].w * vb[j].w); }
    const float ra = 1.0f / sqrtf(wave_sum(sa) * (1.f / D) + EPS), rb = 1.0f / sqrtf(wave_sum(sb) * (1.f / D) + EPS);
    unsigned long long* pa = (unsigned long long*)o0 + lane; unsigned long long* pb = (unsigned long long*)o1 + lane;
#pragma unroll
    for (int j = 0; j < 4; ++j) { pa[64 * j] = (unsigned long long)pk2(va[j].x * ra, va[j].y * ra) | ((unsigned long long)pk2(va[j].z * ra, va[j].w * ra) << 32);
                                  pb[64 * j] = (unsigned long long)pk2(vb[j].x * rb, vb[j].y * rb) | ((unsigned long long)pk2(vb[j].z * rb, vb[j].w * rb) << 32); }
}
constexpr int I_GU = (D / 64) * (FF / 64), I_DN = (FF / 64) * (D / 64), I_IN = (D / 64) * ((1960 + 63) / 64), I_OUT = (D / 64) * (D / 64), I_UQ = (256 / 64) * (768 / 64), I_UKV = (128 / 64) * (1024 / 64);
__device__ __forceinline__ void p0_prologue(const Ctx& C, float* scr, int gw, int gwi, int NGW, int lane) {
    for (int it = gwi; it < 2 * I_GU + I_DN + I_IN; it += NGW) {
        int r = it;
        if (r < I_GU) { p0_transpose_item(C.w1g, D, FF, C.g_ffn1, C.W1GU, MapGate(), scr, r, lane); continue; } r -= I_GU;
        if (r < I_GU) { p0_transpose_item(C.w1u, D, FF, C.g_ffn1, C.W1GU, MapUp(), scr, r, lane); continue; } r -= I_GU;
        if (r < I_DN) { p0_transpose_item(C.w1d, FF, D, nullptr, C.W1D, MapId(), scr, r, lane); continue; } r -= I_DN;
        p0_transpose_item(C.w_in, D, 1960, C.g_mix, C.WIN, MapWin(), scr, r, lane);
    }
    for (int i = gw * 64 + lane; i < 88 * 128; i += NGW * 64) { const int row = 256 + 168 + i / 128, ch = i % 128; *(u32x4*)(C.WIN + (size_t)row * D + ch * 8) = (u32x4){0u, 0u, 0u, 0u}; }
    for (int m = gw; m < M / 2; m += NGW) rms_row2_to_bf16(C.x + (size_t)m * D, C.x + (size_t)(m + M / 2) * D, (bf16_t*)C.main.XN1 + (size_t)m * D, (bf16_t*)C.main.XN1 + (size_t)(m + M / 2) * D, lane);
    for (int m = gw; m < NMETA; m += NGW) rms_row_to_bf16(C.meta + (size_t)m * D, (bf16_t*)C.mt.XN1 + (size_t)m * D, lane);
    for (int i = gw * 64 + lane; i < NPOS * 16; i += NGW * 64) { const int pos = i >> 4, f = i & 15; float s, c; sincos_d((double)pos * INV_FREQ[f], s, c); C.ROPE[2 * i] = c; C.ROPE[2 * i + 1] = s; }
}
template <int PART> __device__ __forceinline__ void p0_late(const Ctx& C, float* scr, int gw, int NGW, int lane) {
    if (PART == 0) {
        for (int it = gw; it < I_OUT + I_UQ + I_UKV; it += NGW) {
            int r = it;
            if (r < I_OUT) { p0_transpose_item(C.w_out, D, D, nullptr, C.WOUT, MapId(), scr, r, lane); continue; } r -= I_OUT;
            if (r < I_UQ) { p0_transpose_item(C.w_uq, 256, 768, C.g_cq, C.WUQ, MapWuq(), scr, r, lane); continue; } r -= I_UQ;
            p0_transpose_item(C.w_ukv, 128, 1024, C.g_ckv, C.WUKV, MapWukv(), scr, r, lane);
        }
    } else {
        for (int it = gw; it < 2 * I_GU + I_DN; it += NGW) {
            int r = it;
            if (r < I_GU) { p0_transpose_item(C.w2g, D, FF, C.g_ffn2, C.W2GU, MapGate(), scr, r, lane); continue; } r -= I_GU;
            if (r < I_GU) { p0_transpose_item(C.w2u, D, FF, C.g_ffn2, C.W2GU, MapUp(), scr, r, lane); continue; } r -= I_GU;
            p0_transpose_item(C.w2d, FF, D, nullptr, C.W2D, MapId(), scr, r, lane);
        }
    }
}

template <int NT, int UNR>
__device__ __forceinline__ void wg_gemm16_steps(const bf16_t* ap, const bf16_t* const (&bp)[NT], int k0, f32x4 (&acc)[NT]) {
    bf16x8 a[UNR], b[UNR][NT];
#pragma unroll
    for (int u = 0; u < UNR; ++u) { a[u] = *(const bf16x8*)(ap + k0 + 32 * u);
#pragma unroll
        for (int t = 0; t < NT; ++t) b[u][t] = *(const bf16x8*)(bp[t] + k0 + 32 * u); }
#pragma unroll
    for (int u = 0; u < UNR; ++u)
#pragma unroll
        for (int t = 0; t < NT; ++t) acc[t] = __builtin_amdgcn_mfma_f32_16x16x32_bf16(a[u], b[u][t], acc[t], 0, 0, 0);
}
template <int NT, int NSPLIT, int UNR>
__device__ __forceinline__ void wg_gemm16(const bf16_t* ap, const bf16_t* const (&bp)[NT], int K, f32x4 (&acc)[NT], int wave, int lane, float* red) {
    const int ksl = K / NSPLIT, kb = wave * ksl, ke = kb + ksl;
    if (wave < NSPLIT) {
        int k0 = kb;
        for (; k0 + 32 * UNR <= ke; k0 += 32 * UNR) wg_gemm16_steps<NT, UNR>(ap, bp, k0, acc);
        { const int r = (ke - k0) >> 5;
          if (UNR > 3 && r == 3) wg_gemm16_steps<NT, 3>(ap, bp, k0, acc); else if (UNR > 2 && r == 2) wg_gemm16_steps<NT, 2>(ap, bp, k0, acc); else for (; k0 < ke; k0 += 32) wg_gemm16_steps<NT, 1>(ap, bp, k0, acc); }
#pragma unroll
        for (int t = 0; t < NT; ++t) *(f32x4*)(red + (size_t)((wave * NT + t) * 64 + lane) * 4) = acc[t];
    }
    __syncthreads();
    if (wave == 0) {
#pragma unroll
        for (int t = 0; t < NT; ++t) { f32x4 sum = *(const f32x4*)(red + (size_t)(t * 64 + lane) * 4);
#pragma unroll
            for (int w = 1; w < NSPLIT; ++w) sum += *(const f32x4*)(red + (size_t)((w * NT + t) * 64 + lane) * 4);
            acc[t] = sum; asm volatile("" ::: "memory"); }
    }
}
__device__ __forceinline__ void task_gateup(const bf16_t* A, const bf16_t* Wgu, const float* ssq, bf16_t* HB, int task, int lane, int wave, float* red) {
    asm volatile("" : "+v"(lane));
    const int ncb = FF / 16, rg = task / ncb, cb = task % ncb, c = lane & 15, q = lane >> 4, hc = cb * 16 + c;
    const bf16_t* ap = A + (size_t)(rg * 16 + c) * D + 8 * q;
    const bf16_t* g0 = Wgu + (size_t)gu_row_gate(hc) * D + 8 * q;
    const bf16_t* const bp[2] = {g0, g0 + (size_t)128 * D};
    f32x4 acc[2]; acc[0] = (f32x4){0.f, 0.f, 0.f, 0.f}; acc[1] = acc[0];
    wg_gemm16<2, 8, 4>(ap, bp, D, acc, wave, lane, red); if (wave != 0) return;
#pragma unroll
    for (int i = 0; i < 4; ++i) { const int row = rg * 16 + 4 * q + i; const float rs = ssq ? 1.0f / sqrtf(sum16f(ssq + (size_t)row * 16) * (1.f / D) + EPS) : 1.f;
        st_wt(HB + (size_t)row * FF + hc, (bf16_t)f2bf(silu_mul(acc[0][i] * rs, acc[1][i] * rs))); }
}
__device__ __forceinline__ void task_down(const bf16_t* A, int K, const bf16_t* Wt, const float* base, float* out, float scale, bf16_t* XN, float* SSQ, int task, int lane, int wave, float* red) {
    asm volatile("" : "+v"(lane));
    const int rg = task >> 4, cb = task & 15, c = lane & 15, q = lane >> 4;
    const bf16_t* ap = A + (size_t)(rg * 16 + c) * K + 8 * q;
    const bf16_t* b0 = Wt + (size_t)(cb * 64 + c) * K + 8 * q;
    const bf16_t* const bp[4] = {b0, b0 + (size_t)16 * K, b0 + (size_t)32 * K, b0 + (size_t)48 * K};
    f32x4 acc[4];
#pragma unroll
    for (int t = 0; t < 4; ++t) acc[t] = (f32x4){0.f, 0.f, 0.f, 0.f};
    wg_gemm16<4, 8, 4>(ap, bp, K, acc, wave, lane, red); if (wave != 0) return;
#pragma unroll
    for (int i = 0; i < 4; ++i) { const int row = rg * 16 + 4 * q + i; float sq = 0.f;
#pragma unroll
        for (int t = 0; t < 4; ++t) { const size_t o = (size_t)row * D + cb * 64 + t * 16 + c; const float v = base[o] + scale * acc[t][i]; st_wt(out + o, v); if (XN) st_wt(XN + o, (bf16_t)f2bf(v)); sq += v * v; }
        sq = rsum16(sq); if (SSQ && c == 0) st_wt(SSQ + (size_t)row * 16 + cb, sq); }
}
__device__ __forceinline__ void task_win(const Ctx& C, const RowSet& R, int rg, int job, int lane, int wave, float* red) {
    asm volatile("" : "+v"(lane));
    const int c = lane & 15, q = lane >> 4;
    const bf16_t* ap = R.XN + (size_t)(rg * 16 + c) * D + 8 * q;
    if (job == 0) {
        const bf16_t* bp[8];
#pragma unroll
        for (int t = 0; t < 8; ++t) bp[t] = C.WIN + (size_t)win_row(256 + 16 * t + c) * D + 8 * q;
        f32x4 acc[8];
#pragma unroll
        for (int t = 0; t < 8; ++t) acc[t] = (f32x4){0.f, 0.f, 0.f, 0.f};
        wg_gemm16<8, 8, 2>(ap, bp, D, acc, wave, lane, red); if (wave != 0) return;
#pragma unroll
        for (int i = 0; i < 4; ++i) { const int row = rg * 16 + 4 * q + i; const float rs = 1.0f / sqrtf(sum16f(R.SSQ1 + (size_t)row * 16) * (1.f / D) + EPS); float sq = 0.f;
#pragma unroll
            for (int t = 0; t < 8; ++t) { const float v = acc[t][i] * rs; sq += v * v; R.CKV[(size_t)row * 128 + 16 * t + c] = (bf16_t)f2bf(v); }
            sq = rsum16(sq); if (c == 0) *(f32x4*)(R.SSQCKV + (size_t)row * 4) = (f32x4){sq, 0.f, 0.f, 0.f}; }
    } else if (job == 1) {
        const bf16_t* bp[3];
#pragma unroll
        for (int t = 0; t < 2; ++t) bp[t] = C.WIN + (size_t)win_row(384 + 16 * t + c) * D + 8 * q;
        bp[2] = C.WIN + (size_t)(c < 8 ? win_row(1952 + c) : 256 + 168 + c) * D + 8 * q;
        f32x4 acc[3];
#pragma unroll
        for (int t = 0; t < 3; ++t) acc[t] = (f32x4){0.f, 0.f, 0.f, 0.f};
        wg_gemm16<3, 8, 4>(ap, bp, D, acc, wave, lane, red); if (wave != 0) return;
#pragma unroll
        for (int i = 0; i < 4; ++i) { const int row = rg * 16 + 4 * q + i; const float rs = 1.0f / sqrtf(sum16f(R.SSQ1 + (size_t)row * 16) * (1.f / D) + EPS); float sp = 0.f;
#pragma unroll
            for (int t = 0; t < 2; ++t) { const float v = acc[t][i] * rs; sp += v * v; R.KPE[(size_t)row * 32 + 16 * t + c] = v; }
            sp = rsum16(sp); if (c == 0) R.SSQKPE[row] = sp;
            if (c < 8) R.LOGF[(size_t)row * 8 + c] = log_sigmoid(acc[2][i] * rs + C.b_forget[c]); }
    } else {
        const int which = 1 + ((job - 2) >> 3), h = (job - 2) & 7;
        const bf16_t* bp[4];
#pragma unroll
        for (int t = 0; t < 4; ++t) bp[t] = C.WIN + (size_t)win_row(416 + which * 512 + h * 64 + 16 * t + c) * D + 8 * q;
        f32x4 acc[4];
#pragma unroll
        for (int t = 0; t < 4; ++t) acc[t] = (f32x4){0.f, 0.f, 0.f, 0.f};
        wg_gemm16<4, 8, 4>(ap, bp, D, acc, wave, lane, red); if (wave != 0) return;
#pragma unroll
        for (int i = 0; i < 4; ++i) { const int row = rg * 16 + 4 * q + i; const float rs = 1.0f / sqrtf(sum16f(R.SSQ1 + (size_t)row * 16) * (1.f / D) + EPS); float sq = 0.f; float v[4];
#pragma unroll
            for (int t = 0; t < 4; ++t) { v[t] = acc[t][i] * rs; sq += v[t] * v[t]; }
            sq = rsum16(sq); const float r = 1.0f / sqrtf(sq * (1.f / 64.f) + EPS);
#pragma unroll
            for (int t = 0; t < 4; ++t) { const int d = 16 * t + c;
                if (which == 1) C.MFK[(row * 8 + h) * 64 + d] = (bf16_t)f2bf(v[t] * r * C.g_k_fox[d]);
                else C.MFV[(row * 8 + h) * 64 + d] = (bf16_t)f2bf(v[t]); } }
    }
}
__device__ __forceinline__ void task_uqkv(const Ctx& C, const RowSet& R, int task, int lane, int wave, float* red) {
    asm volatile("" : "+v"(lane));
    const int rg = task >> 4, job = task & 15, h = job & 7, c = lane & 15, q = lane >> 4;
    int rows[4];
#pragma unroll
    for (int i = 0; i < 4; ++i) rows[i] = rg * 16 + 4 * q + i;
    {
        const bf16_t* ap = R.CKV + (size_t)(rg * 16 + c) * 128 + 8 * q;
        const bf16_t* bp[8];
#pragma unroll
        for (int t = 0; t < 8; ++t) bp[t] = C.WUKV + (size_t)wukv_row(h * 128 + 16 * t + c) * 128 + 8 * q;
        f32x4 acc[8];
#pragma unroll
        for (int t = 0; t < 8; ++t) acc[t] = (f32x4){0.f, 0.f, 0.f, 0.f};
        wg_gemm16<8, 4, 1>(ap, bp, 128, acc, wave, lane, red); if (wave != 0) return;
#pragma unroll
        for (int i = 0; i < 4; ++i) { const int row = rows[i]; const float rs = 1.0f / sqrtf(sum4f(R.SSQCKV + (size_t)row * 4) * (1.f / 128.f) + EPS);
            float v[8], s0 = 0.f;
#pragma unroll
            for (int t = 0; t < 8; ++t) { v[t] = acc[t][i] * rs; if (t < 4) s0 += v[t] * v[t]; }
            s0 = rsum16(s0); const float rk = 1.0f / sqrtf((s0 + R.SSQKPE[row]) * (1.f / 96.f) + EPS);
            const int p = R.meta ? 48 + row : 64 + (row & (T - 1)); const int b0 = R.meta ? 0 : row >> 13, b1 = R.meta ? 2 : b0 + 1;
            const float cs = C.ROPE[(size_t)(p - 48) * 32 + 2 * c], sn = C.ROPE[(size_t)(p - 48) * 32 + 2 * c + 1];
            const float x1 = R.KPE[(size_t)row * 32 + c] * rk * C.g_k_mla[64 + c], x2 = R.KPE[(size_t)row * 32 + 16 + c] * rk * C.g_k_mla[80 + c];
            for (int b = b0; b < b1; ++b) {
#pragma unroll
                for (int t = 0; t < 4; ++t) { C.KM[kaddr(b, h, p, 16 * t + c, DQM)] = (bf16_t)f2bf(v[t] * rk * C.g_k_mla[16 * t + c]); C.VM[vaddr(b, h, p, 16 * t + c)] = (bf16_t)f2bf(v[4 + t]); }
                C.KM[kaddr(b, h, p, 64 + c, DQM)] = (bf16_t)f2bf(x1 * cs - x2 * sn); C.KM[kaddr(b, h, p, 80 + c, DQM)] = (bf16_t)f2bf(x2 * cs + x1 * sn); } }
    }
}


namespace pg8 {
#define PG8_LAS __attribute__((address_space(3)))
typedef unsigned short bf16_t;
typedef short bf16x8 __attribute__((ext_vector_type(8)));
typedef float f32x4 __attribute__((ext_vector_type(4)));
typedef unsigned u32x4 __attribute__((ext_vector_type(4)));
constexpr int BM = 256, BK = 64, HALF = 128, HTB = HALF * BK * 2  , STAGE_BYTES = 8 * HTB, NXCD = 8, WGM = 8;

__host__ __device__ __forceinline__ int lds_byte(int r, int c) { const int st = (r >> 4) * 2 + (c >> 5), rr = r & 15, cc = c & 31, ob = rr * 64 + cc * 2; return st * 1024 + (ob ^ (((ob >> 9) & 1) << 5)); }
__host__ __device__ __forceinline__ void stage_rc(int b, int& R, int& C) { const int st = b / 1024, sb = b % 1024, swz = sb ^ (((sb >> 9) & 1) << 5); R = (st >> 1) * 16 + swz / 64; C = (st & 1) * 32 + (swz % 64) / 2; }
__host__ __device__ __forceinline__ int perm32(int rho) { const int n = rho >> 4, i = rho & 15; return 8 * (i >> 2) + 4 * n + (i & 3); }

struct Unit { int pm, pn, idx; };
struct Gemm { const bf16_t* A; const bf16_t* Bt; int M, N, K, lda; };

struct StaticOrder {
    int nM, nN, nwg, G, c;
    __host__ __device__ void init(int M, int N, int G_, int c_) { nM = M / BM; nN = N / BM; nwg = nM * nN; G = G_; c = c_; }
    __host__ __device__ bool next(int i, Unit& u) const {
        const long L = (long)i * G + c; if (L >= nwg) return false;
        int wgid = (int)L; { const int q = nwg / NXCD, r = nwg % NXCD, xcd = wgid % NXCD, off = wgid / NXCD; wgid = (xcd < r ? xcd * (q + 1) : r * (q + 1) + (xcd - r) * q) + off; }
        const int nig = WGM * nN, gid = wgid / nig, fm = gid * WGM, gsz = (nM - fm) < WGM ? (nM - fm) : WGM;
        u.pm = fm + ((wgid % nig) % gsz); u.pn = (wgid % nig) / gsz; u.idx = i; return true;
    }
    __device__ __forceinline__ void a_ready(const Unit&) const {}
    __device__ __forceinline__ void done(const Unit&) const {}
};
__device__ __forceinline__ unsigned cvt_pk_bf16(float lo, float hi) { unsigned r; asm volatile("v_cvt_pk_bf16_f32 %0, %1, %2" : "=v"(r) : "v"(lo), "v"(hi)); return r; }
typedef float f32x2 __attribute__((ext_vector_type(2)));
template <class Epi, class Sched, bool ALIGN_EPI = false, bool SP2 = false>
__device__ __forceinline__ void gemm_phase(PG8_LAS unsigned char* lds, const Gemm g, const Sched& S, const Epi& E, const int tid) {
    const int wid = __builtin_amdgcn_readfirstlane(tid >> 6), lane = tid & 63, wr = wid >> 2, wc = wid & 3, fr = lane & 15, fq = lane >> 4;
    const int K = g.K, nt = K / BK;
    unsigned voffA[2], voffB[2];
#pragma unroll
    for (int i = 0; i < 2; ++i) { int R, C; stage_rc(tid * 16 + i * 8192, R, C); const int Rb = Epi::PERM ? ((R & ~31) + perm32(R & 31)) : R;
        voffA[i] = (unsigned)(R * g.lda + C) * 2u; voffB[i] = (unsigned)(Rb * K + C) * 2u; }
    const size_t kstep = (size_t)(BK * 2);
    const size_t hstep = (size_t)HALF * K * 2, hstepA = (size_t)HALF * g.lda * 2;
    const size_t tstep = 2 * hstep, tstepA = 2 * hstepA;
    const unsigned ldsw = (unsigned)wid * 1024u;
    const int aoff = lds_byte(wr * 64 + fr, fq * 8), boff = lds_byte(wc * 32 + fr, fq * 8);
#define PG8_SA(b, h) (((b) * 2 + (h)) * HTB)
#define PG8_SB(b, h) ((4 + (b) * 2 + (h)) * HTB)
#define PG8_STAGE(bufoff, gbase, voff) do { _Pragma("unroll") for (int _i = 0; _i < 2; ++_i) \
        __builtin_amdgcn_global_load_lds((const unsigned*)((const char*)(gbase) + (voff)[_i]), (PG8_LAS unsigned*)(lds + (bufoff) + ldsw + _i * 8192), 16, 0, 0); } while (0)
#define PG8_LDA(dst, b, h) do { _Pragma("unroll") for (int m = 0; m < 4; ++m) _Pragma("unroll") for (int k = 0; k < 2; ++k) dst[m][k] = *(const PG8_LAS bf16x8*)(lds + PG8_SA(b, h) + aoff + m * 2048 + k * 1024); } while (0)
#define PG8_LDB(dst, b, h) do { _Pragma("unroll") for (int n = 0; n < 2; ++n) _Pragma("unroll") for (int k = 0; k < 2; ++k) dst[n][k] = *(const PG8_LAS bf16x8*)(lds + PG8_SB(b, h) + boff + n * 2048 + k * 1024); } while (0)
#define PG8_MMA(ai, bj, At, Bt) do { __builtin_amdgcn_s_setprio(1); _Pragma("unroll") for (int m = 0; m < 4; ++m) _Pragma("unroll") for (int n = 0; n < 2; ++n) _Pragma("unroll") for (int k = 0; k < 2; ++k) \
        acc[ai][bj][m][n] = __builtin_amdgcn_mfma_f32_16x16x32_bf16(Bt[n][k], At[m][k], acc[ai][bj][m][n], 0, 0, 0); __builtin_amdgcn_s_setprio(0); } while (0)
#define PG8_WAIT_V(n) asm volatile("s_waitcnt vmcnt(" #n ")" ::: "memory")
#define PG8_WAIT_L(n) asm volatile("s_waitcnt lgkmcnt(" #n ")" ::: "memory")
#define PG8_BAR __builtin_amdgcn_s_barrier()
#define PG8_SCHED __builtin_amdgcn_sched_barrier(0)
    Unit cur, nxt; int ui = 0;
    if (!S.next(0, cur)) return;
    f32x4 acc[2][2][4][2];
#pragma unroll
    for (int a = 0; a < 2; ++a)
#pragma unroll
        for (int b = 0; b < 2; ++b)
#pragma unroll
            for (int m = 0; m < 4; ++m)
#pragma unroll
                for (int n = 0; n < 2; ++n) acc[a][b][m][n] = (f32x4){0.f, 0.f, 0.f, 0.f};
    if constexpr (Epi::HAS_INIT) E.init(acc, cur, wr, wc, fr, fq);
    bf16x8 At[4][2], B0[2][2], B1[2][2];
    const char* cA = (const char*)g.A + (size_t)cur.pm * tstepA; const char* cB = (const char*)g.Bt + (size_t)cur.pn * tstep;
    S.a_ready(cur);
    if constexpr (SP2) {
        PG8_STAGE(PG8_SB(0, 0), cB, voffB); PG8_STAGE(PG8_SB(0, 1), cB + hstep, voffB); PG8_STAGE(PG8_SA(0, 0), cA, voffA); PG8_STAGE(PG8_SA(0, 1), cA + hstepA, voffA);
        if (wr == 1) PG8_BAR;
        PG8_WAIT_V(2); PG8_BAR;
        PG8_STAGE(PG8_SB(1, 0), cB + kstep, voffB); PG8_STAGE(PG8_SA(1, 0), cA + kstep, voffA); PG8_STAGE(PG8_SB(1, 1), cB + hstep + kstep, voffB);
        PG8_WAIT_V(6); PG8_BAR;
    } else {
        PG8_STAGE(PG8_SB(0, 0), cB, voffB); PG8_STAGE(PG8_SA(0, 0), cA, voffA); PG8_STAGE(PG8_SB(0, 1), cB + hstep, voffB); PG8_STAGE(PG8_SA(0, 1), cA + hstepA, voffA);
        if (wr == 1) PG8_BAR;
        PG8_WAIT_V(4); PG8_BAR;
        PG8_STAGE(PG8_SB(1, 0), cB + kstep, voffB); PG8_STAGE(PG8_SA(1, 0), cA + kstep, voffA); PG8_STAGE(PG8_SB(1, 1), cB + hstep + kstep, voffB);
        PG8_WAIT_V(6); PG8_BAR;
    }
    for (;;) {
        const bool has_next = S.next(ui + 1, nxt);
        const char* nA = has_next ? (const char*)g.A + (size_t)nxt.pm * tstepA : cA; const char* nB = has_next ? (const char*)g.Bt + (size_t)nxt.pn * tstep : cB;
        for (int t = 0; t < nt; t += 2) {
            const bool last = (t == nt - 2);
            const char* a1 = cA + (size_t)(t + 1) * kstep;
            const char* a2 = last ? nA : cA + (size_t)(t + 2) * kstep; const char* b2 = last ? nB : cB + (size_t)(t + 2) * kstep;
            const char* a3 = a2 + kstep; const char* b3 = b2 + kstep;
            if (last && has_next) S.a_ready(nxt);
            if constexpr (SP2) {
            PG8_LDB(B0, 0, 0); PG8_LDB(B1, 0, 1); PG8_SCHED; PG8_LDA(At, 0, 0); PG8_STAGE(PG8_SA(1, 1), a1 + hstepA, voffA);
            PG8_WAIT_V(8); PG8_WAIT_L(0); PG8_BAR; PG8_MMA(0, 0, At, B0); PG8_MMA(0, 1, At, B1); PG8_BAR; PG8_SCHED;
            PG8_LDA(At, 0, 1); PG8_STAGE(PG8_SB(0, 0), b2, voffB); PG8_STAGE(PG8_SB(0, 1), b2 + hstep, voffB); PG8_STAGE(PG8_SA(0, 0), a2, voffA);
            PG8_WAIT_V(8); PG8_WAIT_L(0); PG8_BAR; PG8_MMA(1, 0, At, B0); PG8_MMA(1, 1, At, B1); PG8_BAR; PG8_SCHED;
            PG8_LDB(B0, 1, 0); PG8_LDB(B1, 1, 1); PG8_SCHED; PG8_LDA(At, 1, 0); PG8_STAGE(PG8_SA(0, 1), a2 + hstepA, voffA);
            PG8_WAIT_V(8); PG8_WAIT_L(0); PG8_BAR; PG8_MMA(0, 0, At, B0); PG8_MMA(0, 1, At, B1); PG8_BAR; PG8_SCHED;
            PG8_LDA(At, 1, 1); PG8_STAGE(PG8_SB(1, 0), b3, voffB); PG8_STAGE(PG8_SB(1, 1), b3 + hstep, voffB); PG8_STAGE(PG8_SA(1, 0), a3, voffA);
            PG8_WAIT_V(8); PG8_WAIT_L(0); PG8_BAR; PG8_MMA(1, 0, At, B0); PG8_MMA(1, 1, At, B1); PG8_BAR; PG8_SCHED;
            } else {
            PG8_LDB(B0, 0, 0); PG8_SCHED; PG8_LDA(At, 0, 0); PG8_STAGE(PG8_SA(1, 1), a1 + hstepA, voffA);
            PG8_WAIT_L(8); PG8_BAR; PG8_WAIT_L(0); PG8_MMA(0, 0, At, B0); PG8_BAR; PG8_SCHED;
            PG8_LDB(B1, 0, 1); PG8_STAGE(PG8_SB(0, 0), b2, voffB);
            PG8_BAR; PG8_WAIT_L(0); PG8_MMA(0, 1, At, B1); PG8_BAR;
            PG8_LDA(At, 0, 1); PG8_STAGE(PG8_SA(0, 0), a2, voffA);
            PG8_BAR; PG8_WAIT_L(0); PG8_MMA(1, 0, At, B0); PG8_BAR; PG8_SCHED;
            PG8_STAGE(PG8_SB(0, 1), b2 + hstep, voffB);
            PG8_WAIT_V(6); PG8_BAR; PG8_MMA(1, 1, At, B1); PG8_BAR;
            PG8_LDB(B0, 1, 0); PG8_SCHED; PG8_LDA(At, 1, 0); PG8_STAGE(PG8_SA(0, 1), a2 + hstepA, voffA);
            PG8_WAIT_L(8); PG8_BAR; PG8_WAIT_L(0); PG8_MMA(0, 0, At, B0); PG8_BAR; PG8_SCHED;
            PG8_LDB(B1, 1, 1); PG8_STAGE(PG8_SB(1, 0), b3, voffB);
            PG8_BAR; PG8_WAIT_L(0); PG8_MMA(0, 1, At, B1); PG8_BAR;
            PG8_LDA(At, 1, 1); PG8_STAGE(PG8_SA(1, 0), a3, voffA);
            PG8_BAR; PG8_WAIT_L(0); PG8_MMA(1, 0, At, B0); PG8_BAR; PG8_SCHED;
            PG8_STAGE(PG8_SB(1, 1), b3 + hstep, voffB);
            PG8_WAIT_V(6); PG8_BAR; PG8_MMA(1, 1, At, B1); PG8_BAR;
            }
        }
        if constexpr (ALIGN_EPI) { if (wr == 0) PG8_BAR; }
        if constexpr (!Epi::AFTER_DRAIN) { E(acc, cur, wr, wc, fr, fq); S.done(cur); }
        if (!has_next) break;
#pragma unroll
        for (int a = 0; a < 2; ++a)
#pragma unroll
            for (int b = 0; b < 2; ++b)
#pragma unroll
                for (int m = 0; m < 4; ++m)
#pragma unroll
                    for (int n = 0; n < 2; ++n) acc[a][b][m][n] = (f32x4){0.f, 0.f, 0.f, 0.f};
        if constexpr (Epi::HAS_INIT) E.init(acc, nxt, wr, wc, fr, fq);
        cur = nxt; cA = nA; cB = nB; ++ui;
        if constexpr (ALIGN_EPI) { if (wr == 1) PG8_BAR; }
    }
    PG8_WAIT_V(0);
    if constexpr (!ALIGN_EPI) { if (wr == 0) PG8_BAR; }
    PG8_BAR;
    if constexpr (Epi::AFTER_DRAIN) { E.fused(acc, cur, wr, wc, fr, fq, lds, wid, lane); S.done(cur); }
#undef PG8_SA
#undef PG8_SB
#undef PG8_STAGE
#undef PG8_LDA
#undef PG8_LDB
#undef PG8_MMA
#undef PG8_WAIT_V
#undef PG8_WAIT_L
#undef PG8_BAR
#undef PG8_SCHED
}
}

namespace pg8 {
__device__ __forceinline__ float fq_sum(float v) { v += __shfl_xor(v, 16); v += __shfl_xor(v, 32); return v; }
__device__ __forceinline__ u32x4 pack8(const f32x4& a, const f32x4& b) { u32x4 w; w.x = cvt_pk_bf16(a[0], a[1]); w.y = cvt_pk_bf16(a[2], a[3]); w.z = cvt_pk_bf16(b[0], b[1]); w.w = cvt_pk_bf16(b[2], b[3]); return w; }
__device__ __forceinline__ f32x4 silu4(const f32x4& g, const f32x4& u) { f32x4 o;
#pragma unroll
    for (int j = 0; j < 4; ++j) o[j] = g[j] * __builtin_amdgcn_rcpf(1.0f + __builtin_amdgcn_exp2f(-LOG2E * g[j])) * u[j];
    return o; }

template <int NP> __device__ __forceinline__ void rs_rows(const float* ssq, int row0, int fq, float inv_n, float (&rs)[2][4]) {
    f32x4 t[2][4];
#pragma unroll
    for (int ai = 0; ai < 2; ++ai)
#pragma unroll
        for (int m = 0; m < 4; ++m) t[ai][m] = *(const f32x4*)(ssq + (size_t)(row0 + ai * HALF + m * 16) * NP + (NP == 16 ? 4 * fq : 0));
#pragma unroll
    for (int ai = 0; ai < 2; ++ai)
#pragma unroll
        for (int m = 0; m < 4; ++m) { float v = (t[ai][m][0] + t[ai][m][1]) + (t[ai][m][2] + t[ai][m][3]); if (NP == 16) v = fq_sum(v); rs[ai][m] = __builtin_amdgcn_rsqf(v * inv_n + EPS); }
}
struct EpiSwiglu {
    static constexpr bool PERM = true, AFTER_DRAIN = false, HAS_INIT = false;
    bf16_t* HB; const PG8_LAS float* rs_lds;
    __device__ __forceinline__ void operator()(const f32x4 (&acc)[2][2][4][2], const Unit& u, int wr, int wc, int fr, int fq) const {
        const int col0 = u.pn * 128 + wc * 32 + 8 * fq, row0 = u.pm * BM + wr * 64 + fr;
        float rs[2][4];
#pragma unroll
        for (int ai = 0; ai < 2; ++ai)
#pragma unroll
            for (int m = 0; m < 4; ++m) rs[ai][m] = rs_lds ? rs_lds[u.idx * BM + ai * HALF + wr * 64 + m * 16 + fr] : 1.f;
#pragma unroll
        for (int ai = 0; ai < 2; ++ai)
#pragma unroll
            for (int m = 0; m < 4; ++m) { const int row = row0 + ai * HALF + m * 16; const float r = rs[ai][m];
                const f32x4 h0 = silu4(acc[ai][0][m][0] * r, acc[ai][1][m][0] * r), h1 = silu4(acc[ai][0][m][1] * r, acc[ai][1][m][1] * r);
                *(u32x4*)(HB + (size_t)row * FF + col0) = pack8(h0, h1); }
    }
};
template <class Sched> __device__ __forceinline__ void rs_table_fill(const float* ssq, const Sched& S, PG8_LAS float* table, int tid) {
    Unit u; int n = 0; while (S.next(n, u)) ++n;
    for (int e = tid; e < n * BM; e += 512) { S.next(e >> 8, u); table[e] = 1.0f / sqrtf(sum16f(ssq + (size_t)(u.pm * BM + (e & 255)) * 16) * (1.f / D) + EPS); }
    __syncthreads();
}
template <int HALF_SCALE, int BASE_BF16> struct EpiResid {
    static constexpr bool PERM = true, AFTER_DRAIN = false, HAS_INIT = true;
    const void* base; float* out; bf16_t* XN; float* SSQ;
    __device__ __forceinline__ void init(f32x4 (&acc)[2][2][4][2], const Unit& u, int wr, int wc, int fr, int fq) const {
        const int col0 = u.pn * BM + wc * 32 + 8 * fq; const float inv = HALF_SCALE ? 2.0f : 1.0f;
#pragma unroll
        for (int ai = 0; ai < 2; ++ai)
#pragma unroll
            for (int m = 0; m < 4; ++m) { const int row = u.pm * BM + ai * HALF + wr * 64 + m * 16 + fr;
#pragma unroll
                for (int bj = 0; bj < 2; ++bj) { const size_t o = (size_t)row * D + col0 + bj * HALF;
                    if (BASE_BF16) { const u32x4 w = *(const u32x4*)((const bf16_t*)base + o);
                        acc[ai][bj][m][0] = (f32x4){__uint_as_float(w.x << 16), __uint_as_float(w.x & 0xffff0000u), __uint_as_float(w.y << 16), __uint_as_float(w.y & 0xffff0000u)} * inv;
                        acc[ai][bj][m][1] = (f32x4){__uint_as_float(w.z << 16), __uint_as_float(w.z & 0xffff0000u), __uint_as_float(w.w << 16), __uint_as_float(w.w & 0xffff0000u)} * inv; }
                    else { acc[ai][bj][m][0] = *(const f32x4*)((const float*)base + o) * inv; acc[ai][bj][m][1] = *(const f32x4*)((const float*)base + o + 4) * inv; } } }
    }
    __device__ __forceinline__ void operator()(const f32x4 (&acc)[2][2][4][2], const Unit& u, int wr, int wc, int fr, int fq) const {
        const int col0 = u.pn * BM + wc * 32 + 8 * fq; const float scale = HALF_SCALE ? 0.5f : 1.0f;
#pragma unroll
        for (int ai = 0; ai < 2; ++ai)
#pragma unroll
            for (int m = 0; m < 4; ++m) { const int row = u.pm * BM + ai * HALF + wr * 64 + m * 16 + fr; float sq = 0.f;
#pragma unroll
                for (int bj = 0; bj < 2; ++bj) { const size_t o = (size_t)row * D + col0 + bj * HALF;
                    const f32x4 v0 = acc[ai][bj][m][0] * scale, v1 = acc[ai][bj][m][1] * scale;
                    if (out) { *(f32x4*)(out + o) = v0; *(f32x4*)(out + o + 4) = v1; }
                    if (XN) *(u32x4*)(XN + o) = pack8(v0, v1);
                    sq += (v0[0] * v0[0] + v0[1] * v0[1]) + (v0[2] * v0[2] + v0[3] * v0[3]) + (v1[0] * v1[0] + v1[1] * v1[1]) + (v1[2] * v1[2] + v1[3] * v1[3]); }
                if (SSQ) { sq = fq_sum(sq); if (fq == 0) SSQ[(size_t)row * 16 + u.pn * 4 + wc] = sq; } }
    }
};
struct EpiWin {
    static constexpr bool PERM = true, AFTER_DRAIN = false, HAS_INIT = false;
    Ctx C; const PG8_LAS float* rs_lds; const PG8_LAS float* gt;
    __device__ __forceinline__ void operator()(const f32x4 (&acc)[2][2][4][2], const Unit& u, int wr, int wc, int fr, int fq) const {
        const RowSet& R = C.main; const int pn = u.pn;
        f32x4 bfg[2]; if (pn == 1) { bfg[0] = *(const f32x4*)(C.b_forget); bfg[1] = *(const f32x4*)(C.b_forget + 4); }
        float rsr[2][4];
#pragma unroll
        for (int ai = 0; ai < 2; ++ai)
#pragma unroll
            for (int m = 0; m < 4; ++m) rsr[ai][m] = rs_lds[u.idx * BM + ai * HALF + wr * 64 + m * 16 + fr];
#pragma unroll
        for (int ai = 0; ai < 2; ++ai)
#pragma unroll
            for (int m = 0; m < 4; ++m) { const int row = u.pm * BM + ai * HALF + wr * 64 + m * 16 + fr; const float rs = rsr[ai][m];
                f32x4 v[2][2];
#pragma unroll
                for (int bj = 0; bj < 2; ++bj)
#pragma unroll
                    for (int n = 0; n < 2; ++n) v[bj][n] = acc[ai][bj][m][n] * rs;
                float sq[2];
#pragma unroll
                for (int bj = 0; bj < 2; ++bj) sq[bj] = (v[bj][0][0] * v[bj][0][0] + v[bj][0][1] * v[bj][0][1]) + (v[bj][0][2] * v[bj][0][2] + v[bj][0][3] * v[bj][0][3]) +
                                                        (v[bj][1][0] * v[bj][1][0] + v[bj][1][1] * v[bj][1][1]) + (v[bj][1][2] * v[bj][1][2] + v[bj][1][3] * v[bj][1][3]);
                if (pn == 0) {
#pragma unroll
                    for (int bj = 0; bj < 2; ++bj) *(u32x4*)(R.CQ + (size_t)row * 256 + bj * HALF + wc * 32 + 8 * fq) = pack8(v[bj][0], v[bj][1]);
                    const float s = fq_sum(sq[0] + sq[1]); if (fq == 0) R.SSQCQ[(size_t)row * 4 + wc] = s;
                } else if (pn == 1) {
                    *(u32x4*)(R.CKV + (size_t)row * 128 + wc * 32 + 8 * fq) = pack8(v[0][0], v[0][1]);
                    const float s = fq_sum(sq[0]); if (fq == 0) R.SSQCKV[(size_t)row * 4 + wc] = s;
                    if (wc == 0) { *(f32x4*)(R.KPE + (size_t)row * 32 + 4 * fq) = v[1][0]; *(f32x4*)(R.KPE + (size_t)row * 32 + 16 + 4 * fq) = v[1][1];
                        const float sp = fq_sum(sq[1]); if (fq == 0) R.SSQKPE[row] = sp; }
                    if (wc == 1 && fq == 0) { f32x4 l0, l1;
#pragma unroll
                        for (int j = 0; j < 4; ++j) { l0[j] = log_sigmoid(v[1][0][j] + bfg[0][j]); l1[j] = log_sigmoid(v[1][1][j] + bfg[1][j]); }
                        *(f32x4*)(R.LOGF + (size_t)row * 8) = l0; *(f32x4*)(R.LOGF + (size_t)row * 8 + 4) = l1; }
                } else {
                    const int which = (pn - 2) >> 1, h = ((pn - 2) & 1) * 4 + wc; const int b = row >> 13, p = 64 + (row & (T - 1));
                    if (which < 2) { const float r = __builtin_amdgcn_rsqf(fq_sum(sq[0] + sq[1]) * (1.f / 64.f) + EPS) * (which == 0 ? C2F : 1.f); const PG8_LAS float* g = gt + (which == 0 ? 0 : 64);
#pragma unroll
                        for (int bj = 0; bj < 2; ++bj) { v[bj][0] = v[bj][0] * *(const PG8_LAS f32x4*)(g + 32 * bj + 8 * fq) * r; v[bj][1] = v[bj][1] * *(const PG8_LAS f32x4*)(g + 32 * bj + 8 * fq + 4) * r; } }
#pragma unroll
                    for (int bj = 0; bj < 2; ++bj) { bf16_t* dst = (which == 0) ? C.FQ + arow(b, h, p) * 64 + 32 * bj + 8 * fq : (which == 1) ? C.FK + kaddr(b, h, p, 32 * bj + 8 * fq, DFK) : C.FV + vaddr(b, h, p, 32 * bj + 8 * fq);
                        *(u32x4*)dst = pack8(v[bj][0], v[bj][1]); }
                }
                if (m & 1) asm volatile("" ::: "memory"); }
    }
};
struct EpiUq {
    static constexpr bool PERM = true, AFTER_DRAIN = false, HAS_INIT = false;
    const PG8_LAS float* g_q_mla; const float* SSQCQ; float* SSQQ; bf16_t* QM; const float* ROPE;
    __device__ __forceinline__ void operator()(const f32x4 (&acc)[2][2][4][2], const Unit& u, int wr, int wc, int fr, int fq) const {
        const int pn = u.pn;
        float rsr[2][4]; rs_rows<4>(SSQCQ, u.pm * BM + wr * 64 + fr, fq, 1.f / 256.f, rsr);
#pragma unroll
        for (int ai = 0; ai < 2; ++ai)
#pragma unroll
            for (int m = 0; m < 4; ++m) { const int row = u.pm * BM + ai * HALF + wr * 64 + m * 16 + fr; const float rs = rsr[ai][m];
                const int b = row >> 13, p = 64 + (row & (T - 1));
                if (pn < 2) { const int h = pn * 4 + wc; bf16_t* dst = QM + arow(b, h, p) * DQM; float sq = 0.f;
#pragma unroll
                    for (int bj = 0; bj < 2; ++bj) { const f32x4 v0 = acc[ai][bj][m][0] * rs, v1 = acc[ai][bj][m][1] * rs;
                        sq += (v0[0] * v0[0] + v0[1] * v0[1]) + (v0[2] * v0[2] + v0[3] * v0[3]) + (v1[0] * v1[0] + v1[1] * v1[1]) + (v1[2] * v1[2] + v1[3] * v1[3]);
                        const f32x4 g0 = *(const PG8_LAS f32x4*)(g_q_mla + 32 * bj + 8 * fq), g1 = *(const PG8_LAS f32x4*)(g_q_mla + 32 * bj + 8 * fq + 4);
                        *(u32x4*)(dst + 32 * bj + 8 * fq) = pack8(v0 * g0, v1 * g1); }
                    sq = fq_sum(sq); if (fq == 0) SSQQ[(size_t)row * 16 + 2 * h] = sq;
                } else { const float* rp = ROPE + ((size_t)(p - 48) * 16 + 4 * fq) * 2; const f32x4 t0 = *(const f32x4*)rp, t1 = *(const f32x4*)(rp + 4);
                    const f32x4 cs = {t0[0], t0[2], t1[0], t1[2]}, sn = {t0[1], t0[3], t1[1], t1[3]};
                    const f32x4 g0 = *(const PG8_LAS f32x4*)(g_q_mla + 64 + 4 * fq), g1 = *(const PG8_LAS f32x4*)(g_q_mla + 80 + 4 * fq);
#pragma unroll
                    for (int bj = 0; bj < 2; ++bj) { const int h = 2 * wc + bj; const f32x4 v0 = acc[ai][bj][m][0] * rs, v1 = acc[ai][bj][m][1] * rs;
                        float sq = (v0[0] * v0[0] + v0[1] * v0[1]) + (v0[2] * v0[2] + v0[3] * v0[3]) + (v1[0] * v1[0] + v1[1] * v1[1]) + (v1[2] * v1[2] + v1[3] * v1[3]);
                        sq = fq_sum(sq); if (fq == 0) SSQQ[(size_t)row * 16 + 2 * h + 1] = sq;
                        const f32x4 y1 = v0 * g0, y2 = v1 * g1; const f32x4 o1 = y1 * cs - y2 * sn, o2 = y2 * cs + y1 * sn;
                        bf16_t* dst = QM + arow(b, h, p) * DQM; u32x2 w1, w2; w1.x = cvt_pk_bf16(o1[0], o1[1]); w1.y = cvt_pk_bf16(o1[2], o1[3]); w2.x = cvt_pk_bf16(o2[0], o2[1]); w2.y = cvt_pk_bf16(o2[2], o2[3]);
                        *(u32x2*)(dst + 64 + 4 * fq) = w1; *(u32x2*)(dst + 80 + 4 * fq) = w2; } }
                if (m & 1) asm volatile("" ::: "memory"); }
    }
};
struct EpiUkv {
    static constexpr bool PERM = true, AFTER_DRAIN = false, HAS_INIT = false;
    const PG8_LAS float* g_k_mla; const float* SSQCKV; const float* SSQKPE; const float* KPE; bf16_t* KM; bf16_t* VM; const float* ROPE;
    __device__ __forceinline__ void operator()(const f32x4 (&acc)[2][2][4][2], const Unit& u, int wr, int wc, int fr, int fq) const {
        const int pn = u.pn, h = (pn & 1) * 4 + wc;
        float rsr[2][4]; rs_rows<4>(SSQCKV, u.pm * BM + wr * 64 + fr, fq, 1.f / 128.f, rsr);
#pragma unroll
        for (int ai = 0; ai < 2; ++ai)
#pragma unroll
            for (int m = 0; m < 4; ++m) { const int row = u.pm * BM + ai * HALF + wr * 64 + m * 16 + fr; const float rs = rsr[ai][m];
                const int b = row >> 13, p = 64 + (row & (T - 1));
                if (pn < 2) { float sq = 0.f;
#pragma unroll
                    for (int bj = 0; bj < 2; ++bj)
#pragma unroll
                        for (int n = 0; n < 2; ++n) { const f32x4 v = acc[ai][bj][m][n] * rs; sq += (v[0] * v[0] + v[1] * v[1]) + (v[2] * v[2] + v[3] * v[3]); }
                    const float rk = __builtin_amdgcn_rsqf((fq_sum(sq) + SSQKPE[row]) * (1.f / 96.f) + EPS); const float rr = rs * rk;
#pragma unroll
                    for (int bj = 0; bj < 2; ++bj) { const f32x4 g0 = *(const PG8_LAS f32x4*)(g_k_mla + 32 * bj + 8 * fq), g1 = *(const PG8_LAS f32x4*)(g_k_mla + 32 * bj + 8 * fq + 4);
                        *(u32x4*)(KM + kaddr(b, h, p, 32 * bj + 8 * fq, DQM)) = pack8(acc[ai][bj][m][0] * g0 * rr, acc[ai][bj][m][1] * g1 * rr); }
                    const float* rp = ROPE + ((size_t)(p - 48) * 16 + 4 * fq) * 2; const f32x4 t0 = *(const f32x4*)rp, t1 = *(const f32x4*)(rp + 4);
                    const f32x4 cs = {t0[0], t0[2], t1[0], t1[2]}, sn = {t0[1], t0[3], t1[1], t1[3]};
                    const f32x4 y1 = *(const f32x4*)(KPE + (size_t)row * 32 + 4 * fq) * *(const PG8_LAS f32x4*)(g_k_mla + 64 + 4 * fq) * rk, y2 = *(const f32x4*)(KPE + (size_t)row * 32 + 16 + 4 * fq) * *(const PG8_LAS f32x4*)(g_k_mla + 80 + 4 * fq) * rk;
                    const f32x4 o1 = y1 * cs - y2 * sn, o2 = y2 * cs + y1 * sn; u32x2 w1, w2; w1.x = cvt_pk_bf16(o1[0], o1[1]); w1.y = cvt_pk_bf16(o1[2], o1[3]); w2.x = cvt_pk_bf16(o2[0], o2[1]); w2.y = cvt_pk_bf16(o2[2], o2[3]);
                    *(u32x2*)(KM + kaddr(b, h, p, 64 + 4 * fq, DQM)) = w1; *(u32x2*)(KM + kaddr(b, h, p, 80 + 4 * fq, DQM)) = w2;
                } else {
#pragma unroll
                    for (int bj = 0; bj < 2; ++bj) *(u32x4*)(VM + vaddr(b, h, p, 32 * bj + 8 * fq)) = pack8(acc[ai][bj][m][0] * rs, acc[ai][bj][m][1] * rs); }
                if (m & 1) asm volatile("" ::: "memory"); }
    }
};
}


namespace att {
typedef short s16x4 __attribute__((ext_vector_type(4)));
typedef float f32x16 __attribute__((ext_vector_type(16)));
constexpr int NW = 8, QBLK = 32, QB = QBLK * NW, KVBLK = 64;
constexpr int KSLOT = 12288, NKSLOT = 4, VSLOT = 8192, NVSLOT = 3;
constexpr int LDS_K = 0, LDS_V = NKSLOT * KSLOT, LDS_WS = LDS_V + NVSLOT * VSLOT, LDS_OST = LDS_WS + NW * 256, LDS_BYTES = LDS_OST + NW * 4096;
__device__ __forceinline__ int crow(int r, int hi) { return (r & 3) + 8 * (r >> 2) + 4 * hi; }
#define SBAR() __builtin_amdgcn_sched_barrier(0)
__device__ __forceinline__ void cmask(f32x16& p0, f32x16& p1, int jb, int qrel, int hi) {
    const float NEG = -INFINITY; const int kb = 64 * jb + 4 * hi;
#pragma unroll
    for (int r = 0; r < 16; ++r) { const int kv = kb + (r & 3) + 8 * (r >> 2); if (kv > qrel) p0[r] = NEG; if (kv + 32 > qrel) p1[r] = NEG; }
}
__device__ __forceinline__ void glds16(const void* gsrc, unsigned lds_dst) { unsigned keep;
    asm volatile("s_mov_b32 %0, m0\n\ts_mov_b32 m0, %2\n\ts_nop 0\n\tglobal_load_lds_dwordx4 %1, off\n\ts_mov_b32 m0, %0" : "=&s"(keep) : "v"(gsrc), "s"(lds_dst) : "memory"); }
typedef float f32x2_t __attribute__((ext_vector_type(2))); typedef __bf16 bf16x2_t __attribute__((ext_vector_type(2)));
__device__ __forceinline__ unsigned cvtpk_s(float lo, float hi) { f32x2_t v = {lo, hi}; bf16x2_t b = __builtin_convertvector(v, bf16x2_t); return __builtin_bit_cast(unsigned, b); }
#define WAIT_BAR(N) asm volatile("s_waitcnt vmcnt(" #N ") lgkmcnt(0)\n\ts_barrier" ::: "memory")
typedef __attribute__((address_space(3))) const char* lds_cptr;
typedef short v4i16_t __attribute__((ext_vector_type(4)));
#define LDSV8(p) (*(const __attribute__((address_space(3))) bf16x8*)(p))
__device__ __forceinline__ void kload2(bf16x8* kf, lds_cptr kp, int j) { kf[2 * j] = LDSV8(kp + j * 2048); kf[2 * j + 1] = LDSV8(kp + j * 2048 + 512); }
__device__ __forceinline__ s16x4 vtr(lds_cptr p) { return __builtin_bit_cast(s16x4, __builtin_amdgcn_ds_read_tr16_b64_v4i16((__attribute__((address_space(3))) v4i16_t*)p)); }
#define MX3(a, b, c) __builtin_fmaxf(__builtin_fmaxf((a), (b)), (c))
__device__ __forceinline__ float rowmax(const f32x16& p0, const f32x16& p1) {
    float a = MX3(p0[0], p0[1], p1[0]), b = MX3(p0[2], p0[3], p1[1]); a = MX3(a, p1[2], p1[3]);
#pragma unroll
    for (int r = 4; r < 16; r += 4) { a = MX3(a, p0[r], p0[r + 1]); b = MX3(b, p0[r + 2], p0[r + 3]); a = MX3(a, p1[r], p1[r + 1]); b = MX3(b, p1[r + 2], p1[r + 3]); }
    float m = __builtin_fmaxf(a, b); auto rr = __builtin_amdgcn_permlane32_swap(__float_as_uint(m), __float_as_uint(m), false, false);
    return __builtin_fmaxf(__uint_as_float(rr[0]), __uint_as_float(rr[1])); }
__device__ __forceinline__ void pv(f32x16* o, int vb, bf16x8 pa0, bf16x8 pa1, bf16x8 pa2, bf16x8 pa3) {
#pragma unroll
    for (int d0 = 0; d0 < 2; ++d0) { s16x4 lo[4], hi[4];
#pragma unroll
        for (int ks = 0; ks < 4; ++ks) {
            asm volatile("ds_read_b64_tr_b16 %0,%1 offset:%c2" : "=&v"(lo[ks]) : "v"(vb), "i"(d0 * 4096 + ks * 1024) : "memory");
            asm volatile("ds_read_b64_tr_b16 %0,%1 offset:%c2" : "=&v"(hi[ks]) : "v"(vb), "i"(d0 * 4096 + ks * 1024 + 512) : "memory"); }
        asm volatile("s_waitcnt lgkmcnt(0)" ::: "memory"); SBAR();
#define PK(k) (bf16x8){lo[k][0], lo[k][1], lo[k][2], lo[k][3], hi[k][0], hi[k][1], hi[k][2], hi[k][3]}
        o[d0] = __builtin_amdgcn_mfma_f32_32x32x16_bf16(pa0, PK(0), o[d0], 0, 0, 0);
        o[d0] = __builtin_amdgcn_mfma_f32_32x32x16_bf16(pa1, PK(1), o[d0], 0, 0, 0);
        o[d0] = __builtin_amdgcn_mfma_f32_32x32x16_bf16(pa2, PK(2), o[d0], 0, 0, 0);
        o[d0] = __builtin_amdgcn_mfma_f32_32x32x16_bf16(pa3, PK(3), o[d0], 0, 0, 0);
#undef PK
    }
}
#ifndef ATTN_STORE16
#define ATTN_STORE16(p, v) (*(u32x4*)(p) = (v))
#endif
#define MFMA32(a, b, c) __builtin_amdgcn_mfma_f32_32x32x16_bf16(a, b, c, 0, 0, 0)
template <int NKS, bool FOX, int THRL>
__device__ __forceinline__ void attn_unit(int b, int h, int qb, const bf16_t* Qb, const bf16_t* __restrict__ Kb, const bf16_t* __restrict__ Vb, const float* aux, bf16_t* O, int ocol, char* shm, float m0, int tb) {
    constexpr int DK = NKS * 16, NX = NKS * 2 - 8;
    int tid = threadIdx.x; asm volatile("" : "+v"(tid));
    const int lane = tid & 63, r32 = lane & 31, hi = lane >> 5; const int wid = __builtin_amdgcn_readfirstlane(tid >> 6);
    const size_t hb = (size_t)(b * 8 + h) * PR; const int q0 = qb * QB;
    if (wid >= 4) __builtin_amdgcn_s_setprio(1);
    const bf16_t* Kh = Kb + (hb + (size_t)(64 * tb)) * DK; const bf16_t* Vh = Vb + (hb + (size_t)(64 * tb)) * 64;
    const unsigned lds0 = (unsigned)(uintptr_t)shm;
    float* wsf = (float*)(shm + LDS_WS) + wid * 64;
    const bf16_t* ksrc1 = Kh + wid * 512 + lane * 8;
    const bf16_t* ksrc2 = Kh + 4096 + wid * NX * 64 + lane * 8;
    const bf16_t* vsrc = Vh + wid * 512 + lane * 8;
    const unsigned kdst1 = lds0 + LDS_K + wid * 1024, kdst2 = lds0 + LDS_K + 8192 + wid * NX * 128, vdst = lds0 + LDS_V + wid * 1024;
    const bool x2 = lane < NX * 8;
#define DMA_K(t, slot) do { glds16(ksrc1 + (size_t)(t) * KVBLK * DK, (unsigned)__builtin_amdgcn_readfirstlane(kdst1 + (slot))); if (x2) glds16(ksrc2 + (size_t)(t) * KVBLK * DK, (unsigned)__builtin_amdgcn_readfirstlane(kdst2 + (slot))); } while (0)
#define DMA_V(t, slot) glds16(vsrc + (size_t)(t) * KVBLK * 64, (unsigned)__builtin_amdgcn_readfirstlane(vdst + (slot)))
    const int vb0 = (int)(lds0 + LDS_V) + ((lane >> 4) & 1) * 32 + (lane & 3) * 8 + (4 * hi + ((lane & 15) >> 2)) * 64;
    bf16x8 kf[12];
    const lds_cptr shm3 = (lds_cptr)shm; const lds_cptr kp0 = shm3 + LDS_K + hi * 1024 + r32 * 16; const lds_cptr vp0 = shm3 + LDS_V + ((lane >> 4) & 1) * 32 + (lane & 3) * 8 + (4 * hi + ((lane & 15) >> 2)) * 64;
    const int NT = 4 * qb + 5 - tb;
    DMA_K(0, 0); DMA_V(0, 0); DMA_K(1, KSLOT);
    bf16x8 qr[NKS]; float cqv = 0.f;
    { const int prow = 64 + q0 + wid * QBLK + r32; const bf16_t* Qrow = Qb + (hb + prow) * (FOX ? 64 : 96);
      if (FOX) {
#pragma unroll
          for (int d0 = 0; d0 < 4; ++d0) qr[d0] = *(const bf16x8*)(Qrow + d0 * 16 + hi * 8);
          const short one = hi ? (short)0 : (short)0x3f80; qr[NKS - 1] = (bf16x8){one, one, one, 0, 0, 0, 0, 0};
          cqv = aux[hb + prow] * LOG2E;
      } else { const int row = b * T + q0 + wid * QBLK + r32; const float rq = C2M / sqrtf((aux[(size_t)row * 16 + 2 * h] + aux[(size_t)row * 16 + 2 * h + 1]) * (1.f / 96.f) + EPS);
#pragma unroll
          for (int d0 = 0; d0 < NKS; ++d0) { const bf16x8 raw = *(const bf16x8*)(Qrow + d0 * 16 + hi * 8); u32x4 w;
#pragma unroll
              for (int j = 0; j < 4; ++j) w[j] = cvtpk_s(bf2f((bf16_t)raw[2 * j]) * rq, bf2f((bf16_t)raw[2 * j + 1]) * rq);
              qr[d0] = __builtin_bit_cast(bf16x8, w); } } }
    float mhat = 0.f, l_reg = 0.f; f32x16 o[2]; o[0] = f32x16{}; o[1] = f32x16{}; f32x16 negm;
#pragma unroll
    for (int r = 0; r < 16; ++r) negm[r] = cqv;
    asm volatile("" : "+v"(negm));
    const int qrel = wid * QBLK + r32;
#define CMASK(P0, P1, t) do { int jb_ = (t) - (NT - 4); if (jb_ >= 0) cmask(P0, P1, jb_, qrel, hi); } while (0)
    bool resc = false; const bool bounded = m0 < 40.f;
#define RESC() do { if (resc) { asm volatile("s_waitcnt lgkmcnt(0)" ::: "memory"); \
        _Pragma("unroll") for (int d_ = 0; d_ < 2; ++d_) _Pragma("unroll") for (int r = 0; r < 16; ++r) o[d_][r] *= wsf[crow(r, hi)]; } } while (0)
    f32x16 pA0, pA1, pB0, pB1;
    int ks_prev = 3 * KSLOT, ks_cur = 0, ks_next = KSLOT, vs_prev = 2 * VSLOT, vs_cur = 0, vs_next = VSLOT;
#define ROT() do { ks_prev = ks_cur; ks_cur = ks_next; ks_next = (ks_next == (NKSLOT - 1) * KSLOT) ? 0 : ks_next + KSLOT; vs_prev = vs_cur; vs_cur = vs_next; vs_next = (vs_next == (NVSLOT - 1) * VSLOT) ? 0 : vs_next + VSLOT; } while (0)
    DMA_K(2, 2 * KSLOT);
    WAIT_BAR(2);
    { const lds_cptr kb = kp0;
#pragma unroll
      for (int d0 = 0; d0 < NKS; ++d0) { const bf16x8 b0 = LDSV8(kb + d0 * 2048), b1 = LDSV8(kb + d0 * 2048 + 512);
          if (d0 == 0) { pB0 = MFMA32(b0, qr[0], negm); pB1 = MFMA32(b1, qr[0], negm); } else { pB0 = MFMA32(b0, qr[d0], pB0); pB1 = MFMA32(b1, qr[d0], pB1); } }
      if (tb == 0) {
#pragma unroll
          for (int r = 0; r < 16; ++r) pB0[r] = -INFINITY;
#pragma unroll
          for (int r = 0; r < 8; ++r) pB1[r] = -INFINITY; }
      const float rm = bounded ? m0 : rowmax(pB0, pB1); mhat = rm;
#pragma unroll
      for (int r = 0; r < 16; ++r) { pB0[r] = __builtin_amdgcn_exp2f(pB0[r] - rm); pB1[r] = __builtin_amdgcn_exp2f(pB1[r] - rm); }
#pragma unroll
      for (int r = 0; r < 16; ++r) negm[r] = cqv - mhat;
      asm volatile("" : "+v"(negm)); }
    WAIT_BAR(0);
    DMA_K(3, ks_prev); DMA_V(1, vs_next);
    ROT();
    kload2(kf, kp0 + ks_cur, 0); kload2(kf, kp0 + ks_cur, 1);
    s16x4 vlo[8], vhi[8]; u32x4 pw0, pw1, pw2, pw3;
#define PKW(P, B) cvtpk_s(P[B], P[B + 1])
#define PAF(k) __builtin_bit_cast(bf16x8, pw##k)
#define VFR(i) (bf16x8){vlo[i][0], vlo[i][1], vlo[i][2], vlo[i][3], vhi[i][0], vhi[i][1], vhi[i][2], vhi[i][3]}
#define PIN(x) asm volatile("" : "+v"(x))
#define GAPA(MF, A0, A1, A2, A3, W0, W1, PW) do { MF; sacc += A0; sacc += A1; sacc += A2; sacc += A3; PIN(sacc); W0; W1; PIN(PW); SBAR(); } while (0)
#define EX(v) __builtin_amdgcn_exp2f(v)
#define GAPB(MF, X, B) do { MF; X[B] = EX(X[B]); X[B + 1] = EX(X[B + 1]); X[B + 2] = EX(X[B + 2]); X[B + 3] = EX(X[B + 3]); PIN(X); SBAR(); } while (0)
#define VRD(i) do { vlo[i] = vtr(vp_ + (((i) >> 2) * 4096 + ((i) & 3) * 1024)); vhi[i] = vtr(vp_ + (((i) >> 2) * 4096 + ((i) & 3) * 1024 + 512)); } while (0)
#define KRD(G, j) do { if (G) { kload2(kf, kp0 + ks_next, j); SBAR(); } } while (0)
#define KLD(f) do { kf[f] = LDSV8(kx_ + ((f) >> 1) * 2048 + ((f) & 1) * 512); } while (0)
#define STEP(C0, C1, P0, P1, t, GK, GV, GL) do { SBAR(); \
    const lds_cptr vp_ = vp0 + vs_prev; const lds_cptr kx_ = kp0 + ks_cur; \
    VRD(0); KLD(4); SBAR(); float sacc = (P0[0] + P0[1]); \
    GAPA(C0 = MFMA32(kf[0], qr[0], negm), P0[2], P0[3], P0[4], P0[5],     pw0[0] = PKW(P0, 0), pw0[1] = PKW(P0, 2), pw0); \
    VRD(4); KLD(5); SBAR(); GAPA(C1 = MFMA32(kf[1], qr[0], negm), P0[6], P0[7], P0[8], P0[9],     pw0[2] = PKW(P0, 4), pw0[3] = PKW(P0, 6), pw0); \
    VRD(1); KLD(6); SBAR(); GAPA(C0 = MFMA32(kf[2], qr[1], C0),   P0[10], P0[11], P0[12], P0[13], pw1[0] = PKW(P0, 8), pw1[1] = PKW(P0, 10), pw1); \
    VRD(5); KLD(7); SBAR(); GAPA(C1 = MFMA32(kf[3], qr[1], C1),   P0[14], P0[15], P1[0], P1[1],   pw1[2] = PKW(P0, 12), pw1[3] = PKW(P0, 14), pw1); \
    VRD(2); KLD(8); SBAR(); GAPA(C0 = MFMA32(kf[4], qr[2], C0),   P1[2], P1[3], P1[4], P1[5],     pw2[0] = PKW(P1, 0), pw2[1] = PKW(P1, 2), pw2); \
    VRD(6); KLD(9); SBAR(); GAPA(C1 = MFMA32(kf[5], qr[2], C1),   P1[6], P1[7], P1[8], P1[9],     pw2[2] = PKW(P1, 4), pw2[3] = PKW(P1, 6), pw2); \
    VRD(3); if (NKS == 6) KLD(10); SBAR(); GAPA(C0 = MFMA32(kf[6], qr[3], C0),   P1[10], P1[11], P1[12], P1[13], pw3[0] = PKW(P1, 8), pw3[1] = PKW(P1, 10), pw3); \
    VRD(7); if (NKS == 6) KLD(11); SBAR(); GAPA(C1 = MFMA32(kf[7], qr[3], C1),   P1[14], P1[15], 0.f, 0.f,       pw3[2] = PKW(P1, 12), pw3[3] = PKW(P1, 14), pw3); \
    C0 = MFMA32(kf[8], qr[4], C0); C1 = MFMA32(kf[9], qr[4], C1); if (NKS == 6) { C0 = MFMA32(kf[10], qr[NKS - 1], C0); C1 = MFMA32(kf[11], qr[NKS - 1], C1); } \
    l_reg += sacc; \
    if (GK) { DMA_K((t) + 3, ks_prev); } if (GV) { DMA_V((t) + 1, vs_next); } \
    CMASK(C0, C1, t); \
    resc = false; \
    if (!bounded) { float a = MX3(C0[0], C0[1], C1[0]), b_ = MX3(C0[2], C0[3], C1[1]); a = MX3(a, C1[2], C1[3]); \
      _Pragma("unroll") for (int r = 4; r < 16; r += 4) { a = MX3(a, C0[r], C0[r + 1]); b_ = MX3(b_, C0[r + 2], C0[r + 3]); a = MX3(a, C1[r], C1[r + 1]); b_ = MX3(b_, C1[r + 2], C1[r + 3]); } \
      float rm = __builtin_fmaxf(a, b_); { auto rr = __builtin_amdgcn_permlane32_swap(__float_as_uint(rm), __float_as_uint(rm), false, false); rm = __builtin_fmaxf(__uint_as_float(rr[0]), __uint_as_float(rr[1])); } \
      if (__builtin_expect(__any(rm > (float)THRL), 0)) { const float dl = __builtin_fmaxf(rm, 0.f); mhat += dl; \
        _Pragma("unroll") for (int r = 0; r < 16; ++r) { C0[r] -= dl; C1[r] -= dl; } \
        _Pragma("unroll") for (int r = 0; r < 16; ++r) negm[r] = cqv - mhat; asm volatile("" : "+v"(negm)); \
        const float f = __builtin_amdgcn_exp2f(-dl); l_reg *= f; if (hi == 0) wsf[r32] = f; resc = true; } } \
    SBAR(); \
    GAPB(o[0] = MFMA32(PAF(0), VFR(0), o[0]), C0, 0); \
    GAPB(o[1] = MFMA32(PAF(0), VFR(4), o[1]), C0, 4); \
    KRD(GL, 0); GAPB(o[0] = MFMA32(PAF(1), VFR(1), o[0]), C0, 8); \
    KRD(GL, 1); GAPB(o[1] = MFMA32(PAF(1), VFR(5), o[1]), C0, 12); \
    GAPB(o[0] = MFMA32(PAF(2), VFR(2), o[0]), C1, 0); \
    GAPB(o[1] = MFMA32(PAF(2), VFR(6), o[1]), C1, 4); \
    GAPB(o[0] = MFMA32(PAF(3), VFR(3), o[0]), C1, 8); \
    GAPB(o[1] = MFMA32(PAF(3), VFR(7), o[1]), C1, 12); \
    } while (0)
#define ENDW(tt) do { if ((tt) + 3 < NT) { WAIT_BAR(3); } else if ((tt) + 2 < NT) { WAIT_BAR(1); } else { WAIT_BAR(0); } } while (0)
    WAIT_BAR(3);
    STEP(pA0, pA1, pB0, pB1, 1, true, true, true); ENDW(1); RESC(); ROT();
    int t = 2;
#undef CMASK
#define CMASK(P0, P1, t) do { } while (0)
    for (; t + 5 < NT; t += 2) {
        STEP(pB0, pB1, pA0, pA1, t, true, true, true);     WAIT_BAR(3); RESC(); ROT();
        STEP(pA0, pA1, pB0, pB1, t + 1, true, true, true); WAIT_BAR(3); RESC(); ROT();
    }
#undef CMASK
#define CMASK(P0, P1, t) do { int jb_ = (t) - (NT - 4); if (jb_ >= 0) cmask(P0, P1, jb_, qrel, hi); } while (0)
    for (; t + 1 < NT; t += 2) {
        STEP(pB0, pB1, pA0, pA1, t, (t + 3 < NT), (t + 1 < NT), (t + 1 < NT));         ENDW(t);     RESC(); ROT();
        STEP(pA0, pA1, pB0, pB1, t + 1, (t + 4 < NT), (t + 2 < NT), (t + 2 < NT));     ENDW(t + 1); RESC(); ROT();
    }
    STEP(pB0, pB1, pA0, pA1, NT - 1, false, false, false); RESC();
    { float sacc = pB0[0] + pB0[1];
#pragma unroll
      for (int r = 2; r < 16; ++r) sacc += pB0[r];
#pragma unroll
      for (int r = 0; r < 16; ++r) sacc += pB1[r];
      l_reg += sacc;
      pw0 = (u32x4){PKW(pB0, 0), PKW(pB0, 2), PKW(pB0, 4), PKW(pB0, 6)}; pw1 = (u32x4){PKW(pB0, 8), PKW(pB0, 10), PKW(pB0, 12), PKW(pB0, 14)};
      pw2 = (u32x4){PKW(pB1, 0), PKW(pB1, 2), PKW(pB1, 4), PKW(pB1, 6)}; pw3 = (u32x4){PKW(pB1, 8), PKW(pB1, 10), PKW(pB1, 12), PKW(pB1, 14)};
      SBAR(); pv(o, vb0 + vs_cur, PAF(0), PAF(1), PAF(2), PAF(3)); }
#undef PKW
#undef PAF
#undef VFR
#undef PIN
#undef GAPA
#undef GAPB
#undef EX
#undef VRD
#undef KRD
#undef STEP
#undef KLD
#undef ENDW
    { auto rr = __builtin_amdgcn_permlane32_swap(__float_as_uint(l_reg), __float_as_uint(l_reg), false, false); l_reg = __uint_as_float(rr[0]) + __uint_as_float(rr[1]); }
    if (hi == 0) wsf[32 + r32] = l_reg; asm volatile("s_waitcnt lgkmcnt(0)" ::: "memory");
    float rli[16];
#pragma unroll
    for (int r = 0; r < 16; ++r) rli[r] = __builtin_amdgcn_rcpf(wsf[32 + crow(r, hi)]);
    bf16_t* Ow = O + (size_t)(b * T + q0 + wid * QBLK) * D + ocol;
    { bf16_t* stg = (bf16_t*)(shm + LDS_OST) + wid * 2048;
#pragma unroll
      for (int r = 0; r < 16; ++r) { const int orow = crow(r, hi);
#pragma unroll
          for (int d0 = 0; d0 < 2; ++d0) stg[orow * 64 + d0 * 32 + r32] = (bf16_t)f2bf(o[d0][r] * rli[r]); }
      asm volatile("s_waitcnt lgkmcnt(0)" ::: "memory");
#pragma unroll
      for (int i = 0; i < 4; ++i) { const int row = i * 8 + (lane >> 3), ch = lane & 7; const u32x4 v = *(const u32x4*)(stg + row * 64 + ch * 8); ATTN_STORE16(Ow + (size_t)row * D + ch * 8, v); } }
    asm volatile("s_waitcnt lgkmcnt(0)\n\ts_barrier" ::: "memory");
    __builtin_amdgcn_s_setprio(0);
#undef DMA_K
#undef DMA_V
#undef CMASK
#undef RESC
#undef ROT
}
#undef SBAR
#undef WAIT_BAR
#undef MFMA32
#undef MX3
#undef LDSV8
}
constexpr int CW_QATT = 13312, CW_QCONV = CW_QATT + 64 * 8;
__device__ __forceinline__ int wg_dequeue(unsigned* head, volatile __attribute__((address_space(3))) unsigned* slot) {
    __syncthreads();
    if (threadIdx.x == 0) *slot = __hip_atomic_fetch_add(head, 1u, __ATOMIC_RELAXED, __HIP_MEMORY_SCOPE_AGENT);
    __syncthreads();
    return (int)*slot;
}
__device__ __forceinline__ void attn_phase(const Ctx& C, char* shm, unsigned* ctl, unsigned xcc, volatile __attribute__((address_space(3))) unsigned* slot) {
    float m0_mla, m0_fox;
    { const int l = threadIdx.x & 63; float a = fmaxf(fabsf(C.g_q_mla[l]), l < 32 ? fabsf(C.g_q_mla[64 + l]) : 0.f), b2 = fmaxf(fabsf(C.g_k_mla[l]), l < 32 ? fabsf(C.g_k_mla[64 + l]) : 0.f), c = fabsf(C.g_q_fox[l]), d = fabsf(C.g_k_fox[l]);
#pragma unroll
      for (int o = 1; o < 64; o <<= 1) { a = fmaxf(a, __shfl_xor(a, o)); b2 = fmaxf(b2, __shfl_xor(b2, o)); c = fmaxf(c, __shfl_xor(c, o)); d = fmaxf(d, __shfl_xor(d, o)); }
      m0_mla = 9.797958971f * a * b2 * LOG2E * 1.02f; m0_fox = 8.0f * c * d * LOG2E * 1.02f; }
    const float prune = -(2.0f * m0_fox + 40.0f);
    unsigned pre = 128u;
    if (threadIdx.x == 0) pre = __hip_atomic_fetch_add(ctl + CW_QATT + 64 * (int)(xcc & 7u), 1u, __ATOMIC_RELAXED, __HIP_MEMORY_SCOPE_AGENT);
    for (bool own = true;;) {
        __syncthreads();
        if (threadIdx.x == 0) { int grp = (int)(xcc & 7u); unsigned tk = 128u;
            if (own) tk = pre;
            if (tk >= 128u) { unsigned hd[8];
#pragma unroll
                for (int g = 0; g < 8; ++g) hd[g] = __hip_atomic_load(ctl + CW_QATT + 64 * g, __ATOMIC_RELAXED, __HIP_MEMORY_SCOPE_AGENT);
                int pick = -1;
#pragma unroll
                for (int g = 7; g >= 0; --g) { const int gg = (int)((xcc + 1u + (unsigned)g) & 7u); unsigned hv = 0u;
#pragma unroll
                    for (int q = 0; q < 8; ++q) hv = (q == gg) ? hd[q] : hv;
                    if (hv < 128u) pick = gg; }
                if (pick >= 0) { grp = pick; tk = __hip_atomic_fetch_add(ctl + CW_QATT + 64 * grp, 1u, __ATOMIC_RELAXED, __HIP_MEMORY_SCOPE_AGENT); } else tk = 0xffffu; }
            *slot = (tk << 8) | (unsigned)grp; }
        __syncthreads();
        const unsigned sv = *slot; const int grp = (int)(sv & 7u), i = (int)(sv >> 8);
        if (i >= 0xffff) break;
        if (i >= 128) { own = false; continue; }
        if (grp != (int)(xcc & 7u)) own = false;
        if (own && threadIdx.x == 0) pre = __hip_atomic_fetch_add(ctl + CW_QATT + 64 * grp, 1u, __ATOMIC_RELAXED, __HIP_MEMORY_SCOPE_AGENT);
        {
            const int fox = i >> 6, j = i & 63, st = 4 * grp + 2 * (j & 1) + fox, qb = 31 - (j >> 1), bh = st >> 1, b = bh >> 3, h = bh & 7;
            if (!fox) att::attn_unit<6, false, 8>(b, h, qb, C.QM, C.KM, C.VM, C.main.SSQQ, C.O, h * 64, shm, m0_mla, 0);
            else { const int lane = threadIdx.x & 63, cand = 2 * lane; const size_t hb = (size_t)bh * PR;
                bool ok = cand <= 4 * qb;
                if (ok && cand > 0) ok = (C.CUM[hb + 64 + 256 * qb] - C.CUM[hb + 64 * cand - 1]) * LOG2E < prune;
                const unsigned long long m = __ballot(ok); const int tb = 2 * (63 - __builtin_clzll(m));
                att::attn_unit<5, true, 8>(b, h, qb, C.FQ, C.FK, C.FV, C.CUM, C.O, 512 + h * 64, shm, m0_fox, __builtin_amdgcn_readfirstlane(tb)); } } }
    constexpr int NCHUNK = (2 * I_GU + I_DN + 7) / 8;
    for (;;) { const int c = wg_dequeue(ctl + CW_QCONV, slot); if (c >= NCHUNK) break;
        const int w_ = __builtin_amdgcn_readfirstlane(threadIdx.x >> 6); p0_late<1>(C, (float*)shm + w_ * TSCR, c * 8 + w_, NCHUNK * 8, threadIdx.x & 63); }
}
#define LAS __attribute__((address_space(3)))
constexpr int CW_BAR = 1024;
constexpr size_t CTL_ZERO_BYTES = 65536;
constexpr int LDSCTL_OFF = 131072, MISC_OFF = LDSCTL_OFF + 320;
#define XB_TMO      128
#define XB_XCNT(j)  (256  + 64 * (j))
#define XB_XSUB(j)  (1280 + 64 * (j))
#define XB_XGEN(j)  (2304 + 64 * (j))
#define XB_TOP      3328
#define XB_TOPGEN   3392
#define XCD_BAR_WORDS 3456
#define XB_SPIN_CAP (1u << 18)

__device__ __forceinline__ unsigned xb_ld(unsigned* p)              { return __hip_atomic_load(p, __ATOMIC_RELAXED, __HIP_MEMORY_SCOPE_AGENT); }
__device__ __forceinline__ unsigned xb_add(unsigned* p, unsigned v) { return __hip_atomic_fetch_add(p, v, __ATOMIC_RELAXED, __HIP_MEMORY_SCOPE_AGENT); }
__device__ __forceinline__ unsigned xb_xcc_id() { return (unsigned)__builtin_amdgcn_s_getreg((3 << 11) | 20) & 0xFu; }
#define XB_SPIN(cond, bar) do { unsigned _sp = 0; while (cond) { __builtin_amdgcn_s_sleep(1); \
    if ((++_sp & 255u) == 0u) { if (xb_ld(&(bar)[XB_TMO])) break; if (_sp > XB_SPIN_CAP) { atomicAdd(&(bar)[XB_TMO], 1u); break; } } } } while (0)

constexpr int CW_SIDE = 12288;
__device__ __forceinline__ void side_wait(unsigned* w, unsigned target, unsigned* bar) {
    if (threadIdx.x == 0) { XB_SPIN(xb_ld(w) < target, bar); __builtin_amdgcn_fence(__ATOMIC_ACQUIRE, "agent"); asm volatile("s_waitcnt vmcnt(0)" ::: "memory"); }
    __syncthreads();
}
struct XcdBarrier {
    unsigned* bar; unsigned x;
    volatile LAS unsigned* st;
};

__device__ __forceinline__ XcdBarrier xcd_barrier_post(unsigned* bar, volatile LAS unsigned* st) {
    XcdBarrier b; b.bar = bar; b.x = xb_xcc_id(); b.st = st;
    if (threadIdx.x == 0) (void)xb_add(&bar[XB_XCNT(b.x)], 1u);
    return b;
}
__device__ __forceinline__ void xcd_barrier_complete(unsigned* bar, unsigned x, unsigned& nloc, unsigned& nx) {
    const unsigned G = gridDim.x * gridDim.y * gridDim.z;
    unsigned sum, cnt, mine, sp = 0u;
    for (;;) {
        sum = 0u; cnt = 0u; mine = 0u;
#pragma unroll
        for (unsigned j = 0; j < 16; ++j) { const unsigned c = xb_ld(&bar[XB_XCNT(j)]); sum += c; cnt += (c > 0u) ? 1u : 0u; mine = (j == x) ? c : mine; }
        if (sum == G) break;
        __builtin_amdgcn_s_sleep(1);
        if ((++sp & 255u) == 0u) { if (xb_ld(&bar[XB_TMO])) break; if (sp > XB_SPIN_CAP) { atomicAdd(&bar[XB_TMO], 1u); break; } }
    }
    nloc = mine > 0u ? mine : 1u; nx = cnt > 0u ? cnt : 1u;
}

__device__ __forceinline__ void xcd_barrier(const XcdBarrier& b) {
    asm volatile("s_waitcnt vmcnt(0)" ::: "memory");
    __syncthreads();
    if (threadIdx.x == 0) {
        unsigned* bar = b.bar;
        __builtin_amdgcn_s_waitcnt(0);
        unsigned nloc = b.st[0], nx = b.st[1];
        if (nloc == 0u) { xcd_barrier_complete(bar, b.x, nloc, nx); b.st[0] = nloc; b.st[1] = nx; }
        const unsigned old = xb_add(&bar[XB_XSUB(b.x)], 1u);
        const unsigned gen = old / nloc;
        if (old + 1u == (gen + 1u) * nloc) {
            __builtin_amdgcn_fence(__ATOMIC_RELEASE, "agent");
            asm volatile("s_waitcnt vmcnt(0)" ::: "memory");
            const unsigned og = xb_add(&bar[XB_TOP], 1u);
            const unsigned tg = og / nx;
            if (og + 1u == (tg + 1u) * nx) xb_add(&bar[XB_TOPGEN], 1u);
            else XB_SPIN(xb_ld(&bar[XB_TOPGEN]) == tg, bar);
            __builtin_amdgcn_fence(__ATOMIC_ACQUIRE, "agent");
            xb_add(&bar[XB_XGEN(b.x)], 1u);
            asm volatile("s_waitcnt vmcnt(0)" ::: "memory");
        } else {
            XB_SPIN(xb_ld(&bar[XB_XGEN(b.x)]) == gen, bar);
            __builtin_amdgcn_fence(__ATOMIC_ACQUIRE, "agent");
            asm volatile("s_waitcnt vmcnt(0)" ::: "memory");
        }
    }
    __syncthreads();
}

constexpr int NWAVES = 8, LDS_BYTES = 147456;
__device__ __forceinline__ void fk_aug(const Ctx& C, int b, int h, int p, float cum) {
    C.CUM[arow(b, h, p)] = cum;
    const float cc = -cum * LOG2E; const unsigned hi = f2bf(cc); const float r1 = cc - __uint_as_float(hi << 16); const unsigned mid = f2bf(r1); const float r2 = r1 - __uint_as_float(mid << 16); const unsigned lo = f2bf(r2);
    *(u32x4*)(C.FK + kaddr(b, h, p, 64, DFK)) = (u32x4){hi | (mid << 16), lo, 0u, 0u}; *(u32x4*)(C.FK + kaddr(b, h, p, 72, DFK)) = (u32x4){0u, 0u, 0u, 0u};
}
__device__ __forceinline__ void scan_block(const Ctx& C, int bh, float* lds_f, int tid) {
    const int b = bh >> 3, h = bh & 7, lane = tid & 63, w = tid >> 6; constexpr int PER = 16;
    float v[PER]; const int e0 = tid * PER;
#pragma unroll
    for (int i = 0; i < PER; ++i) v[i] = C.main.LOGF[(size_t)(b * T + e0 + i) * 8 + h];
#pragma unroll
    for (int i = 1; i < PER; ++i) v[i] += v[i - 1];
    float s = v[PER - 1];
#pragma unroll
    for (int o = 1; o < 64; o <<= 1) { const float n = __shfl_up(s, o); if (lane >= o) s += n; }
    if (lane == 63) lds_f[w] = s;
    __syncthreads();
    float off = s - v[PER - 1];
#pragma unroll
    for (int j = 0; j < 8; ++j) if (j < w) off += lds_f[j];
#pragma unroll
    for (int i = 0; i < PER; ++i) fk_aug(C, b, h, 64 + e0 + i, off + v[i]);
    if (tid < 16) { float c = 0.f; for (int r = tid + 1; r < 16; ++r) c += C.mt.LOGF[r * 8 + h]; fk_aug(C, b, h, 48 + tid, -c); }
    if (tid >= 256) { const int r = (tid >> 3) & 15, ch = tid & 7;
        if (tid < 384) *(u32x4*)(C.FK + kaddr(b, h, 48 + r, 8 * ch, DFK)) = *(const u32x4*)(C.MFK + (r * 8 + h) * 64 + 8 * ch);
        else *(u32x4*)(C.FV + vaddr(b, h, 48 + r, 8 * ch)) = *(const u32x4*)(C.MFV + (r * 8 + h) * 64 + 8 * ch); }
    if (tid < 48) { const int p = tid; C.CUM[arow(b, h, p)] = 0.f;
        const u32x4 z = {0u, 0u, 0u, 0u};
        for (int j = 0; j < DFK / 8; ++j) *(u32x4*)(C.FK + kaddr(b, h, p, 8 * j, DFK)) = z;
        for (int j = 0; j < DQM / 8; ++j) *(u32x4*)(C.KM + kaddr(b, h, p, 8 * j, DQM)) = z;
        for (int j = 0; j < 8; ++j) { *(u32x4*)(C.FV + vaddr(b, h, p, 8 * j)) = z; *(u32x4*)(C.VM + vaddr(b, h, p, 8 * j)) = z; } }
    __syncthreads();
}
#define GEMM_PHASE(g, E) do { int t_ = threadIdx.x; asm volatile("" : "+v"(t_)); pg8::StaticOrder S_; S_.init((g).M, (g).N, G, (int)blockIdx.x); \
    pg8::gemm_phase<std::remove_cv_t<std::remove_reference_t<decltype(E)>>, pg8::StaticOrder, true, true>(ldsp, g, S_, E, t_); } while (0)
__global__ void __launch_bounds__(NWAVES * 64, 2) mega_fwd(KArgs a) {
    extern __shared__ __attribute__((aligned(16))) unsigned char lds[];
    const Ctx C = make_ctx(a);
    PG8_LAS unsigned char* ldsp = (PG8_LAS unsigned char*)lds;
    const int tid = threadIdx.x, lane = tid & 63, wave = __builtin_amdgcn_readfirstlane(tid >> 6);
    const int G = gridDim.x, gw = blockIdx.x * NWAVES + wave, NGW = G * NWAVES;
    for (int u = tid; u < (LDS_BYTES - LDSCTL_OFF) / 4; u += NWAVES * 64) ((LAS unsigned*)((LAS unsigned char*)lds + LDSCTL_OFF))[u] = 0u;
    __syncthreads();
    PG8_LAS float* const gtab = (PG8_LAS float*)(ldsp + LDSCTL_OFF + 8192);
    if (tid < 320) gtab[tid] = tid < 64 ? C.g_q_fox[tid] : tid < 128 ? C.g_k_fox[tid - 64] : tid < 224 ? C.g_q_mla[tid - 128] : C.g_k_mla[tid - 224];
    __syncthreads();
    unsigned* const ctl = (unsigned*)(a.ws + WS_CTL);
    const XcdBarrier bar = xcd_barrier_post(ctl + CW_BAR, (volatile LAS unsigned*)((LAS unsigned char*)lds + MISC_OFF) + 8);
    p0_prologue(C, (float*)lds + wave * TSCR, gw, wave * G + (int)blockIdx.x, NGW, lane);
    xcd_barrier(bar);
    { const pg8::Gemm g{C.main.XN1, C.W1GU, M, 2 * FF, D, D}; const pg8::EpiSwiglu E{C.main.HB, nullptr}; GEMM_PHASE(g, E); }
    if ((int)blockIdx.x >= G / 2) {
        const int s_ = (int)blockIdx.x - G / 2, NS = G - G / 2; unsigned* const side = ctl + CW_SIDE;
        for (int t = s_; t < FF / 16; t += NS) { task_gateup(C.mt.XN1, C.W1GU, nullptr, C.mt.HB, t, lane, wave, (float*)lds); __syncthreads(); }
        if (wave == 0) { asm volatile("s_waitcnt vmcnt(0)" ::: "memory"); if (tid == 0) xb_add(side, 1u); }
        p0_late<0>(C, (float*)lds + wave * TSCR, s_ * NWAVES + wave, NS * NWAVES, lane);
        if (s_ >= NS - 16) { __syncthreads(); side_wait(side, NS, ctl + CW_BAR);
            task_down(C.mt.HB, FF, C.W1D, C.mt.base1, C.mt.H, 0.5f, C.mt.XN, C.mt.SSQ1, s_ - (NS - 16), lane, wave, (float*)lds);
            if (wave == 0) { asm volatile("s_waitcnt vmcnt(0)" ::: "memory"); if (tid == 0) xb_add(side + 64, 1u); } }
        else if (s_ >= 48 && s_ < 66) { __syncthreads(); side_wait(side + 64, 16, ctl + CW_BAR);
            task_win(C, C.mt, 0, s_ - 48, lane, wave, (float*)lds); __syncthreads(); } }
    xcd_barrier(bar);
    { const pg8::Gemm g{C.main.HB, C.W1D, M, D, FF, FF}; const pg8::EpiResid<1, 0> E{C.main.base1, nullptr, C.main.XN, C.main.SSQ1}; GEMM_PHASE(g, E); }
    xcd_barrier(bar);
    { const pg8::Gemm g{C.main.XN, C.WIN, M, 2048, D, D}; PG8_LAS float* rst = (PG8_LAS float*)(ldsp + LDSCTL_OFF + 1024);
      { pg8::StaticOrder S_; S_.init(g.M, g.N, G, (int)blockIdx.x); pg8::rs_table_fill(C.main.SSQ1, S_, rst, tid); }
      const pg8::EpiWin E{C, rst, gtab}; GEMM_PHASE(g, E); }
    xcd_barrier(bar);
    { int k_ = 128; asm volatile("" : "+s"(k_)); const pg8::Gemm g{C.main.CKV, C.WUKV, M, 1024, k_, k_}; const pg8::EpiUkv E{gtab + 224, C.main.SSQCKV, C.main.SSQKPE, C.main.KPE, C.KM, C.VM, C.ROPE}; GEMM_PHASE(g, E); }
    { const int sb = (int)blockIdx.x - (G - 24);
      if (sb >= 0 && sb < 16) scan_block(C, sb, (float*)lds, tid);
      if (sb >= 16) { task_uqkv(C, C.mt, 8 + (sb - 16), lane, wave, (float*)lds); __syncthreads(); } }
    { int k_ = 256; asm volatile("" : "+s"(k_)); const pg8::Gemm g{C.main.CQ, C.WUQ, M, 768, k_, k_}; const pg8::EpiUq E{gtab + 128, C.main.SSQCQ, C.main.SSQQ, C.QM, C.ROPE}; GEMM_PHASE(g, E); }
    xcd_barrier(bar);
    { static_assert(MISC_OFF + 64 <= LDS_BYTES && att::LDS_BYTES <= LDSCTL_OFF, "attention LDS");
      attn_phase(C, (char*)lds, ctl, bar.x, (volatile LAS unsigned*)((LAS unsigned char*)lds + MISC_OFF) + 12); }
    xcd_barrier(bar);
    { const pg8::Gemm g{C.O, C.WOUT, M, D, D, D}; const pg8::EpiResid<0, 1> E{C.main.XN, nullptr, C.main.XN, C.SSQ2}; GEMM_PHASE(g, E); }
    xcd_barrier(bar);
    { const pg8::Gemm g{C.main.XN, C.W2GU, M, 2 * FF, D, D}; PG8_LAS float* rst = (PG8_LAS float*)(ldsp + LDSCTL_OFF + 1024);
      { pg8::StaticOrder S_; S_.init(g.M, g.N, G, (int)blockIdx.x); pg8::rs_table_fill(C.SSQ2, S_, rst, tid); }
      const pg8::EpiSwiglu E{C.main.HB, rst}; GEMM_PHASE(g, E); }
    xcd_barrier(bar);
    { const pg8::Gemm g{C.main.HB, C.W2D, M, D, FF, FF}; const pg8::EpiResid<1, 1> E{C.main.XN, C.out, nullptr, nullptr}; GEMM_PHASE(g, E); }
}

extern "C" void kernel_launch(void* const* d_in, const int* in_sizes, int n_in, void* d_out, int out_size, void* d_ws, size_t ws_size, hipStream_t stream) {
    static int grid = 0;
    if (grid == 0) {
        if (n_in != 22 || in_sizes[0] != M * D || out_size != M * D || ws_size < WS_END) { fprintf(stderr, "kernel_launch: unexpected shapes (n_in %d, in0 %d, out %d, ws %zu)\n", n_in, n_in > 0 ? in_sizes[0] : -1, out_size, ws_size); grid = -1; return; }
        int dev = 0, cus = 0, per_cu = 0;
        if (hipGetDevice(&dev) != hipSuccess || hipDeviceGetAttribute(&cus, hipDeviceAttributeMultiprocessorCount, dev) != hipSuccess) { grid = -1; return; }
        if (hipFuncSetAttribute((const void*)mega_fwd, hipFuncAttributeMaxDynamicSharedMemorySize, LDS_BYTES) != hipSuccess) { fprintf(stderr, "kernel_launch: hipFuncSetAttribute failed\n"); grid = -1; return; }
        if (hipOccupancyMaxActiveBlocksPerMultiprocessor(&per_cu, (const void*)mega_fwd, NWAVES * 64, LDS_BYTES) != hipSuccess || per_cu < 1) { fprintf(stderr, "kernel_launch: occupancy query reports %d blocks per CU\n", per_cu); grid = -1; return; }
        grid = cus;
    }
    if (grid < 0) return;
    if (hipMemsetAsync((char*)d_ws + WS_CTL, 0, CTL_ZERO_BYTES, stream) != hipSuccess) { fprintf(stderr, "kernel_launch: hipMemsetAsync of the control words failed\n"); return; }
    KArgs a{}; for (int i = 0; i < 22; ++i) a.in[i] = (const float*)d_in[i]; a.out = (float*)d_out; a.ws = (unsigned char*)d_ws;
    void* args[] = {&a};
    const hipError_t e = hipLaunchCooperativeKernel((const void*)mega_fwd, dim3(grid), dim3(NWAVES * 64), args, LDS_BYTES, stream);
    if (e != hipSuccess) fprintf(stderr, "kernel_launch: cooperative launch failed: %s (grid %d)\n", hipGetErrorString(e), grid);
}
```

```cpp
#include <hip/hip_runtime.h>
#include <cstdint>
#include <cstdio>
#include <type_traits>

typedef unsigned short bf16_t;
typedef short bf16x8 __attribute__((ext_vector_type(8)));
typedef float f32x4 __attribute__((ext_vector_type(4)));
typedef unsigned u32x4 __attribute__((ext_vector_type(4)));
typedef unsigned u32x2 __attribute__((ext_vector_type(2)));

constexpr int NB = 2, T = 8192, D = 1024, FF = 2816, M = NB * T, NMETA = 16;
constexpr int PR = 64 + T;
constexpr int NPOS = 16 + T;
constexpr int DQM = 96, DFK = 80, DV = 64;
constexpr float EPS = 1e-6f;
constexpr float LOG2E = 1.4426950408889634f;
constexpr float C2F = 0.125f * LOG2E;
constexpr float C2M = 0.10206207261596577f * LOG2E;

constexpr size_t KiB = 1024, MiB = 1u << 20;
constexpr size_t WS_CTL = 0;
constexpr size_t WS_W1GU = 1 * MiB, WS_W1D = 12 * MiB, WS_W2GU = 18 * MiB, WS_W2D = 29 * MiB, WS_WIN = 35 * MiB, WS_WOUT = 39 * MiB;
constexpr size_t WS_WUQ = 41 * MiB, WS_WUKV = 41 * MiB + 512 * KiB, WS_ROPE = 42 * MiB;
constexpr size_t WS_META = 43 * MiB + 512 * KiB;
constexpr size_t WS_XN = 44 * MiB, WS_CQ = 76 * MiB, WS_CKV = 84 * MiB, WS_KPE = 88 * MiB, WS_LOGF = 90 * MiB, WS_CUM = 90 * MiB + 512 * KiB;
constexpr size_t WS_SSQ1 = 91 * MiB + 256 * KiB, WS_SSQ2 = 92 * MiB + 256 * KiB, WS_SSQCQ = 93 * MiB + 256 * KiB, WS_SSQCKV = 93 * MiB + 512 * KiB, WS_SSQKPE = 93 * MiB + 768 * KiB, WS_SSQQ = 94 * MiB;
constexpr size_t WS_HB = 95 * MiB;
constexpr size_t WS_FQ = 95 * MiB, WS_FK = 111 * MiB + 256 * KiB, WS_FV = 131 * MiB + 512 * KiB, WS_QM = 147 * MiB + 768 * KiB, WS_KM = 172 * MiB, WS_VM = 196 * MiB + 256 * KiB, WS_O = 212 * MiB + 512 * KiB;
constexpr size_t WS_END = 256 * MiB;
static_assert(WS_FQ + (size_t)NB * 8 * PR * 64 * 2 <= WS_FK && WS_FK + (size_t)NB * 8 * PR * DFK * 2 <= WS_FV && WS_FV + (size_t)NB * 8 * PR * 64 * 2 <= WS_QM, "ws map 1");
static_assert(WS_QM + (size_t)NB * 8 * PR * DQM * 2 <= WS_KM && WS_KM + (size_t)NB * 8 * PR * DQM * 2 <= WS_VM && WS_VM + (size_t)NB * 8 * PR * 64 * 2 <= WS_O && WS_O + (size_t)M * D * 2 <= WS_END, "ws map 2");
static_assert(WS_ROPE + (size_t)NPOS * 16 * 8 <= WS_META && WS_CUM + (size_t)NB * 8 * PR * 4 <= WS_SSQ1 && WS_HB + (size_t)M * FF * 2 <= WS_END, "ws map 3");
constexpr size_t MO_XNM = 0, MO_HB = 32 * KiB, MO_H = 128 * KiB, MO_XN = 192 * KiB, MO_SSQ1 = 224 * KiB, MO_CQ = 228 * KiB, MO_SSQCQ = 236 * KiB, MO_CKV = 237 * KiB, MO_SSQCKV = 241 * KiB,
                 MO_KPE = 242 * KiB, MO_SSQKPE = 244 * KiB, MO_LOGF = 245 * KiB, MO_SSQQ = 246 * KiB, MO_FKS = 256 * KiB, MO_FVS = 272 * KiB;

__device__ __forceinline__ float bf2f(bf16_t v) { return __uint_as_float((unsigned)v << 16); }
__device__ __forceinline__ unsigned f2bf(float f) { unsigned u = __float_as_uint(f); return (u + 0x7fffu + ((u >> 16) & 1u)) >> 16; }
__device__ __forceinline__ unsigned pk2(float lo, float hi) { return f2bf(lo) | (f2bf(hi) << 16); }
__device__ __forceinline__ float rsum16(float v) { v += __shfl_xor(v, 1); v += __shfl_xor(v, 2); v += __shfl_xor(v, 4); v += __shfl_xor(v, 8); return v; }
__device__ __forceinline__ float wave_sum(float v) {
#pragma unroll
    for (int o = 1; o < 64; o <<= 1) v += __shfl_xor(v, o);
    return v;
}
__device__ __forceinline__ float sum16f(const float* p) { const f32x4 a = ((const f32x4*)p)[0], b = ((const f32x4*)p)[1], c = ((const f32x4*)p)[2], d = ((const f32x4*)p)[3];
    return ((a[0] + a[1]) + (a[2] + a[3])) + ((b[0] + b[1]) + (b[2] + b[3])) + ((c[0] + c[1]) + (c[2] + c[3])) + ((d[0] + d[1]) + (d[2] + d[3])); }
__device__ __forceinline__ float sum4f(const float* p) { const f32x4 a = *(const f32x4*)p; return (a[0] + a[1]) + (a[2] + a[3]); }
__device__ __forceinline__ float silu_mul(float g, float u) { return g / (1.0f + __expf(-g)) * u; }
__device__ __forceinline__ float log_sigmoid(float x) { return fminf(x, 0.f) - 0.6931471805599453f * __builtin_amdgcn_logf(1.0f + __builtin_amdgcn_exp2f(-LOG2E * fabsf(x))); }

__host__ __device__ __forceinline__ int gu_row_gate(int c) { return 256 * (c >> 7) + (c & 127); }
__host__ __device__ __forceinline__ int rope_slot(int dd) { return 8 * ((dd & 15) >> 2) + 4 * (dd >> 4) + (dd & 3); }
__host__ __device__ __forceinline__ int win_row(int s) {
    if (s < 256) return s;
    if (s < 384) return 256 + (s - 256);
    if (s < 416) return 256 + 128 + rope_slot(s - 384);
    if (s < 1952) { const int i = s - 416, which = i >> 9, head = (i & 511) >> 6, d = i & 63; return 256 * (2 + which * 2 + (head >> 2)) + 128 * (d >> 5) + 32 * (head & 3) + (d & 31); }
    return 256 + 160 + (s - 1952);
}
__host__ __device__ __forceinline__ int wuq_row(int s) { const int h = s / 96, d = s % 96;
    if (d < 64) return 256 * (h >> 2) + 128 * (d >> 5) + 32 * (h & 3) + (d & 31);
    return 512 + 128 * (h & 1) + 32 * (h >> 1) + rope_slot(d - 64); }
__host__ __device__ __forceinline__ int wukv_row(int s) { const int h = s >> 7, d = s & 127;
    if (d < 64) return 256 * (h >> 2) + 128 * (d >> 5) + 32 * (h & 3) + (d & 31);
    const int e = d - 64; return 256 * (2 + (h >> 2)) + 128 * (e >> 5) + 32 * (h & 3) + (e & 31); }

struct KArgs { const float* in[22]; float* out; unsigned char* ws; };
struct RowSet {
    int nrows, meta;
    const bf16_t* XN1; const float* base1; bf16_t* HB; float* H; bf16_t* XN; float* SSQ1;
    bf16_t* CQ; float* SSQCQ; bf16_t* CKV; float* SSQCKV; float* KPE; float* SSQKPE; float* LOGF; float* SSQQ;
};
struct Ctx {
    const float *x, *meta, *g_ffn1, *w1g, *w1u, *w1d, *g_mix, *w_in, *g_cq, *w_uq, *g_ckv, *w_ukv, *g_q_mla, *g_k_mla, *b_forget, *g_q_fox, *g_k_fox, *w_out, *g_ffn2, *w2g, *w2u, *w2d;
    float* out; unsigned char* ws;
    bf16_t *W1GU, *W1D, *W2GU, *W2D, *WIN, *WOUT, *WUQ, *WUKV; float* ROPE;
    bf16_t *FQ, *FK, *FV, *QM, *KM, *VM, *O; float* CUM; float* SSQ2; bf16_t *MFK, *MFV;
    RowSet main, mt;
};
__device__ __forceinline__ Ctx make_ctx(const KArgs& a) {
    Ctx c;
    c.x = a.in[0]; c.meta = a.in[1]; c.g_ffn1 = a.in[2]; c.w1g = a.in[3]; c.w1u = a.in[4]; c.w1d = a.in[5]; c.g_mix = a.in[6]; c.w_in = a.in[7]; c.g_cq = a.in[8]; c.w_uq = a.in[9]; c.g_ckv = a.in[10];
    c.w_ukv = a.in[11]; c.g_q_mla = a.in[12]; c.g_k_mla = a.in[13]; c.b_forget = a.in[14]; c.g_q_fox = a.in[15]; c.g_k_fox = a.in[16]; c.w_out = a.in[17]; c.g_ffn2 = a.in[18]; c.w2g = a.in[19]; c.w2u = a.in[20]; c.w2d = a.in[21];
    c.out = a.out; c.ws = a.ws; unsigned char* ws = a.ws;
    c.W1GU = (bf16_t*)(ws + WS_W1GU); c.W1D = (bf16_t*)(ws + WS_W1D); c.W2GU = (bf16_t*)(ws + WS_W2GU); c.W2D = (bf16_t*)(ws + WS_W2D); c.WIN = (bf16_t*)(ws + WS_WIN); c.WOUT = (bf16_t*)(ws + WS_WOUT);
    c.WUQ = (bf16_t*)(ws + WS_WUQ); c.WUKV = (bf16_t*)(ws + WS_WUKV); c.ROPE = (float*)(ws + WS_ROPE);
    c.FQ = (bf16_t*)(ws + WS_FQ); c.FK = (bf16_t*)(ws + WS_FK); c.FV = (bf16_t*)(ws + WS_FV); c.QM = (bf16_t*)(ws + WS_QM); c.KM = (bf16_t*)(ws + WS_KM); c.VM = (bf16_t*)(ws + WS_VM); c.O = (bf16_t*)(ws + WS_O);
    c.CUM = (float*)(ws + WS_CUM); c.SSQ2 = (float*)(ws + WS_SSQ2);
    RowSet& m = c.main; m.nrows = M; m.meta = 0; m.XN1 = (bf16_t*)(ws + WS_XN); m.base1 = c.x; m.HB = (bf16_t*)(ws + WS_HB); m.H = a.out; m.XN = (bf16_t*)(ws + WS_XN); m.SSQ1 = (float*)(ws + WS_SSQ1);
    m.CQ = (bf16_t*)(ws + WS_CQ); m.SSQCQ = (float*)(ws + WS_SSQCQ); m.CKV = (bf16_t*)(ws + WS_CKV); m.SSQCKV = (float*)(ws + WS_SSQCKV); m.KPE = (float*)(ws + WS_KPE); m.SSQKPE = (float*)(ws + WS_SSQKPE);
    m.LOGF = (float*)(ws + WS_LOGF); m.SSQQ = (float*)(ws + WS_SSQQ);
    unsigned char* mw = ws + WS_META; RowSet& t = c.mt; t.nrows = NMETA; t.meta = 1; t.XN1 = (bf16_t*)(mw + MO_XNM); t.base1 = c.meta; t.HB = (bf16_t*)(mw + MO_HB); t.H = (float*)(mw + MO_H); t.XN = (bf16_t*)(mw + MO_XN);
    t.SSQ1 = (float*)(mw + MO_SSQ1); t.CQ = (bf16_t*)(mw + MO_CQ); t.SSQCQ = (float*)(mw + MO_SSQCQ); t.CKV = (bf16_t*)(mw + MO_CKV); t.SSQCKV = (float*)(mw + MO_SSQCKV); t.KPE = (float*)(mw + MO_KPE);
    t.SSQKPE = (float*)(mw + MO_SSQKPE); t.LOGF = (float*)(mw + MO_LOGF); t.SSQQ = (float*)(mw + MO_SSQQ);
    c.MFK = (bf16_t*)(mw + MO_FKS); c.MFV = (bf16_t*)(mw + MO_FVS);
    return c;
}
__device__ __forceinline__ size_t arow(int b, int h, int p) { return (size_t)((b * 8 + h) * PR + p); }
__device__ __forceinline__ size_t kaddr(int b, int h, int p, int d, int DK) { return ((size_t)((b * 8 + h) * PR + (p & ~63))) * DK + (size_t)((d >> 3) * 512 + (p & 63) * 8 + (d & 7)); }
__device__ __forceinline__ size_t vaddr(int b, int h, int p, int d) { return ((size_t)((b * 8 + h) * PR + (p & ~63))) * 64 + (size_t)((d >> 5) * 2048 + (p & 63) * 32 + (d & 31)); }

constexpr int TSCR = 32 * 68;
__device__ __forceinline__ void st_wt(bf16_t* p, bf16_t v) { __hip_atomic_store(p, v, __ATOMIC_RELAXED, __HIP_MEMORY_SCOPE_AGENT); }
__device__ __forceinline__ void st_wt(float* p, float v) { __hip_atomic_store(p, v, __ATOMIC_RELAXED, __HIP_MEMORY_SCOPE_AGENT); }
template <class MapF>
__device__ __forceinline__ void p0_transpose_item(const float* W, int K, int N, const float* gain, bf16_t* WT, MapF map, float* scr_, int item, int lane) {
    asm volatile("" : "+v"(lane));
    unsigned* scr = (unsigned*)scr_;
    const int nblk = (N + 63) / 64, kb = item / nblk, nb = item % nblk, k0 = 64 * kb, n0 = 64 * nb;
    const int x = lane & 15, kr = lane >> 4, nq = n0 + 4 * x;
    f32x4 e[8], o[8];
#pragma unroll
    for (int j = 0; j < 8; ++j) { const int k = k0 + 8 * j + 2 * kr;
        if (nq < N) { e[j] = *(const f32x4*)(W + (size_t)k * N + nq); o[j] = *(const f32x4*)(W + (size_t)(k + 1) * N + nq); } else { e[j] = (f32x4){0.f, 0.f, 0.f, 0.f}; o[j] = e[j]; } }
#pragma unroll
    for (int j = 0; j < 8; ++j) { const int k = k0 + 8 * j + 2 * kr; float ge = 1.f, go = 1.f; if (gain) { ge = gain[k]; go = gain[k + 1]; }
        u32x4 p; p.x = pk2(e[j].x * ge, o[j].x * go); p.y = pk2(e[j].y * ge, o[j].y * go); p.z = pk2(e[j].z * ge, o[j].z * go); p.w = pk2(e[j].w * ge, o[j].w * go);
        *(u32x4*)(scr + (4 * j + kr) * 68 + 4 * x) = p; }
    asm volatile("s_waitcnt vmcnt(0) lgkmcnt(0)" ::: "memory");
    const int c = lane >> 3;
#pragma unroll
    for (int j = 0; j < 8; ++j) { const int n = (lane & 7) + 8 * j; if (n0 + n < N) { const unsigned* t = scr + (4 * c) * 68 + n;
        const u32x4 v = {t[0], t[68], t[136], t[204]};
        *(u32x4*)(WT + (size_t)map(n0 + n) * K + k0 + 8 * c) = v; } }
    asm volatile("s_waitcnt vmcnt(0) lgkmcnt(0)" ::: "memory");
}
struct MapId { __device__ int operator()(int n) const { return n; } };
struct MapGate { __device__ int operator()(int n) const { return gu_row_gate(n); } };
struct MapUp { __device__ int operator()(int n) const { return gu_row_gate(n) + 128; } };
struct MapWin { __device__ int operator()(int n) const { return win_row(n); } };
struct MapWuq { __device__ int operator()(int n) const { return wuq_row(n); } };
struct MapWukv { __device__ int operator()(int n) const { return wukv_row(n); } };

__device__ __constant__ double INV_FREQ[16] = {1.0, 0.5623413251903491, 0.31622776601683794, 0.1778279410038923, 0.1, 0.05623413251903491, 0.03162277660168379, 0.01778279410038923,
                                               0.01, 0.005623413251903491, 0.0031622776601683794, 0.0017782794100389228, 0.001, 0.0005623413251903491, 0.00031622776601683794, 0.00017782794100389227};
__device__ __forceinline__ void sincos_d(double x, float& s, float& c) {
    const double k = rint(x * 0.15915494309189535); const double r = fma(-k, 6.283185307179586, x) - k * 2.4492935982947064e-16; const double r2 = r * r;
    double ss = 1.0 / 15511210043330985984000000.0, cc = 1.0 / 620448401733239439360000.0;
    const double sf[12] = {1.0 / 25852016738884976640000.0, 1.0 / 51090942171709440000.0, 1.0 / 121645100408832000.0, 1.0 / 355687428096000.0, 1.0 / 1307674368000.0, 1.0 / 6227020800.0, 1.0 / 39916800.0,
                           1.0 / 362880.0, 1.0 / 5040.0, 1.0 / 120.0, 1.0 / 6.0, 1.0};
    const double cf[12] = {1.0 / 1124000727777607680000.0, 1.0 / 2432902008176640000.0, 1.0 / 6402373705728000.0, 1.0 / 20922789888000.0, 1.0 / 87178291200.0, 1.0 / 479001600.0, 1.0 / 3628800.0,
                           1.0 / 40320.0, 1.0 / 720.0, 1.0 / 24.0, 1.0 / 2.0, 1.0};
#pragma unroll
    for (int i = 0; i < 12; ++i) { ss = fma(-ss, r2, sf[i]); cc = fma(-cc, r2, cf[i]); }
    s = (float)(ss * r); c = (float)cc;
}
__device__ __forceinline__ void rms_row_to_bf16(const float* xrow, bf16_t* orow, int lane) {
    const f32x4* xr = (const f32x4*)xrow + lane; f32x4 v[4]; float s = 0.f;
#pragma unroll
    for (int j = 0; j < 4; ++j) { v[j] = xr[64 * j]; s += (v[j].x * v[j].x + v[j].y * v[j].y) + (v[j].z * v[j].z + v[j].w * v[j].w); }
    const float rstd = 1.0f / sqrtf(wave_sum(s) * (1.f / D) + EPS);
    unsigned long long* o8 = (unsigned long long*)orow + lane;
#pragma unroll
    for (int j = 0; j < 4; ++j) o8[64 * j] = (unsigned long long)pk2(v[j].x * rstd, v[j].y * rstd) | ((unsigned long long)pk2(v[j].z * rstd, v[j].w * rstd) << 32);
}
__device__ __forceinline__ void rms_row2_to_bf16(const float* x0, const float* x1, bf16_t* o0, bf16_t* o1, int lane) {
    const f32x4* xa = (const f32x4*)x0 + lane; const f32x4* xb = (const f32x4*)x1 + lane; f32x4 va[4], vb[4]; float sa = 0.f, sb = 0.f;
#pragma unroll
    for (int j = 0; j < 4; ++j) { va[j] = xa[64 * j]; vb[j] = xb[64 * j]; }
#pragma unroll
    for (int j = 0; j < 4; ++j) { sa += (va[j].x * va[j].x + va[j].y * va[j].y) + (va[j].z * va[j].z + va[j].w * va[j].w); sb += (vb[j].x * vb[j].x + vb[j].y * vb[j].y) + (vb[j].z * vb[j].z + vb[j].w * vb[j].w); }
    const float ra = 1.0f / sqrtf(wave_sum(sa) * (1.f / D) + EPS), rb = 1.0f / sqrtf(wave_sum(sb) * (1.f / D) + EPS);
    unsigned long long* pa = (unsigned long long*)o0 + lane; unsigned long long* pb = (unsigned long long*)o1 + lane;
#pragma unroll
    for (int j = 0; j < 4; ++j) { pa[64 * j] = (unsigned long long)pk2(va[j].x * ra, va[j].y * ra) | ((unsigned long long)pk2(va[j].z * ra, va[j].w * ra) << 32);
                                  pb[64 * j] = (unsigned long long)pk2(vb[j].x * rb, vb[j].y * rb) | ((unsigned long long)pk2(vb[j].z * rb, vb[j].w * rb) << 32); }
}
constexpr int I_GU = (D / 64) * (FF / 64), I_DN = (FF / 64) * (D / 64), I_IN = (D / 64) * ((1960 + 63) / 64), I_OUT = (D / 64) * (D / 64), I_UQ = (256 / 64) * (768 / 64), I_UKV = (128 / 64) * (1024 / 64);
__device__ __forceinline__ void p0_prologue(const Ctx& C, float* scr, int gw, int gwi, int NGW, int lane) {
    for (int it = gwi; it < 2 * I_GU + I_DN + I_IN; it += NGW) {
        int r = it;
        if (r < I_GU) { p0_transpose_item(C.w1g, D, FF, C.g_ffn1, C.W1GU, MapGate(), scr, r, lane); continue; } r -= I_GU;
        if (r < I_GU) { p0_transpose_item(C.w1u, D, FF, C.g_ffn1, C.W1GU, MapUp(), scr, r, lane); continue; } r -= I_GU;
        if (r < I_DN) { p0_transpose_item(C.w1d, FF, D, nullptr, C.W1D, MapId(), scr, r, lane); continue; } r -= I_DN;
        p0_transpose_item(C.w_in, D, 1960, C.g_mix, C.WIN, MapWin(), scr, r, lane);
    }
    for (int i = gw * 64 + lane; i < 88 * 128; i += NGW * 64) { const int row = 256 + 168 + i / 128, ch = i % 128; *(u32x4*)(C.WIN + (size_t)row * D + ch * 8) = (u32x4){0u, 0u, 0u, 0u}; }
    for (int m = gw; m < M / 2; m += NGW) rms_row2_to_bf16(C.x + (size_t)m * D, C.x + (size_t)(m + M / 2) * D, (bf16_t*)C.main.XN1 + (size_t)m * D, (bf16_t*)C.main.XN1 + (size_t)(m + M / 2) * D, lane);
    for (int m = gw; m < NMETA; m += NGW) rms_row_to_bf16(C.meta + (size_t)m * D, (bf16_t*)C.mt.XN1 + (size_t)m * D, lane);
    for (int i = gw * 64 + lane; i < NPOS * 16; i += NGW * 64) { const int pos = i >> 4, f = i & 15; float s, c; sincos_d((double)pos * INV_FREQ[f], s, c); C.ROPE[2 * i] = c; C.ROPE[2 * i + 1] = s; }
}
template <int PART> __device__ __forceinline__ void p0_late(const Ctx& C, float* scr, int gw, int NGW, int lane) {
    if (PART == 0) {
        for (int it = gw; it < I_OUT + I_UQ + I_UKV; it += NGW) {
            int r = it;
            if (r < I_OUT) { p0_transpose_item(C.w_out, D, D, nullptr, C.WOUT, MapId(), scr, r, lane); continue; } r -= I_OUT;
            if (r < I_UQ) { p0_transpose_item(C.w_uq, 256, 768, C.g_cq, C.WUQ, MapWuq(), scr, r, lane); continue; } r -= I_UQ;
            p0_transpose_item(C.w_ukv, 128, 1024, C.g_ckv, C.WUKV, MapWukv(), scr, r, lane);
        }
    } else {
        for (int it = gw; it < 2 * I_GU + I_DN; it += NGW) {
            int r = it;
            if (r < I_GU) { p0_transpose_item(C.w2g, D, FF, C.g_ffn2, C.W2GU, MapGate(), scr, r, lane); continue; } r -= I_GU;
            if (r < I_GU) { p0_transpose_item(C.w2u, D, FF, C.g_ffn2, C.W2GU, MapUp(), scr, r, lane); continue; } r -= I_GU;
            p0_transpose_item(C.w2d, FF, D, nullptr, C.W2D, MapId(), scr, r, lane);
        }
    }
}

template <int NT, int UNR>
__device__ __forceinline__ void wg_gemm16_steps(const bf16_t* ap, const bf16_t* const (&bp)[NT], int k0, f32x4 (&acc)[NT]) {
    bf16x8 a[UNR], b[UNR][NT];
#pragma unroll
    for (int u = 0; u < UNR; ++u) { a[u] = *(const bf16x8*)(ap + k0 + 32 * u);
#pragma unroll
        for (int t = 0; t < NT; ++t) b[u][t] = *(const bf16x8*)(bp[t] + k0 + 32 * u); }
#pragma unroll
    for (int u = 0; u < UNR; ++u)
#pragma unroll
        for (int t = 0; t < NT; ++t) acc[t] = __builtin_amdgcn_mfma_f32_16x16x32_bf16(a[u], b[u][t], acc[t], 0, 0, 0);
}
template <int NT, int NSPLIT, int UNR>
__device__ __forceinline__ void wg_gemm16(const bf16_t* ap, const bf16_t* const (&bp)[NT], int K, f32x4 (&acc)[NT], int wave, int lane, float* red) {
    const int ksl = K / NSPLIT, kb = wave * ksl, ke = kb + ksl;
    if (wave < NSPLIT) {
        int k0 = kb;
        for (; k0 + 32 * UNR <= ke; k0 += 32 * UNR) wg_gemm16_steps<NT, UNR>(ap, bp, k0, acc);
        { const int r = (ke - k0) >> 5;
          if (UNR > 3 && r == 3) wg_gemm16_steps<NT, 3>(ap, bp, k0, acc); else if (UNR > 2 && r == 2) wg_gemm16_steps<NT, 2>(ap, bp, k0, acc); else for (; k0 < ke; k0 += 32) wg_gemm16_steps<NT, 1>(ap, bp, k0, acc); }
#pragma unroll
        for (int t = 0; t < NT; ++t) *(f32x4*)(red + (size_t)((wave * NT + t) * 64 + lane) * 4) = acc[t];
    }
    __syncthreads();
    if (wave == 0) {
#pragma unroll
        for (int t = 0; t < NT; ++t) { f32x4 sum = *(const f32x4*)(red + (size_t)(t * 64 + lane) * 4);
#pragma unroll
            for (int w = 1; w < NSPLIT; ++w) sum += *(const f32x4*)(red + (size_t)((w * NT + t) * 64 + lane) * 4);
            acc[t] = sum; asm volatile("" ::: "memory"); }
    }
}
__device__ __forceinline__ void task_gateup(const bf16_t* A, const bf16_t* Wgu, const float* ssq, bf16_t* HB, int task, int lane, int wave, float* red) {
    asm volatile("" : "+v"(lane));
    const int ncb = FF / 16, rg = task / ncb, cb = task % ncb, c = lane & 15, q = lane >> 4, hc = cb * 16 + c;
    const bf16_t* ap = A + (size_t)(rg * 16 + c) * D + 8 * q;
    const bf16_t* g0 = Wgu + (size_t)gu_row_gate(hc) * D + 8 * q;
    const bf16_t* const bp[2] = {g0, g0 + (size_t)128 * D};
    f32x4 acc[2]; acc[0] = (f32x4){0.f, 0.f, 0.f, 0.f}; acc[1] = acc[0];
    wg_gemm16<2, 8, 4>(ap, bp, D, acc, wave, lane, red); if (wave != 0) return;
#pragma unroll
    for (int i = 0; i < 4; ++i) { const int row = rg * 16 + 4 * q + i; const float rs = ssq ? 1.0f / sqrtf(sum16f(ssq + (size_t)row * 16) * (1.f / D) + EPS) : 1.f;
        st_wt(HB + (size_t)row * FF + hc, (bf16_t)f2bf(silu_mul(acc[0][i] * rs, acc[1][i] * rs))); }
}
__device__ __forceinline__ void task_down(const bf16_t* A, int K, const bf16_t* Wt, const float* base, float* out, float scale, bf16_t* XN, float* SSQ, int task, int lane, int wave, float* red) {
    asm volatile("" : "+v"(lane));
    const int rg = task >> 4, cb = task & 15, c = lane & 15, q = lane >> 4;
    const bf16_t* ap = A + (size_t)(rg * 16 + c) * K + 8 * q;
    const bf16_t* b0 = Wt + (size_t)(cb * 64 + c) * K + 8 * q;
    const bf16_t* const bp[4] = {b0, b0 + (size_t)16 * K, b0 + (size_t)32 * K, b0 + (size_t)48 * K};
    f32x4 acc[4];
#pragma unroll
    for (int t = 0; t < 4; ++t) acc[t] = (f32x4){0.f, 0.f, 0.f, 0.f};
    wg_gemm16<4, 8, 4>(ap, bp, K, acc, wave, lane, red); if (wave != 0) return;
#pragma unroll
    for (int i = 0; i < 4; ++i) { const int row = rg * 16 + 4 * q + i; float sq = 0.f;
#pragma unroll
        for (int t = 0; t < 4; ++t) { const size_t o = (size_t)row * D + cb * 64 + t * 16 + c; const float v = base[o] + scale * acc[t][i]; st_wt(out + o, v); if (XN) st_wt(XN + o, (bf16_t)f2bf(v)); sq += v * v; }
        sq = rsum16(sq); if (SSQ && c == 0) st_wt(SSQ + (size_t)row * 16 + cb, sq); }
}
__device__ __forceinline__ void task_win(const Ctx& C, const RowSet& R, int rg, int job, int lane, int wave, float* red) {
    asm volatile("" : "+v"(lane));
    const int c = lane & 15, q = lane >> 4;
    const bf16_t* ap = R.XN + (size_t)(rg * 16 + c) * D + 8 * q;
    if (job == 0) {
        const bf16_t* bp[8];
#pragma unroll
        for (int t = 0; t < 8; ++t) bp[t] = C.WIN + (size_t)win_row(256 + 16 * t + c) * D + 8 * q;
        f32x4 acc[8];
#pragma unroll
        for (int t = 0; t < 8; ++t) acc[t] = (f32x4){0.f, 0.f, 0.f, 0.f};
        wg_gemm16<8, 8, 2>(ap, bp, D, acc, wave, lane, red); if (wave != 0) return;
#pragma unroll
        for (int i = 0; i < 4; ++i) { const int row = rg * 16 + 4 * q + i; const float rs = 1.0f / sqrtf(sum16f(R.SSQ1 + (size_t)row * 16) * (1.f / D) + EPS); float sq = 0.f;
#pragma unroll
            for (int t = 0; t < 8; ++t) { const float v = acc[t][i] * rs; sq += v * v; R.CKV[(size_t)row * 128 + 16 * t + c] = (bf16_t)f2bf(v); }
            sq = rsum16(sq); if (c == 0) *(f32x4*)(R.SSQCKV + (size_t)row * 4) = (f32x4){sq, 0.f, 0.f, 0.f}; }
    } else if (job == 1) {
        const bf16_t* bp[3];
#pragma unroll
        for (int t = 0; t < 2; ++t) bp[t] = C.WIN + (size_t)win_row(384 + 16 * t + c) * D + 8 * q;
        bp[2] = C.WIN + (size_t)(c < 8 ? win_row(1952 + c) : 256 + 168 + c) * D + 8 * q;
        f32x4 acc[3];
#pragma unroll
        for (int t = 0; t < 3; ++t) acc[t] = (f32x4){0.f, 0.f, 0.f, 0.f};
        wg_gemm16<3, 8, 4>(ap, bp, D, acc, wave, lane, red); if (wave != 0) return;
#pragma unroll
        for (int i = 0; i < 4; ++i) { const int row = rg * 16 + 4 * q + i; const float rs = 1.0f / sqrtf(sum16f(R.SSQ1 + (size_t)row * 16) * (1.f / D) + EPS); float sp = 0.f;
#pragma unroll
            for (int t = 0; t < 2; ++t) { const float v = acc[t][i] * rs; sp += v * v; R.KPE[(size_t)row * 32 + 16 * t + c] = v; }
            sp = rsum16(sp); if (c == 0) R.SSQKPE[row] = sp;
            if (c < 8) R.LOGF[(size_t)row * 8 + c] = log_sigmoid(acc[2][i] * rs + C.b_forget[c]); }
    } else {
        const int which = 1 + ((job - 2) >> 3), h = (job - 2) & 7;
        const bf16_t* bp[4];
#pragma unroll
        for (int t = 0; t < 4; ++t) bp[t] = C.WIN + (size_t)win_row(416 + which * 512 + h * 64 + 16 * t + c) * D + 8 * q;
        f32x4 acc[4];
#pragma unroll
        for (int t = 0; t < 4; ++t) acc[t] = (f32x4){0.f, 0.f, 0.f, 0.f};
        wg_gemm16<4, 8, 4>(ap, bp, D, acc, wave, lane, red); if (wave != 0) return;
#pragma unroll
        for (int i = 0; i < 4; ++i) { const int row = rg * 16 + 4 * q + i; const float rs = 1.0f / sqrtf(sum16f(R.SSQ1 + (size_t)row * 16) * (1.f / D) + EPS); float sq = 0.f; float v[4];
#pragma unroll
            for (int t = 0; t < 4; ++t) { v[t] = acc[t][i] * rs; sq += v[t] * v[t]; }
            sq = rsum16(sq); const float r = 1.0f / sqrtf(sq * (1.f / 64.f) + EPS);
#pragma unroll
            for (int t = 0; t < 4; ++t) { const int d = 16 * t + c;
                if (which == 1) C.MFK[(row * 8 + h) * 64 + d] = (bf16_t)f2bf(v[t] * r * C.g_k_fox[d]);
                else C.MFV[(row * 8 + h) * 64 + d] = (bf16_t)f2bf(v[t]); } }
    }
}
__device__ __forceinline__ void task_uqkv(const Ctx& C, const RowSet& R, int task, int lane, int wave, float* red) {
    asm volatile("" : "+v"(lane));
    const int rg = task >> 4, job = task & 15, h = job & 7, c = lane & 15, q = lane >> 4;
    int rows[4];
#pragma unroll
    for (int i = 0; i < 4; ++i) rows[i] = rg * 16 + 4 * q + i;
    {
        const bf16_t* ap = R.CKV + (size_t)(rg * 16 + c) * 128 + 8 * q;
        const bf16_t* bp[8];
#pragma unroll
        for (int t = 0; t < 8; ++t) bp[t] = C.WUKV + (size_t)wukv_row(h * 128 + 16 * t + c) * 128 + 8 * q;
        f32x4 acc[8];
#pragma unroll
        for (int t = 0; t < 8; ++t) acc[t] = (f32x4){0.f, 0.f, 0.f, 0.f};
        wg_gemm16<8, 4, 1>(ap, bp, 128, acc, wave, lane, red); if (wave != 0) return;
#pragma unroll
        for (int i = 0; i < 4; ++i) { const int row = rows[i]; const float rs = 1.0f / sqrtf(sum4f(R.SSQCKV + (size_t)row * 4) * (1.f / 128.f) + EPS);
            float v[8], s0 = 0.f;
#pragma unroll
            for (int t = 0; t < 8; ++t) { v[t] = acc[t][i] * rs; if (t < 4) s0 += v[t] * v[t]; }
            s0 = rsum16(s0); const float rk = 1.0f / sqrtf((s0 + R.SSQKPE[row]) * (1.f / 96.f) + EPS);
            const int p = R.meta ? 48 + row : 64 + (row & (T - 1)); const int b0 = R.meta ? 0 : row >> 13, b1 = R.meta ? 2 : b0 + 1;
            const float cs = C.ROPE[(size_t)(p - 48) * 32 + 2 * c], sn = C.ROPE[(size_t)(p - 48) * 32 + 2 * c + 1];
            const float x1 = R.KPE[(size_t)row * 32 + c] * rk * C.g_k_mla[64 + c], x2 = R.KPE[(size_t)row * 32 + 16 + c] * rk * C.g_k_mla[80 + c];
            for (int b = b0; b < b1; ++b) {
#pragma unroll
                for (int t = 0; t < 4; ++t) { C.KM[kaddr(b, h, p, 16 * t + c, DQM)] = (bf16_t)f2bf(v[t] * rk * C.g_k_mla[16 * t + c]); C.VM[vaddr(b, h, p, 16 * t + c)] = (bf16_t)f2bf(v[4 + t]); }
                C.KM[kaddr(b, h, p, 64 + c, DQM)] = (bf16_t)f2bf(x1 * cs - x2 * sn); C.KM[kaddr(b, h, p, 80 + c, DQM)] = (bf16_t)f2bf(x2 * cs + x1 * sn); } }
    }
}


namespace pg8 {
#define PG8_LAS __attribute__((address_space(3)))
typedef unsigned short bf16_t;
typedef short bf16x8 __attribute__((ext_vector_type(8)));
typedef float f32x4 __attribute__((ext_vector_type(4)));
typedef unsigned u32x4 __attribute__((ext_vector_type(4)));
constexpr int BM = 256, BK = 64, HALF = 128, HTB = HALF * BK * 2  , STAGE_BYTES = 8 * HTB, NXCD = 8, WGM = 8;

__host__ __device__ __forceinline__ int lds_byte(int r, int c) { const int st = (r >> 4) * 2 + (c >> 5), rr = r & 15, cc = c & 31, ob = rr * 64 + cc * 2; return st * 1024 + (ob ^ (((ob >> 9) & 1) << 5)); }
__host__ __device__ __forceinline__ void stage_rc(int b, int& R, int& C) { const int st = b / 1024, sb = b % 1024, swz = sb ^ (((sb >> 9) & 1) << 5); R = (st >> 1) * 16 + swz / 64; C = (st & 1) * 32 + (swz % 64) / 2; }
__host__ __device__ __forceinline__ int perm32(int rho) { const int n = rho >> 4, i = rho & 15; return 8 * (i >> 2) + 4 * n + (i & 3); }

struct Unit { int pm, pn, idx; };
struct Gemm { const bf16_t* A; const bf16_t* Bt; int M, N, K, lda; };

struct StaticOrder {
    int nM, nN, nwg, G, c;
    __host__ __device__ void init(int M, int N, int G_, int c_) { nM = M / BM; nN = N / BM; nwg = nM * nN; G = G_; c = c_; }
    __host__ __device__ bool next(int i, Unit& u) const {
        const long L = (long)i * G + c; if (L >= nwg) return false;
        int wgid = (int)L; { const int q = nwg / NXCD, r = nwg % NXCD, xcd = wgid % NXCD, off = wgid / NXCD; wgid = (xcd < r ? xcd * (q + 1) : r * (q + 1) + (xcd - r) * q) + off; }
        const int nig = WGM * nN, gid = wgid / nig, fm = gid * WGM, gsz = (nM - fm) < WGM ? (nM - fm) : WGM;
        u.pm = fm + ((wgid % nig) % gsz); u.pn = (wgid % nig) / gsz; u.idx = i; return true;
    }
    __device__ __forceinline__ void a_ready(const Unit&) const {}
    __device__ __forceinline__ void done(const Unit&) const {}
};
__device__ __forceinline__ unsigned cvt_pk_bf16(float lo, float hi) { unsigned r; asm volatile("v_cvt_pk_bf16_f32 %0, %1, %2" : "=v"(r) : "v"(lo), "v"(hi)); return r; }
typedef float f32x2 __attribute__((ext_vector_type(2)));
template <class Epi, class Sched, bool ALIGN_EPI = false, bool SP2 = false>
__device__ __forceinline__ void gemm_phase(PG8_LAS unsigned char* lds, const Gemm g, const Sched& S, const Epi& E, const int tid) {
    const int wid = __builtin_amdgcn_readfirstlane(tid >> 6), lane = tid & 63, wr = wid >> 2, wc = wid & 3, fr = lane & 15, fq = lane >> 4;
    const int K = g.K, nt = K / BK;
    unsigned voffA[2], voffB[2];
#pragma unroll
    for (int i = 0; i < 2; ++i) { int R, C; stage_rc(tid * 16 + i * 8192, R, C); const int Rb = Epi::PERM ? ((R & ~31) + perm32(R & 31)) : R;
        voffA[i] = (unsigned)(R * g.lda + C) * 2u; voffB[i] = (unsigned)(Rb * K + C) * 2u; }
    const size_t kstep = (size_t)(BK * 2);
    const size_t hstep = (size_t)HALF * K * 2, hstepA = (size_t)HALF * g.lda * 2;
    const size_t tstep = 2 * hstep, tstepA = 2 * hstepA;
    const unsigned ldsw = (unsigned)wid * 1024u;
    const int aoff = lds_byte(wr * 64 + fr, fq * 8), boff = lds_byte(wc * 32 + fr, fq * 8);
#define PG8_SA(b, h) (((b) * 2 + (h)) * HTB)
#define PG8_SB(b, h) ((4 + (b) * 2 + (h)) * HTB)
#define PG8_STAGE(bufoff, gbase, voff) do { _Pragma("unroll") for (int _i = 0; _i < 2; ++_i) \
        __builtin_amdgcn_global_load_lds((const unsigned*)((const char*)(gbase) + (voff)[_i]), (PG8_LAS unsigned*)(lds + (bufoff) + ldsw + _i * 8192), 16, 0, 0); } while (0)
#define PG8_LDA(dst, b, h) do { _Pragma("unroll") for (int m = 0; m < 4; ++m) _Pragma("unroll") for (int k = 0; k < 2; ++k) dst[m][k] = *(const PG8_LAS bf16x8*)(lds + PG8_SA(b, h) + aoff + m * 2048 + k * 1024); } while (0)
#define PG8_LDB(dst, b, h) do { _Pragma("unroll") for (int n = 0; n < 2; ++n) _Pragma("unroll") for (int k = 0; k < 2; ++k) dst[n][k] = *(const PG8_LAS bf16x8*)(lds + PG8_SB(b, h) + boff + n * 2048 + k * 1024); } while (0)
#define PG8_MMA(ai, bj, At, Bt) do { __builtin_amdgcn_s_setprio(1); _Pragma("unroll") for (int m = 0; m < 4; ++m) _Pragma("unroll") for (int n = 0; n < 2; ++n) _Pragma("unroll") for (int k = 0; k < 2; ++k) \
        acc[ai][bj][m][n] = __builtin_amdgcn_mfma_f32_16x16x32_bf16(Bt[n][k], At[m][k], acc[ai][bj][m][n], 0, 0, 0); __builtin_amdgcn_s_setprio(0); } while (0)
#define PG8_WAIT_V(n) asm volatile("s_waitcnt vmcnt(" #n ")" ::: "memory")
#define PG8_WAIT_L(n) asm volatile("s_waitcnt lgkmcnt(" #n ")" ::: "memory")
#define PG8_BAR __builtin_amdgcn_s_barrier()
#define PG8_SCHED __builtin_amdgcn_sched_barrier(0)
    Unit cur, nxt; int ui = 0;
    if (!S.next(0, cur)) return;
    f32x4 acc[2][2][4][2];
#pragma unroll
    for (int a = 0; a < 2; ++a)
#pragma unroll
        for (int b = 0; b < 2; ++b)
#pragma unroll
            for (int m = 0; m < 4; ++m)
#pragma unroll
                for (int n = 0; n < 2; ++n) acc[a][b][m][n] = (f32x4){0.f, 0.f, 0.f, 0.f};
    if constexpr (Epi::HAS_INIT) E.init(acc, cur, wr, wc, fr, fq);
    bf16x8 At[4][2], B0[2][2], B1[2][2];
    const char* cA = (const char*)g.A + (size_t)cur.pm * tstepA; const char* cB = (const char*)g.Bt + (size_t)cur.pn * tstep;
    S.a_ready(cur);
    if constexpr (SP2) {
        PG8_STAGE(PG8_SB(0, 0), cB, voffB); PG8_STAGE(PG8_SB(0, 1), cB + hstep, voffB); PG8_STAGE(PG8_SA(0, 0), cA, voffA); PG8_STAGE(PG8_SA(0, 1), cA + hstepA, voffA);
        if (wr == 1) PG8_BAR;
        PG8_WAIT_V(2); PG8_BAR;
        PG8_STAGE(PG8_SB(1, 0), cB + kstep, voffB); PG8_STAGE(PG8_SA(1, 0), cA + kstep, voffA); PG8_STAGE(PG8_SB(1, 1), cB + hstep + kstep, voffB);
        PG8_WAIT_V(6); PG8_BAR;
    } else {
        PG8_STAGE(PG8_SB(0, 0), cB, voffB); PG8_STAGE(PG8_SA(0, 0), cA, voffA); PG8_STAGE(PG8_SB(0, 1), cB + hstep, voffB); PG8_STAGE(PG8_SA(0, 1), cA + hstepA, voffA);
        if (wr == 1) PG8_BAR;
        PG8_WAIT_V(4); PG8_BAR;
        PG8_STAGE(PG8_SB(1, 0), cB + kstep, voffB); PG8_STAGE(PG8_SA(1, 0), cA + kstep, voffA); PG8_STAGE(PG8_SB(1, 1), cB + hstep + kstep, voffB);
        PG8_WAIT_V(6); PG8_BAR;
    }
    for (;;) {
        const bool has_next = S.next(ui + 1, nxt);
        const char* nA = has_next ? (const char*)g.A + (size_t)nxt.pm * tstepA : cA; const char* nB = has_next ? (const char*)g.Bt + (size_t)nxt.pn * tstep : cB;
        for (int t = 0; t < nt; t += 2) {
            const bool last = (t == nt - 2);
            const char* a1 = cA + (size_t)(t + 1) * kstep;
            const char* a2 = last ? nA : cA + (size_t)(t + 2) * kstep; const char* b2 = last ? nB : cB + (size_t)(t + 2) * kstep;
            const char* a3 = a2 + kstep; const char* b3 = b2 + kstep;
            if (last && has_next) S.a_ready(nxt);
            if constexpr (SP2) {
            PG8_LDB(B0, 0, 0); PG8_LDB(B1, 0, 1); PG8_SCHED; PG8_LDA(At, 0, 0); PG8_STAGE(PG8_SA(1, 1), a1 + hstepA, voffA);
            PG8_WAIT_V(8); PG8_WAIT_L(0); PG8_BAR; PG8_MMA(0, 0, At, B0); PG8_MMA(0, 1, At, B1); PG8_BAR; PG8_SCHED;
            PG8_LDA(At, 0, 1); PG8_STAGE(PG8_SB(0, 0), b2, voffB); PG8_STAGE(PG8_SB(0, 1), b2 + hstep, voffB); PG8_STAGE(PG8_SA(0, 0), a2, voffA);
            PG8_WAIT_V(8); PG8_WAIT_L(0); PG8_BAR; PG8_MMA(1, 0, At, B0); PG8_MMA(1, 1, At, B1); PG8_BAR; PG8_SCHED;
            PG8_LDB(B0, 1, 0); PG8_LDB(B1, 1, 1); PG8_SCHED; PG8_LDA(At, 1, 0); PG8_STAGE(PG8_SA(0, 1), a2 + hstepA, voffA);
            PG8_WAIT_V(8); PG8_WAIT_L(0); PG8_BAR; PG8_MMA(0, 0, At, B0); PG8_MMA(0, 1, At, B1); PG8_BAR; PG8_SCHED;
            PG8_LDA(At, 1, 1); PG8_STAGE(PG8_SB(1, 0), b3, voffB); PG8_STAGE(PG8_SB(1, 1), b3 + hstep, voffB); PG8_STAGE(PG8_SA(1, 0), a3, voffA);
            PG8_WAIT_V(8); PG8_WAIT_L(0); PG8_BAR; PG8_MMA(1, 0, At, B0); PG8_MMA(1, 1, At, B1); PG8_BAR; PG8_SCHED;
            } else {
            PG8_LDB(B0, 0, 0); PG8_SCHED; PG8_LDA(At, 0, 0); PG8_STAGE(PG8_SA(1, 1), a1 + hstepA, voffA);
            PG8_WAIT_L(8); PG8_BAR; PG8_WAIT_L(0); PG8_MMA(0, 0, At, B0); PG8_BAR; PG8_SCHED;
            PG8_LDB(B1, 0, 1); PG8_STAGE(PG8_SB(0, 0), b2, voffB);
            PG8_BAR; PG8_WAIT_L(0); PG8_MMA(0, 1, At, B1); PG8_BAR;
            PG8_LDA(At, 0, 1); PG8_STAGE(PG8_SA(0, 0), a2, voffA);
            PG8_BAR; PG8_WAIT_L(0); PG8_MMA(1, 0, At, B0); PG8_BAR; PG8_SCHED;
            PG8_STAGE(PG8_SB(0, 1), b2 + hstep, voffB);
            PG8_WAIT_V(6); PG8_BAR; PG8_MMA(1, 1, At, B1); PG8_BAR;
            PG8_LDB(B0, 1, 0); PG8_SCHED; PG8_LDA(At, 1, 0); PG8_STAGE(PG8_SA(0, 1), a2 + hstepA, voffA);
            PG8_WAIT_L(8); PG8_BAR; PG8_WAIT_L(0); PG8_MMA(0, 0, At, B0); PG8_BAR; PG8_SCHED;
            PG8_LDB(B1, 1, 1); PG8_STAGE(PG8_SB(1, 0), b3, voffB);
            PG8_BAR; PG8_WAIT_L(0); PG8_MMA(0, 1, At, B1); PG8_BAR;
            PG8_LDA(At, 1, 1); PG8_STAGE(PG8_SA(1, 0), a3, voffA);
            PG8_BAR; PG8_WAIT_L(0); PG8_MMA(1, 0, At, B0); PG8_BAR; PG8_SCHED;
            PG8_STAGE(PG8_SB(1, 1), b3 + hstep, voffB);
            PG8_WAIT_V(6); PG8_BAR; PG8_MMA(1, 1, At, B1); PG8_BAR;
            }
        }
        if constexpr (ALIGN_EPI) { if (wr == 0) PG8_BAR; }
        if constexpr (!Epi::AFTER_DRAIN) { E(acc, cur, wr, wc, fr, fq); S.done(cur); }
        if (!has_next) break;
#pragma unroll
        for (int a = 0; a < 2; ++a)
#pragma unroll
            for (int b = 0; b < 2; ++b)
#pragma unroll
                for (int m = 0; m < 4; ++m)
#pragma unroll
                    for (int n = 0; n < 2; ++n) acc[a][b][m][n] = (f32x4){0.f, 0.f, 0.f, 0.f};
        if constexpr (Epi::HAS_INIT) E.init(acc, nxt, wr, wc, fr, fq);
        cur = nxt; cA = nA; cB = nB; ++ui;
        if constexpr (ALIGN_EPI) { if (wr == 1) PG8_BAR; }
    }
    PG8_WAIT_V(0);
    if constexpr (!ALIGN_EPI) { if (wr == 0) PG8_BAR; }
    PG8_BAR;
    if constexpr (Epi::AFTER_DRAIN) { E.fused(acc, cur, wr, wc, fr, fq, lds, wid, lane); S.done(cur); }
#undef PG8_SA
#undef PG8_SB
#undef PG8_STAGE
#undef PG8_LDA
#undef PG8_LDB
#undef PG8_MMA
#undef PG8_WAIT_V
#undef PG8_WAIT_L
#undef PG8_BAR
#undef PG8_SCHED
}
}

namespace pg8 {
__device__ __forceinline__ float fq_sum(float v) { v += __shfl_xor(v, 16); v += __shfl_xor(v, 32); return v; }
__device__ __forceinline__ u32x4 pack8(const f32x4& a, const f32x4& b) { u32x4 w; w.x = cvt_pk_bf16(a[0], a[1]); w.y = cvt_pk_bf16(a[2], a[3]); w.z = cvt_pk_bf16(b[0], b[1]); w.w = cvt_pk_bf16(b[2], b[3]); return w; }
__device__ __forceinline__ f32x4 silu4(const f32x4& g, const f32x4& u) { f32x4 o;
#pragma unroll
    for (int j = 0; j < 4; ++j) o[j] = g[j] * __builtin_amdgcn_rcpf(1.0f + __builtin_amdgcn_exp2f(-LOG2E * g[j])) * u[j];
    return o; }

template <int NP> __device__ __forceinline__ void rs_rows(const float* ssq, int row0, int fq, float inv_n, float (&rs)[2][4]) {
    f32x4 t[2][4];
#pragma unroll
    for (int ai = 0; ai < 2; ++ai)
#pragma unroll
        for (int m = 0; m < 4; ++m) t[ai][m] = *(const f32x4*)(ssq + (size_t)(row0 + ai * HALF + m * 16) * NP + (NP == 16 ? 4 * fq : 0));
#pragma unroll
    for (int ai = 0; ai < 2; ++ai)
#pragma unroll
        for (int m = 0; m < 4; ++m) { float v = (t[ai][m][0] + t[ai][m][1]) + (t[ai][m][2] + t[ai][m][3]); if (NP == 16) v = fq_sum(v); rs[ai][m] = __builtin_amdgcn_rsqf(v * inv_n + EPS); }
}
struct EpiSwiglu {
    static constexpr bool PERM = true, AFTER_DRAIN = false, HAS_INIT = false;
    bf16_t* HB; const PG8_LAS float* rs_lds;
    __device__ __forceinline__ void operator()(const f32x4 (&acc)[2][2][4][2], const Unit& u, int wr, int wc, int fr, int fq) const {
        const int col0 = u.pn * 128 + wc * 32 + 8 * fq, row0 = u.pm * BM + wr * 64 + fr;
        float rs[2][4];
#pragma unroll
        for (int ai = 0; ai < 2; ++ai)
#pragma unroll
            for (int m = 0; m < 4; ++m) rs[ai][m] = rs_lds ? rs_lds[u.idx * BM + ai * HALF + wr * 64 + m * 16 + fr] : 1.f;
#pragma unroll
        for (int ai = 0; ai < 2; ++ai)
#pragma unroll
            for (int m = 0; m < 4; ++m) { const int row = row0 + ai * HALF + m * 16; const float r = rs[ai][m];
                const f32x4 h0 = silu4(acc[ai][0][m][0] * r, acc[ai][1][m][0] * r), h1 = silu4(acc[ai][0][m][1] * r, acc[ai][1][m][1] * r);
                *(u32x4*)(HB + (size_t)row * FF + col0) = pack8(h0, h1); }
    }
};
template <class Sched> __device__ __forceinline__ void rs_table_fill(const float* ssq, const Sched& S, PG8_LAS float* table, int tid) {
    Unit u; int n = 0; while (S.next(n, u)) ++n;
    for (int e = tid; e < n * BM; e += 512) { S.next(e >> 8, u); table[e] = 1.0f / sqrtf(sum16f(ssq + (size_t)(u.pm * BM + (e & 255)) * 16) * (1.f / D) + EPS); }
    __syncthreads();
}
template <int HALF_SCALE, int BASE_BF16> struct EpiResid {
    static constexpr bool PERM = true, AFTER_DRAIN = false, HAS_INIT = true;
    const void* base; float* out; bf16_t* XN; float* SSQ;
    __device__ __forceinline__ void init(f32x4 (&acc)[2][2][4][2], const Unit& u, int wr, int wc, int fr, int fq) const {
        const int col0 = u.pn * BM + wc * 32 + 8 * fq; const float inv = HALF_SCALE ? 2.0f : 1.0f;
#pragma unroll
        for (int ai = 0; ai < 2; ++ai)
#pragma unroll
            for (int m = 0; m < 4; ++m) { const int row = u.pm * BM + ai * HALF + wr * 64 + m * 16 + fr;
#pragma unroll
                for (int bj = 0; bj < 2; ++bj) { const size_t o = (size_t)row * D + col0 + bj * HALF;
                    if (BASE_BF16) { const u32x4 w = *(const u32x4*)((const bf16_t*)base + o);
                        acc[ai][bj][m][0] = (f32x4){__uint_as_float(w.x << 16), __uint_as_float(w.x & 0xffff0000u), __uint_as_float(w.y << 16), __uint_as_float(w.y & 0xffff0000u)} * inv;
                        acc[ai][bj][m][1] = (f32x4){__uint_as_float(w.z << 16), __uint_as_float(w.z & 0xffff0000u), __uint_as_float(w.w << 16), __uint_as_float(w.w & 0xffff0000u)} * inv; }
                    else { acc[ai][bj][m][0] = *(const f32x4*)((const float*)base + o) * inv; acc[ai][bj][m][1] = *(const f32x4*)((const float*)base + o + 4) * inv; } } }
    }
    __device__ __forceinline__ void operator()(const f32x4 (&acc)[2][2][4][2], const Unit& u, int wr, int wc, int fr, int fq) const {
        const int col0 = u.pn * BM + wc * 32 + 8 * fq; const float scale = HALF_SCALE ? 0.5f : 1.0f;
#pragma unroll
        for (int ai = 0; ai < 2; ++ai)
#pragma unroll
            for (int m = 0; m < 4; ++m) { const int row = u.pm * BM + ai * HALF + wr * 64 + m * 16 + fr; float sq = 0.f;
#pragma unroll
                for (int bj = 0; bj < 2; ++bj) { const size_t o = (size_t)row * D + col0 + bj * HALF;
                    const f32x4 v0 = acc[ai][bj][m][0] * scale, v1 = acc[ai][bj][m][1] * scale;
                    if (out) { *(f32x4*)(out + o) = v0; *(f32x4*)(out + o + 4) = v1; }
                    if (XN) *(u32x4*)(XN + o) = pack8(v0, v1);
                    sq += (v0[0] * v0[0] + v0[1] * v0[1]) + (v0[2] * v0[2] + v0[3] * v0[3]) + (v1[0] * v1[0] + v1[1] * v1[1]) + (v1[2] * v1[2] + v1[3] * v1[3]); }
                if (SSQ) { sq = fq_sum(sq); if (fq == 0) SSQ[(size_t)row * 16 + u.pn * 4 + wc] = sq; } }
    }
};
struct EpiWin {
    static constexpr bool PERM = true, AFTER_DRAIN = false, HAS_INIT = false;
    Ctx C; const PG8_LAS float* rs_lds; const PG8_LAS float* gt;
    __device__ __forceinline__ void operator()(const f32x4 (&acc)[2][2][4][2], const Unit& u, int wr, int wc, int fr, int fq) const {
        const RowSet& R = C.main; const int pn = u.pn;
        f32x4 bfg[2]; if (pn == 1) { bfg[0] = *(const f32x4*)(C.b_forget); bfg[1] = *(const f32x4*)(C.b_forget + 4); }
        float rsr[2][4];
#pragma unroll
        for (int ai = 0; ai < 2; ++ai)
#pragma unroll
            for (int m = 0; m < 4; ++m) rsr[ai][m] = rs_lds[u.idx * BM + ai * HALF + wr * 64 + m * 16 + fr];
#pragma unroll
        for (int ai = 0; ai < 2; ++ai)
#pragma unroll
            for (int m = 0; m < 4; ++m) { const int row = u.pm * BM + ai * HALF + wr * 64 + m * 16 + fr; const float rs = rsr[ai][m];
                f32x4 v[2][2];
#pragma unroll
                for (int bj = 0; bj < 2; ++bj)
#pragma unroll
                    for (int n = 0; n < 2; ++n) v[bj][n] = acc[ai][bj][m][n] * rs;
                float sq[2];
#pragma unroll
                for (int bj = 0; bj < 2; ++bj) sq[bj] = (v[bj][0][0] * v[bj][0][0] + v[bj][0][1] * v[bj][0][1]) + (v[bj][0][2] * v[bj][0][2] + v[bj][0][3] * v[bj][0][3]) +
                                                        (v[bj][1][0] * v[bj][1][0] + v[bj][1][1] * v[bj][1][1]) + (v[bj][1][2] * v[bj][1][2] + v[bj][1][3] * v[bj][1][3]);
                if (pn == 0) {
#pragma unroll
                    for (int bj = 0; bj < 2; ++bj) *(u32x4*)(R.CQ + (size_t)row * 256 + bj * HALF + wc * 32 + 8 * fq) = pack8(v[bj][0], v[bj][1]);
                    const float s = fq_sum(sq[0] + sq[1]); if (fq == 0) R.SSQCQ[(size_t)row * 4 + wc] = s;
                } else if (pn == 1) {
                    *(u32x4*)(R.CKV + (size_t)row * 128 + wc * 32 + 8 * fq) = pack8(v[0][0], v[0][1]);
                    const float s = fq_sum(sq[0]); if (fq == 0) R.SSQCKV[(size_t)row * 4 + wc] = s;
                    if (wc == 0) { *(f32x4*)(R.KPE + (size_t)row * 32 + 4 * fq) = v[1][0]; *(f32x4*)(R.KPE + (size_t)row * 32 + 16 + 4 * fq) = v[1][1];
                        const float sp = fq_sum(sq[1]); if (fq == 0) R.SSQKPE[row] = sp; }
                    if (wc == 1 && fq == 0) { f32x4 l0, l1;
#pragma unroll
                        for (int j = 0; j < 4; ++j) { l0[j] = log_sigmoid(v[1][0][j] + bfg[0][j]); l1[j] = log_sigmoid(v[1][1][j] + bfg[1][j]); }
                        *(f32x4*)(R.LOGF + (size_t)row * 8) = l0; *(f32x4*)(R.LOGF + (size_t)row * 8 + 4) = l1; }
                } else {
                    const int which = (pn - 2) >> 1, h = ((pn - 2) & 1) * 4 + wc; const int b = row >> 13, p = 64 + (row & (T - 1));
                    if (which < 2) { const float r = __builtin_amdgcn_rsqf(fq_sum(sq[0] + sq[1]) * (1.f / 64.f) + EPS) * (which == 0 ? C2F : 1.f); const PG8_LAS float* g = gt + (which == 0 ? 0 : 64);
#pragma unroll
                        for (int bj = 0; bj < 2; ++bj) { v[bj][0] = v[bj][0] * *(const PG8_LAS f32x4*)(g + 32 * bj + 8 * fq) * r; v[bj][1] = v[bj][1] * *(const PG8_LAS f32x4*)(g + 32 * bj + 8 * fq + 4) * r; } }
#pragma unroll
                    for (int bj = 0; bj < 2; ++bj) { bf16_t* dst = (which == 0) ? C.FQ + arow(b, h, p) * 64 + 32 * bj + 8 * fq : (which == 1) ? C.FK + kaddr(b, h, p, 32 * bj + 8 * fq, DFK) : C.FV + vaddr(b, h, p, 32 * bj + 8 * fq);
                        *(u32x4*)dst = pack8(v[bj][0], v[bj][1]); }
                }
                if (m & 1) asm volatile("" ::: "memory"); }
    }
};
struct EpiUq {
    static constexpr bool PERM = true, AFTER_DRAIN = false, HAS_INIT = false;
    const PG8_LAS float* g_q_mla; const float* SSQCQ; float* SSQQ; bf16_t* QM; const float* ROPE;
    __device__ __forceinline__ void operator()(const f32x4 (&acc)[2][2][4][2], const Unit& u, int wr, int wc, int fr, int fq) const {
        const int pn = u.pn;
        float rsr[2][4]; rs_rows<4>(SSQCQ, u.pm * BM + wr * 64 + fr, fq, 1.f / 256.f, rsr);
#pragma unroll
        for (int ai = 0; ai < 2; ++ai)
#pragma unroll
            for (int m = 0; m < 4; ++m) { const int row = u.pm * BM + ai * HALF + wr * 64 + m * 16 + fr; const float rs = rsr[ai][m];
                const int b = row >> 13, p = 64 + (row & (T - 1));
                if (pn < 2) { const int h = pn * 4 + wc; bf16_t* dst = QM + arow(b, h, p) * DQM; float sq = 0.f;
#pragma unroll
                    for (int bj = 0; bj < 2; ++bj) { const f32x4 v0 = acc[ai][bj][m][0] * rs, v1 = acc[ai][bj][m][1] * rs;
                        sq += (v0[0] * v0[0] + v0[1] * v0[1]) + (v0[2] * v0[2] + v0[3] * v0[3]) + (v1[0] * v1[0] + v1[1] * v1[1]) + (v1[2] * v1[2] + v1[3] * v1[3]);
                        const f32x4 g0 = *(const PG8_LAS f32x4*)(g_q_mla + 32 * bj + 8 * fq), g1 = *(const PG8_LAS f32x4*)(g_q_mla + 32 * bj + 8 * fq + 4);
                        *(u32x4*)(dst + 32 * bj + 8 * fq) = pack8(v0 * g0, v1 * g1); }
                    sq = fq_sum(sq); if (fq == 0) SSQQ[(size_t)row * 16 + 2 * h] = sq;
                } else { const float* rp = ROPE + ((size_t)(p - 48) * 16 + 4 * fq) * 2; const f32x4 t0 = *(const f32x4*)rp, t1 = *(const f32x4*)(rp + 4);
                    const f32x4 cs = {t0[0], t0[2], t1[0], t1[2]}, sn = {t0[1], t0[3], t1[1], t1[3]};
                    const f32x4 g0 = *(const PG8_LAS f32x4*)(g_q_mla + 64 + 4 * fq), g1 = *(const PG8_LAS f32x4*)(g_q_mla + 80 + 4 * fq);
#pragma unroll
                    for (int bj = 0; bj < 2; ++bj) { const int h = 2 * wc + bj; const f32x4 v0 = acc[ai][bj][m][0] * rs, v1 = acc[ai][bj][m][1] * rs;
                        float sq = (v0[0] * v0[0] + v0[1] * v0[1]) + (v0[2] * v0[2] + v0[3] * v0[3]) + (v1[0] * v1[0] + v1[1] * v1[1]) + (v1[2] * v1[2] + v1[3] * v1[3]);
                        sq = fq_sum(sq); if (fq == 0) SSQQ[(size_t)row * 16 + 2 * h + 1] = sq;
                        const f32x4 y1 = v0 * g0, y2 = v1 * g1; const f32x4 o1 = y1 * cs - y2 * sn, o2 = y2 * cs + y1 * sn;
                        bf16_t* dst = QM + arow(b, h, p) * DQM; u32x2 w1, w2; w1.x = cvt_pk_bf16(o1[0], o1[1]); w1.y = cvt_pk_bf16(o1[2], o1[3]); w2.x = cvt_pk_bf16(o2[0], o2[1]); w2.y = cvt_pk_bf16(o2[2], o2[3]);
                        *(u32x2*)(dst + 64 + 4 * fq) = w1; *(u32x2*)(dst + 80 + 4 * fq) = w2; } }
                if (m & 1) asm volatile("" ::: "memory"); }
    }
};
struct EpiUkv {
    static constexpr bool PERM = true, AFTER_DRAIN = false, HAS_INIT = false;
    const PG8_LAS float* g_k_mla; const float* SSQCKV; const float* SSQKPE; const float* KPE; bf16_t* KM; bf16_t* VM; const float* ROPE;
    __device__ __forceinline__ void operator()(const f32x4 (&acc)[2][2][4][2], const Unit& u, int wr, int wc, int fr, int fq) const {
        const int pn = u.pn, h = (pn & 1) * 4 + wc;
        float rsr[2][4]; rs_rows<4>(SSQCKV, u.pm * BM + wr * 64 + fr, fq, 1.f / 128.f, rsr);
#pragma unroll
        for (int ai = 0; ai < 2; ++ai)
#pragma unroll
            for (int m = 0; m < 4; ++m) { const int row = u.pm * BM + ai * HALF + wr * 64 + m * 16 + fr; const float rs = rsr[ai][m];
                const int b = row >> 13, p = 64 + (row & (T - 1));
                if (pn < 2) { float sq = 0.f;
#pragma unroll
                    for (int bj = 0; bj < 2; ++bj)
#pragma unroll
                        for (int n = 0; n < 2; ++n) { const f32x4 v = acc[ai][bj][m][n] * rs; sq += (v[0] * v[0] + v[1] * v[1]) + (v[2] * v[2] + v[3] * v[3]); }
                    const float rk = __builtin_amdgcn_rsqf((fq_sum(sq) + SSQKPE[row]) * (1.f / 96.f) + EPS); const float rr = rs * rk;
#pragma unroll
                    for (int bj = 0; bj < 2; ++bj) { const f32x4 g0 = *(const PG8_LAS f32x4*)(g_k_mla + 32 * bj + 8 * fq), g1 = *(const PG8_LAS f32x4*)(g_k_mla + 32 * bj + 8 * fq + 4);
                        *(u32x4*)(KM + kaddr(b, h, p, 32 * bj + 8 * fq, DQM)) = pack8(acc[ai][bj][m][0] * g0 * rr, acc[ai][bj][m][1] * g1 * rr); }
                    const float* rp = ROPE + ((size_t)(p - 48) * 16 + 4 * fq) * 2; const f32x4 t0 = *(const f32x4*)rp, t1 = *(const f32x4*)(rp + 4);
                    const f32x4 cs = {t0[0], t0[2], t1[0], t1[2]}, sn = {t0[1], t0[3], t1[1], t1[3]};
                    const f32x4 y1 = *(const f32x4*)(KPE + (size_t)row * 32 + 4 * fq) * *(const PG8_LAS f32x4*)(g_k_mla + 64 + 4 * fq) * rk, y2 = *(const f32x4*)(KPE + (size_t)row * 32 + 16 + 4 * fq) * *(const PG8_LAS f32x4*)(g_k_mla + 80 + 4 * fq) * rk;
                    const f32x4 o1 = y1 * cs - y2 * sn, o2 = y2 * cs + y1 * sn; u32x2 w1, w2; w1.x = cvt_pk_bf16(o1[0], o1[1]); w1.y = cvt_pk_bf16(o1[2], o1[3]); w2.x = cvt_pk_bf16(o2[0], o2[1]); w2.y = cvt_pk_bf16(o2[2], o2[3]);
                    *(u32x2*)(KM + kaddr(b, h, p, 64 + 4 * fq, DQM)) = w1; *(u32x2*)(KM + kaddr(b, h, p, 80 + 4 * fq, DQM)) = w2;
                } else {
#pragma unroll
                    for (int bj = 0; bj < 2; ++bj) *(u32x4*)(VM + vaddr(b, h, p, 32 * bj + 8 * fq)) = pack8(acc[ai][bj][m][0] * rs, acc[ai][bj][m][1] * rs); }
                if (m & 1) asm volatile("" ::: "memory"); }
    }
};
}


namespace att {
typedef short s16x4 __attribute__((ext_vector_type(4)));
typedef float f32x16 __attribute__((ext_vector_type(16)));
constexpr int NW = 8, QBLK = 32, QB = QBLK * NW, KVBLK = 64;
constexpr int KSLOT = 12288, NKSLOT = 4, VSLOT = 8192, NVSLOT = 3;
constexpr int LDS_K = 0, LDS_V = NKSLOT * KSLOT, LDS_WS = LDS_V + NVSLOT * VSLOT, LDS_OST = LDS_WS + NW * 256, LDS_BYTES = LDS_OST + NW * 4096;
__device__ __forceinline__ int crow(int r, int hi) { return (r & 3) + 8 * (r >> 2) + 4 * hi; }
#define SBAR() __builtin_amdgcn_sched_barrier(0)
__device__ __forceinline__ void cmask(f32x16& p0, f32x16& p1, int jb, int qrel, int hi) {
    const float NEG = -INFINITY; const int kb = 64 * jb + 4 * hi;
#pragma unroll
    for (int r = 0; r < 16; ++r) { const int kv = kb + (r & 3) + 8 * (r >> 2); if (kv > qrel) p0[r] = NEG; if (kv + 32 > qrel) p1[r] = NEG; }
}
__device__ __forceinline__ void glds16(const void* gsrc, unsigned lds_dst) { unsigned keep;
    asm volatile("s_mov_b32 %0, m0\n\ts_mov_b32 m0, %2\n\ts_nop 0\n\tglobal_load_lds_dwordx4 %1, off\n\ts_mov_b32 m0, %0" : "=&s"(keep) : "v"(gsrc), "s"(lds_dst) : "memory"); }
typedef float f32x2_t __attribute__((ext_vector_type(2))); typedef __bf16 bf16x2_t __attribute__((ext_vector_type(2)));
__device__ __forceinline__ unsigned cvtpk_s(float lo, float hi) { f32x2_t v = {lo, hi}; bf16x2_t b = __builtin_convertvector(v, bf16x2_t); return __builtin_bit_cast(unsigned, b); }
#define WAIT_BAR(N) asm volatile("s_waitcnt vmcnt(" #N ") lgkmcnt(0)\n\ts_barrier" ::: "memory")
typedef __attribute__((address_space(3))) const char* lds_cptr;
typedef short v4i16_t __attribute__((ext_vector_type(4)));
#define LDSV8(p) (*(const __attribute__((address_space(3))) bf16x8*)(p))
__device__ __forceinline__ void kload2(bf16x8* kf, lds_cptr kp, int j) { kf[2 * j] = LDSV8(kp + j * 2048); kf[2 * j + 1] = LDSV8(kp + j * 2048 + 512); }
__device__ __forceinline__ s16x4 vtr(lds_cptr p) { return __builtin_bit_cast(s16x4, __builtin_amdgcn_ds_read_tr16_b64_v4i16((__attribute__((address_space(3))) v4i16_t*)p)); }
#define MX3(a, b, c) __builtin_fmaxf(__builtin_fmaxf((a), (b)), (c))
__device__ __forceinline__ float rowmax(const f32x16& p0, const f32x16& p1) {
    float a = MX3(p0[0], p0[1], p1[0]), b = MX3(p0[2], p0[3], p1[1]); a = MX3(a, p1[2], p1[3]);
#pragma unroll
    for (int r = 4; r < 16; r += 4) { a = MX3(a, p0[r], p0[r + 1]); b = MX3(b, p0[r + 2], p0[r + 3]); a = MX3(a, p1[r], p1[r + 1]); b = MX3(b, p1[r + 2], p1[r + 3]); }
    float m = __builtin_fmaxf(a, b); auto rr = __builtin_amdgcn_permlane32_swap(__float_as_uint(m), __float_as_uint(m), false, false);
    return __builtin_fmaxf(__uint_as_float(rr[0]), __uint_as_float(rr[1])); }
__device__ __forceinline__ void pv(f32x16* o, int vb, bf16x8 pa0, bf16x8 pa1, bf16x8 pa2, bf16x8 pa3) {
#pragma unroll
    for (int d0 = 0; d0 < 2; ++d0) { s16x4 lo[4], hi[4];
#pragma unroll
        for (int ks = 0; ks < 4; ++ks) {
            asm volatile("ds_read_b64_tr_b16 %0,%1 offset:%c2" : "=&v"(lo[ks]) : "v"(vb), "i"(d0 * 4096 + ks * 1024) : "memory");
            asm volatile("ds_read_b64_tr_b16 %0,%1 offset:%c2" : "=&v"(hi[ks]) : "v"(vb), "i"(d0 * 4096 + ks * 1024 + 512) : "memory"); }
        asm volatile("s_waitcnt lgkmcnt(0)" ::: "memory"); SBAR();
#define PK(k) (bf16x8){lo[k][0], lo[k][1], lo[k][2], lo[k][3], hi[k][0], hi[k][1], hi[k][2], hi[k][3]}
        o[d0] = __builtin_amdgcn_mfma_f32_32x32x16_bf16(pa0, PK(0), o[d0], 0, 0, 0);
        o[d0] = __builtin_amdgcn_mfma_f32_32x32x16_bf16(pa1, PK(1), o[d0], 0, 0, 0);
        o[d0] = __builtin_amdgcn_mfma_f32_32x32x16_bf16(pa2, PK(2), o[d0], 0, 0, 0);
        o[d0] = __builtin_amdgcn_mfma_f32_32x32x16_bf16(pa3, PK(3), o[d0], 0, 0, 0);
#undef PK
    }
}
#ifndef ATTN_STORE16
#define ATTN_STORE16(p, v) (*(u32x4*)(p) = (v))
#endif
#define MFMA32(a, b, c) __builtin_amdgcn_mfma_f32_32x32x16_bf16(a, b, c, 0, 0, 0)
template <int NKS, bool FOX, int THRL>
__device__ __forceinline__ void attn_unit(int b, int h, int qb, const bf16_t* Qb, const bf16_t* __restrict__ Kb, const bf16_t* __restrict__ Vb, const float* aux, bf16_t* O, int ocol, char* shm, float m0, int tb) {
    constexpr int DK = NKS * 16, NX = NKS * 2 - 8;
    int tid = threadIdx.x; asm volatile("" : "+v"(tid));
    const int lane = tid & 63, r32 = lane & 31, hi = lane >> 5; const int wid = __builtin_amdgcn_readfirstlane(tid >> 6);
    const size_t hb = (size_t)(b * 8 + h) * PR; const int q0 = qb * QB;
    if (wid >= 4) __builtin_amdgcn_s_setprio(1);
    const bf16_t* Kh = Kb + (hb + (size_t)(64 * tb)) * DK; const bf16_t* Vh = Vb + (hb + (size_t)(64 * tb)) * 64;
    const unsigned lds0 = (unsigned)(uintptr_t)shm;
    float* wsf = (float*)(shm + LDS_WS) + wid * 64;
    const bf16_t* ksrc1 = Kh + wid * 512 + lane * 8;
    const bf16_t* ksrc2 = Kh + 4096 + wid * NX * 64 + lane * 8;
    const bf16_t* vsrc = Vh + wid * 512 + lane * 8;
    const unsigned kdst1 = lds0 + LDS_K + wid * 1024, kdst2 = lds0 + LDS_K + 8192 + wid * NX * 128, vdst = lds0 + LDS_V + wid * 1024;
    const bool x2 = lane < NX * 8;
#define DMA_K(t, slot) do { glds16(ksrc1 + (size_t)(t) * KVBLK * DK, (unsigned)__builtin_amdgcn_readfirstlane(kdst1 + (slot))); if (x2) glds16(ksrc2 + (size_t)(t) * KVBLK * DK, (unsigned)__builtin_amdgcn_readfirstlane(kdst2 + (slot))); } while (0)
#define DMA_V(t, slot) glds16(vsrc + (size_t)(t) * KVBLK * 64, (unsigned)__builtin_amdgcn_readfirstlane(vdst + (slot)))
    const int vb0 = (int)(lds0 + LDS_V) + ((lane >> 4) & 1) * 32 + (lane & 3) * 8 + (4 * hi + ((lane & 15) >> 2)) * 64;
    bf16x8 kf[12];
    const lds_cptr shm3 = (lds_cptr)shm; const lds_cptr kp0 = shm3 + LDS_K + hi * 1024 + r32 * 16; const lds_cptr vp0 = shm3 + LDS_V + ((lane >> 4) & 1) * 32 + (lane & 3) * 8 + (4 * hi + ((lane & 15) >> 2)) * 64;
    const int NT = 4 * qb + 5 - tb;
    DMA_K(0, 0); DMA_V(0, 0); DMA_K(1, KSLOT);
    bf16x8 qr[NKS]; float cqv = 0.f;
    { const int prow = 64 + q0 + wid * QBLK + r32; const bf16_t* Qrow = Qb + (hb + prow) * (FOX ? 64 : 96);
      if (FOX) {
#pragma unroll
          for (int d0 = 0; d0 < 4; ++d0) qr[d0] = *(const bf16x8*)(Qrow + d0 * 16 + hi * 8);
          const short one = hi ? (short)0 : (short)0x3f80; qr[NKS - 1] = (bf16x8){one, one, one, 0, 0, 0, 0, 0};
          cqv = aux[hb + prow] * LOG2E;
      } else { const int row = b * T + q0 + wid * QBLK + r32; const float rq = C2M / sqrtf((aux[(size_t)row * 16 + 2 * h] + aux[(size_t)row * 16 + 2 * h + 1]) * (1.f / 96.f) + EPS);
#pragma unroll
          for (int d0 = 0; d0 < NKS; ++d0) { const bf16x8 raw = *(const bf16x8*)(Qrow + d0 * 16 + hi * 8); u32x4 w;
#pragma unroll
              for (int j = 0; j < 4; ++j) w[j] = cvtpk_s(bf2f((bf16_t)raw[2 * j]) * rq, bf2f((bf16_t)raw[2 * j + 1]) * rq);
              qr[d0] = __builtin_bit_cast(bf16x8, w); } } }
    float mhat = 0.f, l_reg = 0.f; f32x16 o[2]; o[0] = f32x16{}; o[1] = f32x16{}; f32x16 negm;
#pragma unroll
    for (int r = 0; r < 16; ++r) negm[r] = cqv;
    asm volatile("" : "+v"(negm));
    const int qrel = wid * QBLK + r32;
#define CMASK(P0, P1, t) do { int jb_ = (t) - (NT - 4); if (jb_ >= 0) cmask(P0, P1, jb_, qrel, hi); } while (0)
    bool resc = false; const bool bounded = m0 < 40.f;
#define RESC() do { if (resc) { asm volatile("s_waitcnt lgkmcnt(0)" ::: "memory"); \
        _Pragma("unroll") for (int d_ = 0; d_ < 2; ++d_) _Pragma("unroll") for (int r = 0; r < 16; ++r) o[d_][r] *= wsf[crow(r, hi)]; } } while (0)
    f32x16 pA0, pA1, pB0, pB1;
    int ks_prev = 3 * KSLOT, ks_cur = 0, ks_next = KSLOT, vs_prev = 2 * VSLOT, vs_cur = 0, vs_next = VSLOT;
#define ROT() do { ks_prev = ks_cur; ks_cur = ks_next; ks_next = (ks_next == (NKSLOT - 1) * KSLOT) ? 0 : ks_next + KSLOT; vs_prev = vs_cur; vs_cur = vs_next; vs_next = (vs_next == (NVSLOT - 1) * VSLOT) ? 0 : vs_next + VSLOT; } while (0)
    DMA_K(2, 2 * KSLOT);
    WAIT_BAR(2);
    { const lds_cptr kb = kp0;
#pragma unroll
      for (int d0 = 0; d0 < NKS; ++d0) { const bf16x8 b0 = LDSV8(kb + d0 * 2048), b1 = LDSV8(kb + d0 * 2048 + 512);
          if (d0 == 0) { pB0 = MFMA32(b0, qr[0], negm); pB1 = MFMA32(b1, qr[0], negm); } else { pB0 = MFMA32(b0, qr[d0], pB0); pB1 = MFMA32(b1, qr[d0], pB1); } }
      if (tb == 0) {
#pragma unroll
          for (int r = 0; r < 16; ++r) pB0[r] = -INFINITY;
#pragma unroll
          for (int r = 0; r < 8; ++r) pB1[r] = -INFINITY; }
      const float rm = bounded ? m0 : rowmax(pB0, pB1); mhat = rm;
#pragma unroll
      for (int r = 0; r < 16; ++r) { pB0[r] = __builtin_amdgcn_exp2f(pB0[r] - rm); pB1[r] = __builtin_amdgcn_exp2f(pB1[r] - rm); }
#pragma unroll
      for (int r = 0; r < 16; ++r) negm[r] = cqv - mhat;
      asm volatile("" : "+v"(negm)); }
    WAIT_BAR(0);
    DMA_K(3, ks_prev); DMA_V(1, vs_next);
    ROT();
    kload2(kf, kp0 + ks_cur, 0); kload2(kf, kp0 + ks_cur, 1);
    s16x4 vlo[8], vhi[8]; u32x4 pw0, pw1, pw2, pw3;
#define PKW(P, B) cvtpk_s(P[B], P[B + 1])
#define PAF(k) __builtin_bit_cast(bf16x8, pw##k)
#define VFR(i) (bf16x8){vlo[i][0], vlo[i][1], vlo[i][2], vlo[i][3], vhi[i][0], vhi[i][1], vhi[i][2], vhi[i][3]}
#define PIN(x) asm volatile("" : "+v"(x))
#define GAPA(MF, A0, A1, A2, A3, W0, W1, PW) do { MF; sacc += A0; sacc += A1; sacc += A2; sacc += A3; PIN(sacc); W0; W1; PIN(PW); SBAR(); } while (0)
#define EX(v) __builtin_amdgcn_exp2f(v)
#define GAPB(MF, X, B) do { MF; X[B] = EX(X[B]); X[B + 1] = EX(X[B + 1]); X[B + 2] = EX(X[B + 2]); X[B + 3] = EX(X[B + 3]); PIN(X); SBAR(); } while (0)
#define VRD(i) do { vlo[i] = vtr(vp_ + (((i) >> 2) * 4096 + ((i) & 3) * 1024)); vhi[i] = vtr(vp_ + (((i) >> 2) * 4096 + ((i) & 3) * 1024 + 512)); } while (0)
#define KRD(G, j) do { if (G) { kload2(kf, kp0 + ks_next, j); SBAR(); } } while (0)
#define KLD(f) do { kf[f] = LDSV8(kx_ + ((f) >> 1) * 2048 + ((f) & 1) * 512); } while (0)
#define STEP(C0, C1, P0, P1, t, GK, GV, GL) do { SBAR(); \
    const lds_cptr vp_ = vp0 + vs_prev; const lds_cptr kx_ = kp0 + ks_cur; \
    VRD(0); KLD(4); SBAR(); float sacc = (P0[0] + P0[1]); \
    GAPA(C0 = MFMA32(kf[0], qr[0], negm), P0[2], P0[3], P0[4], P0[5],     pw0[0] = PKW(P0, 0), pw0[1] = PKW(P0, 2), pw0); \
    VRD(4); KLD(5); SBAR(); GAPA(C1 = MFMA32(kf[1], qr[0], negm), P0[6], P0[7], P0[8], P0[9],     pw0[2] = PKW(P0, 4), pw0[3] = PKW(P0, 6), pw0); \
    VRD(1); KLD(6); SBAR(); GAPA(C0 = MFMA32(kf[2], qr[1], C0),   P0[10], P0[11], P0[12], P0[13], pw1[0] = PKW(P0, 8), pw1[1] = PKW(P0, 10), pw1); \
    VRD(5); KLD(7); SBAR(); GAPA(C1 = MFMA32(kf[3], qr[1], C1),   P0[14], P0[15], P1[0], P1[1],   pw1[2] = PKW(P0, 12), pw1[3] = PKW(P0, 14), pw1); \
    VRD(2); KLD(8); SBAR(); GAPA(C0 = MFMA32(kf[4], qr[2], C0),   P1[2], P1[3], P1[4], P1[5],     pw2[0] = PKW(P1, 0), pw2[1] = PKW(P1, 2), pw2); \
    VRD(6); KLD(9); SBAR(); GAPA(C1 = MFMA32(kf[5], qr[2], C1),   P1[6], P1[7], P1[8], P1[9],     pw2[2] = PKW(P1, 4), pw2[3] = PKW(P1, 6), pw2); \
    VRD(3); if (NKS == 6) KLD(10); SBAR(); GAPA(C0 = MFMA32(kf[6], qr[3], C0),   P1[10], P1[11], P1[12], P1[13], pw3[0] = PKW(P1, 8), pw3[1] = PKW(P1, 10), pw3); \
    VRD(7); if (NKS == 6) KLD(11); SBAR(); GAPA(C1 = MFMA32(kf[7], qr[3], C1),   P1[14], P1[15], 0.f, 0.f,       pw3[2] = PKW(P1, 12), pw3[3] = PKW(P1, 14), pw3); \
    C0 = MFMA32(kf[8], qr[4], C0); C1 = MFMA32(kf[9], qr[4], C1); if (NKS == 6) { C0 = MFMA32(kf[10], qr[NKS - 1], C0); C1 = MFMA32(kf[11], qr[NKS - 1], C1); } \
    l_reg += sacc; \
    if (GK) { DMA_K((t) + 3, ks_prev); } if (GV) { DMA_V((t) + 1, vs_next); } \
    CMASK(C0, C1, t); \
    resc = false; \
    if (!bounded) { float a = MX3(C0[0], C0[1], C1[0]), b_ = MX3(C0[2], C0[3], C1[1]); a = MX3(a, C1[2], C1[3]); \
      _Pragma("unroll") for (int r = 4; r < 16; r += 4) { a = MX3(a, C0[r], C0[r + 1]); b_ = MX3(b_, C0[r + 2], C0[r + 3]); a = MX3(a, C1[r], C1[r + 1]); b_ = MX3(b_, C1[r + 2], C1[r + 3]); } \
      float rm = __builtin_fmaxf(a, b_); { auto rr = __builtin_amdgcn_permlane32_swap(__float_as_uint(rm), __float_as_uint(rm), false, false); rm = __builtin_fmaxf(__uint_as_float(rr[0]), __uint_as_float(rr[1])); } \
      if (__builtin_expect(__any(rm > (float)THRL), 0)) { const float dl = __builtin_fmaxf(rm, 0.f); mhat += dl; \
        _Pragma("unroll") for (int r = 0; r < 16; ++r) { C0[r] -= dl; C1[r] -= dl; } \
        _Pragma("unroll") for (int r = 0; r < 16; ++r) negm[r] = cqv - mhat; asm volatile("" : "+v"(negm)); \
        const float f = __builtin_amdgcn_exp2f(-dl); l_reg *= f; if (hi == 0) wsf[r32] = f; resc = true; } } \
    SBAR(); \
    GAPB(o[0] = MFMA32(PAF(0), VFR(0), o[0]), C0, 0); \
    GAPB(o[1] = MFMA32(PAF(0), VFR(4), o[1]), C0, 4); \
    KRD(GL, 0); GAPB(o[0] = MFMA32(PAF(1), VFR(1), o[0]), C0, 8); \
    KRD(GL, 1); GAPB(o[1] = MFMA32(PAF(1), VFR(5), o[1]), C0, 12); \
    GAPB(o[0] = MFMA32(PAF(2), VFR(2), o[0]), C1, 0); \
    GAPB(o[1] = MFMA32(PAF(2), VFR(6), o[1]), C1, 4); \
    GAPB(o[0] = MFMA32(PAF(3), VFR(3), o[0]), C1, 8); \
    GAPB(o[1] = MFMA32(PAF(3), VFR(7), o[1]), C1, 12); \
    } while (0)
#define ENDW(tt) do { if ((tt) + 3 < NT) { WAIT_BAR(3); } else if ((tt) + 2 < NT) { WAIT_BAR(1); } else { WAIT_BAR(0); } } while (0)
    WAIT_BAR(3);
    STEP(pA0, pA1, pB0, pB1, 1, true, true, true); ENDW(1); RESC(); ROT();
    int t = 2;
#undef CMASK
#define CMASK(P0, P1, t) do { } while (0)
    for (; t + 5 < NT; t += 2) {
        STEP(pB0, pB1, pA0, pA1, t, true, true, true);     WAIT_BAR(3); RESC(); ROT();
        STEP(pA0, pA1, pB0, pB1, t + 1, true, true, true); WAIT_BAR(3); RESC(); ROT();
    }
#undef CMASK
#define CMASK(P0, P1, t) do { int jb_ = (t) - (NT - 4); if (jb_ >= 0) cmask(P0, P1, jb_, qrel, hi); } while (0)
    for (; t + 1 < NT; t += 2) {
        STEP(pB0, pB1, pA0, pA1, t, (t + 3 < NT), (t + 1 < NT), (t + 1 < NT));         ENDW(t);     RESC(); ROT();
        STEP(pA0, pA1, pB0, pB1, t + 1, (t + 4 < NT), (t + 2 < NT), (t + 2 < NT));     ENDW(t + 1); RESC(); ROT();
    }
    STEP(pB0, pB1, pA0, pA1, NT - 1, false, false, false); RESC();
    { float sacc = pB0[0] + pB0[1];
#pragma unroll
      for (int r = 2; r < 16; ++r) sacc += pB0[r];
#pragma unroll
      for (int r = 0; r < 16; ++r) sacc += pB1[r];
      l_reg += sacc;
      pw0 = (u32x4){PKW(pB0, 0), PKW(pB0, 2), PKW(pB0, 4), PKW(pB0, 6)}; pw1 = (u32x4){PKW(pB0, 8), PKW(pB0, 10), PKW(pB0, 12), PKW(pB0, 14)};
      pw2 = (u32x4){PKW(pB1, 0), PKW(pB1, 2), PKW(pB1, 4), PKW(pB1, 6)}; pw3 = (u32x4){PKW(pB1, 8), PKW(pB1, 10), PKW(pB1, 12), PKW(pB1, 14)};
      SBAR(); pv(o, vb0 + vs_cur, PAF(0), PAF(1), PAF(2), PAF(3)); }
#undef PKW
#undef PAF
#undef VFR
#undef PIN
#undef GAPA
#undef GAPB
#undef EX
#undef VRD
#undef KRD
#undef STEP
#undef KLD
#undef ENDW
    { auto rr = __builtin_amdgcn_permlane32_swap(__float_as_uint(l_reg), __float_as_uint(l_reg), false, false); l_reg = __uint_as_float(rr[0]) + __uint_as_float(rr[1]); }
    if (hi == 0) wsf[32 + r32] = l_reg; asm volatile("s_waitcnt lgkmcnt(0)" ::: "memory");
    float rli[16];
#pragma unroll
    for (int r = 0; r < 16; ++r) rli[r] = __builtin_amdgcn_rcpf(wsf[32 + crow(r, hi)]);
    bf16_t* Ow = O + (size_t)(b * T + q0 + wid * QBLK) * D + ocol;
    { bf16_t* stg = (bf16_t*)(shm + LDS_OST) + wid * 2048;
#pragma unroll
      for (int r = 0; r < 16; ++r) { const int orow = crow(r, hi);
#pragma unroll
          for (int d0 = 0; d0 < 2; ++d0) stg[orow * 64 + d0 * 32 + r32] = (bf16_t)f2bf(o[d0][r] * rli[r]); }
      asm volatile("s_waitcnt lgkmcnt(0)" ::: "memory");
#pragma unroll
      for (int i = 0; i < 4; ++i) { const int row = i * 8 + (lane >> 3), ch = lane & 7; const u32x4 v = *(const u32x4*)(stg + row * 64 + ch * 8); ATTN_STORE16(Ow + (size_t)row * D + ch * 8, v); } }
    asm volatile("s_waitcnt lgkmcnt(0)\n\ts_barrier" ::: "memory");
    __builtin_amdgcn_s_setprio(0);
#undef DMA_K
#undef DMA_V
#undef CMASK
#undef RESC
#undef ROT
}
#undef SBAR
#undef WAIT_BAR
#undef MFMA32
#undef MX3
#undef LDSV8
}
constexpr int CW_QATT = 13312, CW_QCONV = CW_QATT + 64 * 8;
__device__ __forceinline__ int wg_dequeue(unsigned* head, volatile __attribute__((address_space(3))) unsigned* slot) {
    __syncthreads();
    if (threadIdx.x == 0) *slot = __hip_atomic_fetch_add(head, 1u, __ATOMIC_RELAXED, __HIP_MEMORY_SCOPE_AGENT);
    __syncthreads();
    return (int)*slot;
}
__device__ __forceinline__ void attn_phase(const Ctx& C, char* shm, unsigned* ctl, unsigned xcc, volatile __attribute__((address_space(3))) unsigned* slot) {
    float m0_mla, m0_fox;
    { const int l = threadIdx.x & 63; float a = fmaxf(fabsf(C.g_q_mla[l]), l < 32 ? fabsf(C.g_q_mla[64 + l]) : 0.f), b2 = fmaxf(fabsf(C.g_k_mla[l]), l < 32 ? fabsf(C.g_k_mla[64 + l]) : 0.f), c = fabsf(C.g_q_fox[l]), d = fabsf(C.g_k_fox[l]);
#pragma unroll
      for (int o = 1; o < 64; o <<= 1) { a = fmaxf(a, __shfl_xor(a, o)); b2 = fmaxf(b2, __shfl_xor(b2, o)); c = fmaxf(c, __shfl_xor(c, o)); d = fmaxf(d, __shfl_xor(d, o)); }
      m0_mla = 9.797958971f * a * b2 * LOG2E * 1.02f; m0_fox = 8.0f * c * d * LOG2E * 1.02f; }
    const float prune = -(2.0f * m0_fox + 40.0f);
    unsigned pre = 128u;
    if (threadIdx.x == 0) pre = __hip_atomic_fetch_add(ctl + CW_QATT + 64 * (int)(xcc & 7u), 1u, __ATOMIC_RELAXED, __HIP_MEMORY_SCOPE_AGENT);
    for (bool own = true;;) {
        __syncthreads();
        if (threadIdx.x == 0) { int grp = (int)(xcc & 7u); unsigned tk = 128u;
            if (own) tk = pre;
            if (tk >= 128u) { unsigned hd[8];
#pragma unroll
                for (int g = 0; g < 8; ++g) hd[g] = __hip_atomic_load(ctl + CW_QATT + 64 * g, __ATOMIC_RELAXED, __HIP_MEMORY_SCOPE_AGENT);
                int pick = -1;
#pragma unroll
                for (int g = 7; g >= 0; --g) { const int gg = (int)((xcc + 1u + (unsigned)g) & 7u); unsigned hv = 0u;
#pragma unroll
                    for (int q = 0; q < 8; ++q) hv = (q == gg) ? hd[q] : hv;
                    if (hv < 128u) pick = gg; }
                if (pick >= 0) { grp = pick; tk = __hip_atomic_fetch_add(ctl + CW_QATT + 64 * grp, 1u, __ATOMIC_RELAXED, __HIP_MEMORY_SCOPE_AGENT); } else tk = 0xffffu; }
            *slot = (tk << 8) | (unsigned)grp; }
        __syncthreads();
        const unsigned sv = *slot; const int grp = (int)(sv & 7u), i = (int)(sv >> 8);
        if (i >= 0xffff) break;
        if (i >= 128) { own = false; continue; }
        if (grp != (int)(xcc & 7u)) own = false;
        if (own && threadIdx.x == 0) pre = __hip_atomic_fetch_add(ctl + CW_QATT + 64 * grp, 1u, __ATOMIC_RELAXED, __HIP_MEMORY_SCOPE_AGENT);
        {
            const int fox = i >> 6, j = i & 63, st = 4 * grp + 2 * (j & 1) + fox, qb = 31 - (j >> 1), bh = st >> 1, b = bh >> 3, h = bh & 7;
            if (!fox) att::attn_unit<6, false, 8>(b, h, qb, C.QM, C.KM, C.VM, C.main.SSQQ, C.O, h * 64, shm, m0_mla, 0);
            else { const int lane = threadIdx.x & 63, cand = 2 * lane; const size_t hb = (size_t)bh * PR;
                bool ok = cand <= 4 * qb;
                if (ok && cand > 0) ok = (C.CUM[hb + 64 + 256 * qb] - C.CUM[hb + 64 * cand - 1]) * LOG2E < prune;
                const unsigned long long m = __ballot(ok); const int tb = 2 * (63 - __builtin_clzll(m));
                att::attn_unit<5, true, 8>(b, h, qb, C.FQ, C.FK, C.FV, C.CUM, C.O, 512 + h * 64, shm, m0_fox, __builtin_amdgcn_readfirstlane(tb)); } } }
    constexpr int NCHUNK = (2 * I_GU + I_DN + 7) / 8;
    for (;;) { const int c = wg_dequeue(ctl + CW_QCONV, slot); if (c >= NCHUNK) break;
        const int w_ = __builtin_amdgcn_readfirstlane(threadIdx.x >> 6); p0_late<1>(C, (float*)shm + w_ * TSCR, c * 8 + w_, NCHUNK * 8, threadIdx.x & 63); }
}
#define LAS __attribute__((address_space(3)))
constexpr int CW_BAR = 1024;
constexpr size_t CTL_ZERO_BYTES = 65536;
constexpr int LDSCTL_OFF = 131072, MISC_OFF = LDSCTL_OFF + 320;
#define XB_TMO      128
#define XB_XCNT(j)  (256  + 64 * (j))
#define XB_XSUB(j)  (1280 + 64 * (j))
#define XB_XGEN(j)  (2304 + 64 * (j))
#define XB_TOP      3328
#define XB_TOPGEN   3392
#define XCD_BAR_WORDS 3456
#define XB_SPIN_CAP (1u << 18)

__device__ __forceinline__ unsigned xb_ld(unsigned* p)              { return __hip_atomic_load(p, __ATOMIC_RELAXED, __HIP_MEMORY_SCOPE_AGENT); }
__device__ __forceinline__ unsigned xb_add(unsigned* p, unsigned v) { return __hip_atomic_fetch_add(p, v, __ATOMIC_RELAXED, __HIP_MEMORY_SCOPE_AGENT); }
__device__ __forceinline__ unsigned xb_xcc_id() { return (unsigned)__builtin_amdgcn_s_getreg((3 << 11) | 20) & 0xFu; }
#define XB_SPIN(cond, bar) do { unsigned _sp = 0; while (cond) { __builtin_amdgcn_s_sleep(1); \
    if ((++_sp & 255u) == 0u) { if (xb_ld(&(bar)[XB_TMO])) break; if (_sp > XB_SPIN_CAP) { atomicAdd(&(bar)[XB_TMO], 1u); break; } } } } while (0)

constexpr int CW_SIDE = 12288;
__device__ __forceinline__ void side_wait(unsigned* w, unsigned target, unsigned* bar) {
    if (threadIdx.x == 0) { XB_SPIN(xb_ld(w) < target, bar); __builtin_amdgcn_fence(__ATOMIC_ACQUIRE, "agent"); asm volatile("s_waitcnt vmcnt(0)" ::: "memory"); }
    __syncthreads();
}
struct XcdBarrier {
    unsigned* bar; unsigned x;
    volatile LAS unsigned* st;
};

__device__ __forceinline__ XcdBarrier xcd_barrier_post(unsigned* bar, volatile LAS unsigned* st) {
    XcdBarrier b; b.bar = bar; b.x = xb_xcc_id(); b.st = st;
    if (threadIdx.x == 0) (void)xb_add(&bar[XB_XCNT(b.x)], 1u);
    return b;
}
__device__ __forceinline__ void xcd_barrier_complete(unsigned* bar, unsigned x, unsigned& nloc, unsigned& nx) {
    const unsigned G = gridDim.x * gridDim.y * gridDim.z;
    unsigned sum, cnt, mine, sp = 0u;
    for (;;) {
        sum = 0u; cnt = 0u; mine = 0u;
#pragma unroll
        for (unsigned j = 0; j < 16; ++j) { const unsigned c = xb_ld(&bar[XB_XCNT(j)]); sum += c; cnt += (c > 0u) ? 1u : 0u; mine = (j == x) ? c : mine; }
        if (sum == G) break;
        __builtin_amdgcn_s_sleep(1);
        if ((++sp & 255u) == 0u) { if (xb_ld(&bar[XB_TMO])) break; if (sp > XB_SPIN_CAP) { atomicAdd(&bar[XB_TMO], 1u); break; } }
    }
    nloc = mine > 0u ? mine : 1u; nx = cnt > 0u ? cnt : 1u;
}

__device__ __forceinline__ void xcd_barrier(const XcdBarrier& b) {
    asm volatile("s_waitcnt vmcnt(0)" ::: "memory");
    __syncthreads();
    if (threadIdx.x == 0) {
        unsigned* bar = b.bar;
        __builtin_amdgcn_s_waitcnt(0);
        unsigned nloc = b.st[0], nx = b.st[1];
        if (nloc == 0u) { xcd_barrier_complete(bar, b.x, nloc, nx); b.st[0] = nloc; b.st[1] = nx; }
        const unsigned old = xb_add(&bar[XB_XSUB(b.x)], 1u);
        const unsigned gen = old / nloc;
        if (old + 1u == (gen + 1u) * nloc) {
            __builtin_amdgcn_fence(__ATOMIC_RELEASE, "agent");
            asm volatile("s_waitcnt vmcnt(0)" ::: "memory");
            const unsigned og = xb_add(&bar[XB_TOP], 1u);
            const unsigned tg = og / nx;
            if (og + 1u == (tg + 1u) * nx) xb_add(&bar[XB_TOPGEN], 1u);
            else XB_SPIN(xb_ld(&bar[XB_TOPGEN]) == tg, bar);
            __builtin_amdgcn_fence(__ATOMIC_ACQUIRE, "agent");
            xb_add(&bar[XB_XGEN(b.x)], 1u);
            asm volatile("s_waitcnt vmcnt(0)" ::: "memory");
        } else {
            XB_SPIN(xb_ld(&bar[XB_XGEN(b.x)]) == gen, bar);
            __builtin_amdgcn_fence(__ATOMIC_ACQUIRE, "agent");
            asm volatile("s_waitcnt vmcnt(0)" ::: "memory");
        }
    }
    __syncthreads();
}

constexpr int NWAVES = 8, LDS_BYTES = 147456;
__device__ __forceinline__ void fk_aug(const Ctx& C, int b, int h, int p, float cum) {
    C.CUM[arow(b, h, p)] = cum;
    const float cc = -cum * LOG2E; const unsigned hi = f2bf(cc); const float r1 = cc - __uint_as_float(hi << 16); const unsigned mid = f2bf(r1); const float r2 = r1 - __uint_as_float(mid << 16); const unsigned lo = f2bf(r2);
    *(u32x4*)(C.FK + kaddr(b, h, p, 64, DFK)) = (u32x4){hi | (mid << 16), lo, 0u, 0u}; *(u32x4*)(C.FK + kaddr(b, h, p, 72, DFK)) = (u32x4){0u, 0u, 0u, 0u};
}
__device__ __forceinline__ void scan_block(const Ctx& C, int bh, float* lds_f, int tid) {
    const int b = bh >> 3, h = bh & 7, lane = tid & 63, w = tid >> 6; constexpr int PER = 16;
    float v[PER]; const int e0 = tid * PER;
#pragma unroll
    for (int i = 0; i < PER; ++i) v[i] = C.main.LOGF[(size_t)(b * T + e0 + i) * 8 + h];
#pragma unroll
    for (int i = 1; i < PER; ++i) v[i] += v[i - 1];
    float s = v[PER - 1];
#pragma unroll
    for (int o = 1; o < 64; o <<= 1) { const float n = __shfl_up(s, o); if (lane >= o) s += n; }
    if (lane == 63) lds_f[w] = s;
    __syncthreads();
    float off = s - v[PER - 1];
#pragma unroll
    for (int j = 0; j < 8; ++j) if (j < w) off += lds_f[j];
#pragma unroll
    for (int i = 0; i < PER; ++i) fk_aug(C, b, h, 64 + e0 + i, off + v[i]);
    if (tid < 16) { float c = 0.f; for (int r = tid + 1; r < 16; ++r) c += C.mt.LOGF[r * 8 + h]; fk_aug(C, b, h, 48 + tid, -c); }
    if (tid >= 256) { const int r = (tid >> 3) & 15, ch = tid & 7;
        if (tid < 384) *(u32x4*)(C.FK + kaddr(b, h, 48 + r, 8 * ch, DFK)) = *(const u32x4*)(C.MFK + (r * 8 + h) * 64 + 8 * ch);
        else *(u32x4*)(C.FV + vaddr(b, h, 48 + r, 8 * ch)) = *(const u32x4*)(C.MFV + (r * 8 + h) * 64 + 8 * ch); }
    if (tid < 48) { const int p = tid; C.CUM[arow(b, h, p)] = 0.f;
        const u32x4 z = {0u, 0u, 0u, 0u};
        for (int j = 0; j < DFK / 8; ++j) *(u32x4*)(C.FK + kaddr(b, h, p, 8 * j, DFK)) = z;
        for (int j = 0; j < DQM / 8; ++j) *(u32x4*)(C.KM + kaddr(b, h, p, 8 * j, DQM)) = z;
        for (int j = 0; j < 8; ++j) { *(u32x4*)(C.FV + vaddr(b, h, p, 8 * j)) = z; *(u32x4*)(C.VM + vaddr(b, h, p, 8 * j)) = z; } }
    __syncthreads();
}
#define GEMM_PHASE(g, E) do { int t_ = threadIdx.x; asm volatile("" : "+v"(t_)); pg8::StaticOrder S_; S_.init((g).M, (g).N, G, (int)blockIdx.x); \
    pg8::gemm_phase<std::remove_cv_t<std::remove_reference_t<decltype(E)>>, pg8::StaticOrder, true, true>(ldsp, g, S_, E, t_); } while (0)
__global__ void __launch_bounds__(NWAVES * 64, 2) mega_fwd(KArgs a) {
    extern __shared__ __attribute__((aligned(16))) unsigned char lds[];
    const Ctx C = make_ctx(a);
    PG8_LAS unsigned char* ldsp = (PG8_LAS unsigned char*)lds;
    const int tid = threadIdx.x, lane = tid & 63, wave = __builtin_amdgcn_readfirstlane(tid >> 6);
    const int G = gridDim.x, gw = blockIdx.x * NWAVES + wave, NGW = G * NWAVES;
    for (int u = tid; u < (LDS_BYTES - LDSCTL_OFF) / 4; u += NWAVES * 64) ((LAS unsigned*)((LAS unsigned char*)lds + LDSCTL_OFF))[u] = 0u;
    __syncthreads();
    PG8_LAS float* const gtab = (PG8_LAS float*)(ldsp + LDSCTL_OFF + 8192);
    if (tid < 320) gtab[tid] = tid < 64 ? C.g_q_fox[tid] : tid < 128 ? C.g_k_fox[tid - 64] : tid < 224 ? C.g_q_mla[tid - 128] : C.g_k_mla[tid - 224];
    __syncthreads();
    unsigned* const ctl = (unsigned*)(a.ws + WS_CTL);
    const XcdBarrier bar = xcd_barrier_post(ctl + CW_BAR, (volatile LAS unsigned*)((LAS unsigned char*)lds + MISC_OFF) + 8);
    p0_prologue(C, (float*)lds + wave * TSCR, gw, wave * G + (int)blockIdx.x, NGW, lane);
    xcd_barrier(bar);
    { const int s_ = (int)blockIdx.x - G / 2, NS = G - G / 2; unsigned* const side = ctl + CW_SIDE;
      if (s_ >= 0) {
          for (int t = s_; t < FF / 16; t += NS) { task_gateup(C.mt.XN1, C.W1GU, nullptr, C.mt.HB, t, lane, wave, (float*)lds); __syncthreads(); }
          if (wave == 0) { asm volatile("s_waitcnt vmcnt(0)" ::: "memory"); if (tid == 0) xb_add(side, 1u); } }
      { const pg8::Gemm g{C.main.XN1, C.W1GU, M, 2 * FF, D, D}; const pg8::EpiSwiglu E{C.main.HB, nullptr}; GEMM_PHASE(g, E); }
      if (s_ >= NS - 16) { side_wait(side, NS, ctl + CW_BAR);
          task_down(C.mt.HB, FF, C.W1D, C.mt.base1, C.mt.H, 0.5f, C.mt.XN, C.mt.SSQ1, s_ - (NS - 16), lane, wave, (float*)lds);
          if (wave == 0) { asm volatile("s_waitcnt vmcnt(0)" ::: "memory"); if (tid == 0) xb_add(side + 64, 1u); } }
      else if (s_ >= 48 && s_ < 66) { side_wait(side + 64, 16, ctl + CW_BAR); task_win(C, C.mt, 0, s_ - 48, lane, wave, (float*)lds); __syncthreads(); }
      else if (s_ >= 0) p0_late<0>(C, (float*)lds + wave * TSCR, (s_ < 48 ? s_ : s_ - 18) * NWAVES + wave, (NS - 34) * NWAVES, lane); }
    xcd_barrier(bar);
    { const pg8::Gemm g{C.main.HB, C.W1D, M, D, FF, FF}; const pg8::EpiResid<1, 0> E{C.main.base1, nullptr, C.main.XN, C.main.SSQ1}; GEMM_PHASE(g, E); }
    xcd_barrier(bar);
    { const pg8::Gemm g{C.main.XN, C.WIN, M, 2048, D, D}; PG8_LAS float* rst = (PG8_LAS float*)(ldsp + LDSCTL_OFF + 1024);
      { pg8::StaticOrder S_; S_.init(g.M, g.N, G, (int)blockIdx.x); pg8::rs_table_fill(C.main.SSQ1, S_, rst, tid); }
      const pg8::EpiWin E{C, rst, gtab}; GEMM_PHASE(g, E); }
    xcd_barrier(bar);
    { int k_ = 128; asm volatile("" : "+s"(k_)); const pg8::Gemm g{C.main.CKV, C.WUKV, M, 1024, k_, k_}; const pg8::EpiUkv E{gtab + 224, C.main.SSQCKV, C.main.SSQKPE, C.main.KPE, C.KM, C.VM, C.ROPE}; GEMM_PHASE(g, E); }
    { const int sb = (int)blockIdx.x - (G - 24);
      if (sb >= 0 && sb < 16) scan_block(C, sb, (float*)lds, tid);
      if (sb >= 16) { task_uqkv(C, C.mt, 8 + (sb - 16), lane, wave, (float*)lds); __syncthreads(); } }
    { int k_ = 256; asm volatile("" : "+s"(k_)); const pg8::Gemm g{C.main.CQ, C.WUQ, M, 768, k_, k_}; const pg8::EpiUq E{gtab + 128, C.main.SSQCQ, C.main.SSQQ, C.QM, C.ROPE}; GEMM_PHASE(g, E); }
    xcd_barrier(bar);
    { static_assert(MISC_OFF + 64 <= LDS_BYTES && att::LDS_BYTES <= LDSCTL_OFF, "attention LDS");
      attn_phase(C, (char*)lds, ctl, bar.x, (volatile LAS unsigned*)((LAS unsigned char*)lds + MISC_OFF) + 12); }
    xcd_barrier(bar);
    { const pg8::Gemm g{C.O, C.WOUT, M, D, D, D}; const pg8::EpiResid<0, 1> E{C.main.XN, nullptr, C.main.XN, C.SSQ2}; GEMM_PHASE(g, E); }
    xcd_barrier(bar);
    { const pg8::Gemm g{C.main.XN, C.W2GU, M, 2 * FF, D, D}; PG8_LAS float* rst = (PG8_LAS float*)(ldsp + LDSCTL_OFF + 1024);
      { pg8::StaticOrder S_; S_.init(g.M, g.N, G, (int)blockIdx.x); pg8::rs_table_fill(C.SSQ2, S_, rst, tid); }
      const pg8::EpiSwiglu E{C.main.HB, rst}; GEMM_PHASE(g, E); }
    xcd_barrier(bar);
    { const pg8::Gemm g{C.main.HB, C.W2D, M, D, FF, FF}; const pg8::EpiResid<1, 1> E{C.main.XN, C.out, nullptr, nullptr}; GEMM_PHASE(g, E); }
}

extern "C" void kernel_launch(void* const* d_in, const int* in_sizes, int n_in, void* d_out, int out_size, void* d_ws, size_t ws_size, hipStream_t stream) {
    static int grid = 0;
    if (grid == 0) {
        if (n_in != 22 || in_sizes[0] != M * D || out_size != M * D || ws_size < WS_END) { fprintf(stderr, "kernel_launch: unexpected shapes (n_in %d, in0 %d, out %d, ws %zu)\n", n_in, n_in > 0 ? in_sizes[0] : -1, out_size, ws_size); grid = -1; return; }
        int dev = 0, cus = 0, per_cu = 0;
        if (hipGetDevice(&dev) != hipSuccess || hipDeviceGetAttribute(&cus, hipDeviceAttributeMultiprocessorCount, dev) != hipSuccess) { grid = -1; return; }
        if (hipFuncSetAttribute((const void*)mega_fwd, hipFuncAttributeMaxDynamicSharedMemorySize, LDS_BYTES) != hipSuccess) { fprintf(stderr, "kernel_launch: hipFuncSetAttribute failed\n"); grid = -1; return; }
        if (hipOccupancyMaxActiveBlocksPerMultiprocessor(&per_cu, (const void*)mega_fwd, NWAVES * 64, LDS_BYTES) != hipSuccess || per_cu < 1) { fprintf(stderr, "kernel_launch: occupancy query reports %d blocks per CU\n", per_cu); grid = -1; return; }
        grid = cus;
    }
    if (grid < 0) return;
    if (hipMemsetAsync((char*)d_ws + WS_CTL, 0, CTL_ZERO_BYTES, stream) != hipSuccess) { fprintf(stderr, "kernel_launch: hipMemsetAsync of the control words failed\n"); return; }
    KArgs a{}; for (int i = 0; i < 22; ++i) a.in[i] = (const float*)d_in[i]; a.out = (float*)d_out; a.ws = (unsigned char*)d_ws;
    void* args[] = {&a};
    const hipError_t e = hipLaunchCooperativeKernel((const void*)mega_fwd, dim3(grid), dim3(NWAVES * 64), args, LDS_BYTES, stream);
    if (e != hipSuccess) fprintf(stderr, "kernel_launch: cooperative launch failed: %s (grid %d)\n", hipGetErrorString(e), grid);
}
```

```cpp
#include <hip/hip_runtime.h>
#include <cstdint>
#include <cstdio>
#include <type_traits>

typedef unsigned short bf16_t;
typedef short bf16x8 __attribute__((ext_vector_type(8)));
typedef float f32x4 __attribute__((ext_vector_type(4)));
typedef unsigned u32x4 __attribute__((ext_vector_type(4)));
typedef unsigned u32x2 __attribute__((ext_vector_type(2)));

constexpr int NB = 2, T = 8192, D = 1024, FF = 2816, M = NB * T, NMETA = 16;
constexpr int PR = 64 + T;
constexpr int NPOS = 16 + T;
constexpr int DQM = 96, DFK = 80, DV = 64;
constexpr float EPS = 1e-6f;
constexpr float LOG2E = 1.4426950408889634f;
constexpr float C2F = 0.125f * LOG2E;
constexpr float C2M = 0.10206207261596577f * LOG2E;

constexpr size_t KiB = 1024, MiB = 1u << 20;
constexpr size_t WS_CTL = 0;
constexpr size_t WS_W1GU = 1 * MiB, WS_W1D = 12 * MiB, WS_W2GU = 18 * MiB, WS_W2D = 29 * MiB, WS_WIN = 35 * MiB, WS_WOUT = 39 * MiB;
constexpr size_t WS_WUQ = 41 * MiB, WS_WUKV = 41 * MiB + 512 * KiB, WS_ROPE = 42 * MiB;
constexpr size_t WS_META = 43 * MiB + 512 * KiB;
constexpr size_t WS_XN = 44 * MiB, WS_CQ = 76 * MiB, WS_CKV = 84 * MiB, WS_KPE = 88 * MiB, WS_LOGF = 90 * MiB, WS_CUM = 90 * MiB + 512 * KiB;
constexpr size_t WS_SSQ1 = 91 * MiB + 256 * KiB, WS_SSQ2 = 92 * MiB + 256 * KiB, WS_SSQCQ = 93 * MiB + 256 * KiB, WS_SSQCKV = 93 * MiB + 512 * KiB, WS_SSQKPE = 93 * MiB + 768 * KiB, WS_SSQQ = 94 * MiB;
constexpr size_t WS_HB = 95 * MiB;
constexpr size_t WS_FQ = 95 * MiB, WS_FK = 111 * MiB + 256 * KiB, WS_FV = 131 * MiB + 512 * KiB, WS_QM = 147 * MiB + 768 * KiB, WS_KM = 172 * MiB, WS_VM = 196 * MiB + 256 * KiB, WS_O = 212 * MiB + 512 * KiB;
constexpr size_t WS_END = 256 * MiB;
static_assert(WS_FQ + (size_t)NB * 8 * PR * 64 * 2 <= WS_FK && WS_FK + (size_t)NB * 8 * PR * DFK * 2 <= WS_FV && WS_FV + (size_t)NB * 8 * PR * 64 * 2 <= WS_QM, "ws map 1");
static_assert(WS_QM + (size_t)NB * 8 * PR * DQM * 2 <= WS_KM && WS_KM + (size_t)NB * 8 * PR * DQM * 2 <= WS_VM && WS_VM + (size_t)NB * 8 * PR * 64 * 2 <= WS_O && WS_O + (size_t)M * D * 2 <= WS_END, "ws map 2");
static_assert(WS_ROPE + (size_t)NPOS * 16 * 8 <= WS_META && WS_CUM + (size_t)NB * 8 * PR * 4 <= WS_SSQ1 && WS_HB + (size_t)M * FF * 2 <= WS_END, "ws map 3");
constexpr size_t MO_XNM = 0, MO_HB = 32 * KiB, MO_H = 128 * KiB, MO_XN = 192 * KiB, MO_SSQ1 = 224 * KiB, MO_CQ = 228 * KiB, MO_SSQCQ = 236 * KiB, MO_CKV = 237 * KiB, MO_SSQCKV = 241 * KiB,
                 MO_KPE = 242 * KiB, MO_SSQKPE = 244 * KiB, MO_LOGF = 245 * KiB, MO_SSQQ = 246 * KiB, MO_FKS = 256 * KiB, MO_FVS = 272 * KiB;

__device__ __forceinline__ float bf2f(bf16_t v) { return __uint_as_float((unsigned)v << 16); }
__device__ __forceinline__ unsigned f2bf(float f) { unsigned u = __float_as_uint(f); return (u + 0x7fffu + ((u >> 16) & 1u)) >> 16; }
__device__ __forceinline__ unsigned pk2(float lo, float hi) { return f2bf(lo) | (f2bf(hi) << 16); }
__device__ __forceinline__ float rsum16(float v) { v += __shfl_xor(v, 1); v += __shfl_xor(v, 2); v += __shfl_xor(v, 4); v += __shfl_xor(v, 8); return v; }
__device__ __forceinline__ float wave_sum(float v) {
#pragma unroll
    for (int o = 1; o < 64; o <<= 1) v += __shfl_xor(v, o);
    return v;
}
__device__ __forceinline__ float sum16f(const float* p) { const f32x4 a = ((const f32x4*)p)[0], b = ((const f32x4*)p)[1], c = ((const f32x4*)p)[2], d = ((const f32x4*)p)[3];
    return ((a[0] + a[1]) + (a[2] + a[3])) + ((b[0] + b[1]) + (b[2] + b[3])) + ((c[0] + c[1]) + (c[2] + c[3])) + ((d[0] + d[1]) + (d[2] + d[3])); }
__device__ __forceinline__ float sum4f(const float* p) { const f32x4 a = *(const f32x4*)p; return (a[0] + a[1]) + (a[2] + a[3]); }
__device__ __forceinline__ float silu_mul(float g, float u) { return g / (1.0f + __expf(-g)) * u; }
__device__ __forceinline__ float log_sigmoid(float x) { return fminf(x, 0.f) - 0.6931471805599453f * __builtin_amdgcn_logf(1.0f + __builtin_amdgcn_exp2f(-LOG2E * fabsf(x))); }

__host__ __device__ __forceinline__ int gu_row_gate(int c) { return 256 * (c >> 7) + (c & 127); }
__host__ __device__ __forceinline__ int rope_slot(int dd) { return 8 * ((dd & 15) >> 2) + 4 * (dd >> 4) + (dd & 3); }
__host__ __device__ __forceinline__ int win_row(int s) {
    if (s < 256) return s;
    if (s < 384) return 256 + (s - 256);
    if (s < 416) return 256 + 128 + rope_slot(s - 384);
    if (s < 1952) { const int i = s - 416, which = i >> 9, head = (i & 511) >> 6, d = i & 63; return 256 * (2 + which * 2 + (head >> 2)) + 128 * (d >> 5) + 32 * (head & 3) + (d & 31); }
    return 256 + 160 + (s - 1952);
}
__host__ __device__ __forceinline__ int wuq_row(int s) { const int h = s / 96, d = s % 96;
    if (d < 64) return 256 * (h >> 2) + 128 * (d >> 5) + 32 * (h & 3) + (d & 31);
    return 512 + 128 * (h & 1) + 32 * (h >> 1) + rope_slot(d - 64); }
__host__ __device__ __forceinline__ int wukv_row(int s) { const int h = s >> 7, d = s & 127;
    if (d < 64) return 256 * (h >> 2) + 128 * (d >> 5) + 32 * (h & 3) + (d & 31);
    const int e = d - 64; return 256 * (2 + (h >> 2)) + 128 * (e >> 5) + 32 * (h & 3) + (e & 31); }

struct KArgs { const float* in[22]; float* out; unsigned char* ws; };
struct RowSet {
    int nrows, meta;
    const bf16_t* XN1; const float* base1; bf16_t* HB; float* H; bf16_t* XN; float* SSQ1;
    bf16_t* CQ; float* SSQCQ; bf16_t* CKV; float* SSQCKV; float* KPE; float* SSQKPE; float* LOGF; float* SSQQ;
};
struct Ctx {
    const float *x, *meta, *g_ffn1, *w1g, *w1u, *w1d, *g_mix, *w_in, *g_cq, *w_uq, *g_ckv, *w_ukv, *g_q_mla, *g_k_mla, *b_forget, *g_q_fox, *g_k_fox, *w_out, *g_ffn2, *w2g, *w2u, *w2d;
    float* out; unsigned char* ws;
    bf16_t *W1GU, *W1D, *W2GU, *W2D, *WIN, *WOUT, *WUQ, *WUKV; float* ROPE;
    bf16_t *FQ, *FK, *FV, *QM, *KM, *VM, *O; float* CUM; float* SSQ2; bf16_t *MFK, *MFV;
    RowSet main, mt;
};
__device__ __forceinline__ Ctx make_ctx(const KArgs& a) {
    Ctx c;
    c.x = a.in[0]; c.meta = a.in[1]; c.g_ffn1 = a.in[2]; c.w1g = a.in[3]; c.w1u = a.in[4]; c.w1d = a.in[5]; c.g_mix = a.in[6]; c.w_in = a.in[7]; c.g_cq = a.in[8]; c.w_uq = a.in[9]; c.g_ckv = a.in[10];
    c.w_ukv = a.in[11]; c.g_q_mla = a.in[12]; c.g_k_mla = a.in[13]; c.b_forget = a.in[14]; c.g_q_fox = a.in[15]; c.g_k_fox = a.in[16]; c.w_out = a.in[17]; c.g_ffn2 = a.in[18]; c.w2g = a.in[19]; c.w2u = a.in[20]; c.w2d = a.in[21];
    c.out = a.out; c.ws = a.ws; unsigned char* ws = a.ws;
    c.W1GU = (bf16_t*)(ws + WS_W1GU); c.W1D = (bf16_t*)(ws + WS_W1D); c.W2GU = (bf16_t*)(ws + WS_W2GU); c.W2D = (bf16_t*)(ws + WS_W2D); c.WIN = (bf16_t*)(ws + WS_WIN); c.WOUT = (bf16_t*)(ws + WS_WOUT);
    c.WUQ = (bf16_t*)(ws + WS_WUQ); c.WUKV = (bf16_t*)(ws + WS_WUKV); c.ROPE = (float*)(ws + WS_ROPE);
    c.FQ = (bf16_t*)(ws + WS_FQ); c.FK = (bf16_t*)(ws + WS_FK); c.FV = (bf16_t*)(ws + WS_FV); c.QM = (bf16_t*)(ws + WS_QM); c.KM = (bf16_t*)(ws + WS_KM); c.VM = (bf16_t*)(ws + WS_VM); c.O = (bf16_t*)(ws + WS_O);
    c.CUM = (float*)(ws + WS_CUM); c.SSQ2 = (float*)(ws + WS_SSQ2);
    RowSet& m = c.main; m.nrows = M; m.meta = 0; m.XN1 = (bf16_t*)(ws + WS_XN); m.base1 = c.x; m.HB = (bf16_t*)(ws + WS_HB); m.H = a.out; m.XN = (bf16_t*)(ws + WS_XN); m.SSQ1 = (float*)(ws + WS_SSQ1);
    m.CQ = (bf16_t*)(ws + WS_CQ); m.SSQCQ = (float*)(ws + WS_SSQCQ); m.CKV = (bf16_t*)(ws + WS_CKV); m.SSQCKV = (float*)(ws + WS_SSQCKV); m.KPE = (float*)(ws + WS_KPE); m.SSQKPE = (float*)(ws + WS_SSQKPE);
    m.LOGF = (float*)(ws + WS_LOGF); m.SSQQ = (float*)(ws + WS_SSQQ);
    unsigned char* mw = ws + WS_META; RowSet& t = c.mt; t.nrows = NMETA; t.meta = 1; t.XN1 = (bf16_t*)(mw + MO_XNM); t.base1 = c.meta; t.HB = (bf16_t*)(mw + MO_HB); t.H = (float*)(mw + MO_H); t.XN = (bf16_t*)(mw + MO_XN);
    t.SSQ1 = (float*)(mw + MO_SSQ1); t.CQ = (bf16_t*)(mw + MO_CQ); t.SSQCQ = (float*)(mw + MO_SSQCQ); t.CKV = (bf16_t*)(mw + MO_CKV); t.SSQCKV = (float*)(mw + MO_SSQCKV); t.KPE = (float*)(mw + MO_KPE);
    t.SSQKPE = (float*)(mw + MO_SSQKPE); t.LOGF = (float*)(mw + MO_LOGF); t.SSQQ = (float*)(mw + MO_SSQQ);
    c.MFK = (bf16_t*)(mw + MO_FKS); c.MFV = (bf16_t*)(mw + MO_FVS);
    return c;
}
__device__ __forceinline__ size_t arow(int b, int h, int p) { return (size_t)((b * 8 + h) * PR + p); }
__device__ __forceinline__ size_t kaddr(int b, int h, int p, int d, int DK) { return ((size_t)((b * 8 + h) * PR + (p & ~63))) * DK + (size_t)((d >> 3) * 512 + (p & 63) * 8 + (d & 7)); }
__device__ __forceinline__ size_t vaddr(int b, int h, int p, int d) { return ((size_t)((b * 8 + h) * PR + (p & ~63))) * 64 + (size_t)((d >> 5) * 2048 + (p & 63) * 32 + (d & 31)); }

constexpr int TSCR = 32 * 68;
__device__ __forceinline__ void st_wt(bf16_t* p, bf16_t v) { __hip_atomic_store(p, v, __ATOMIC_RELAXED, __HIP_MEMORY_SCOPE_AGENT); }
__device__ __forceinline__ void st_wt(float* p, float v) { __hip_atomic_store(p, v, __ATOMIC_RELAXED, __HIP_MEMORY_SCOPE_AGENT); }
template <class MapF>
__device__ __forceinline__ void p0_transpose_item(const float* W, int K, int N, const float* gain, bf16_t* WT, MapF map, float* scr_, int item, int lane) {
    asm volatile("" : "+v"(lane));
    unsigned* scr = (unsigned*)scr_;
    const int nblk = (N + 63) / 64, kb = item / nblk, nb = item % nblk, k0 = 64 * kb, n0 = 64 * nb;
    const int x = lane & 15, kr = lane >> 4, nq = n0 + 4 * x;
    f32x4 e[8], o[8];
#pragma unroll
    for (int j = 0; j < 8; ++j) { const int k = k0 + 8 * j + 2 * kr;
        if (nq < N) { e[j] = *(const f32x4*)(W + (size_t)k * N + nq); o[j] = *(const f32x4*)(W + (size_t)(k + 1) * N + nq); } else { e[j] = (f32x4){0.f, 0.f, 0.f, 0.f}; o[j] = e[j]; } }
#pragma unroll
    for (int j = 0; j < 8; ++j) { const int k = k0 + 8 * j + 2 * kr; float ge = 1.f, go = 1.f; if (gain) { ge = gain[k]; go = gain[k + 1]; }
        u32x4 p; p.x = pk2(e[j].x * ge, o[j].x * go); p.y = pk2(e[j].y * ge, o[j].y * go); p.z = pk2(e[j].z * ge, o[j].z * go); p.w = pk2(e[j].w * ge, o[j].w * go);
        *(u32x4*)(scr + (4 * j + kr) * 68 + 4 * x) = p; }
    asm volatile("s_waitcnt vmcnt(0) lgkmcnt(0)" ::: "memory");
    const int c = lane >> 3;
#pragma unroll
    for (int j = 0; j < 8; ++j) { const int n = (lane & 7) + 8 * j; if (n0 + n < N) { const unsigned* t = scr + (4 * c) * 68 + n;
        const u32x4 v = {t[0], t[68], t[136], t[204]};
        *(u32x4*)(WT + (size_t)map(n0 + n) * K + k0 + 8 * c) = v; } }
    asm volatile("s_waitcnt vmcnt(0) lgkmcnt(0)" ::: "memory");
}
struct MapId { __device__ int operator()(int n) const { return n; } };
struct MapGate { __device__ int operator()(int n) const { return gu_row_gate(n); } };
struct MapUp { __device__ int operator()(int n) const { return gu_row_gate(n) + 128; } };
struct MapWin { __device__ int operator()(int n) const { return win_row(n); } };
struct MapWuq { __device__ int operator()(int n) const { return wuq_row(n); } };
struct MapWukv { __device__ int operator()(int n) const { return wukv_row(n); } };

__device__ __constant__ double INV_FREQ[16] = {1.0, 0.5623413251903491, 0.31622776601683794, 0.1778279410038923, 0.1, 0.05623413251903491, 0.03162277660168379, 0.01778279410038923,
                                               0.01, 0.005623413251903491, 0.0031622776601683794, 0.0017782794100389228, 0.001, 0.0005623413251903491, 0.00031622776601683794, 0.00017782794100389227};
__device__ __forceinline__ void sincos_d(double x, float& s, float& c) {
    const double k = rint(x * 0.15915494309189535); const double r = fma(-k, 6.283185307179586, x) - k * 2.4492935982947064e-16; const double r2 = r * r;
    double ss = 1.0 / 15511210043330985984000000.0, cc = 1.0 / 620448401733239439360000.0;
    const double sf[12] = {1.0 / 25852016738884976640000.0, 1.0 / 51090942171709440000.0, 1.0 / 121645100408832000.0, 1.0 / 355687428096000.0, 1.0 / 1307674368000.0, 1.0 / 6227020800.0, 1.0 / 39916800.0,
                           1.0 / 362880.0, 1.0 / 5040.0, 1.0 / 120.0, 1.0 / 6.0, 1.0};
    const double cf[12] = {1.0 / 1124000727777607680000.0, 1.0 / 2432902008176640000.0, 1.0 / 6402373705728000.0, 1.0 / 20922789888000.0, 1.0 / 87178291200.0, 1.0 / 479001600.0, 1.0 / 3628800.0,
                           1.0 / 40320.0, 1.0 / 720.0, 1.0 / 24.0, 1.0 / 2.0, 1.0};
#pragma unroll
    for (int i = 0; i < 12; ++i) { ss = fma(-ss, r2, sf[i]); cc = fma(-cc, r2, cf[i]); }
    s = (float)(ss * r); c = (float)cc;
}
__device__ __forceinline__ void rms_row_to_bf16(const float* xrow, bf16_t* orow, int lane) {
    const f32x4* xr = (const f32x4*)xrow + lane; f32x4 v[4]; float s = 0.f;
#pragma unroll
    for (int j = 0; j < 4; ++j) { v[j] = xr[64 * j]; s += (v[j].x * v[j].x + v[j].y * v[j].y) + (v[j].z * v[j].z + v[j].w * v[j].w); }
    const float rstd = 1.0f / sqrtf(wave_sum(s) * (1.f / D) + EPS);
    unsigned long long* o8 = (unsigned long long*)orow + lane;
#pragma unroll
    for (int j = 0; j < 4; ++j) o8[64 * j] = (unsigned long long)pk2(v[j].x * rstd, v[j].y * rstd) | ((unsigned long long)pk2(v[j].z * rstd, v[j].w * rstd) << 32);
}
__device__ __forceinline__ void rms_row2_to_bf16(const float* x0, const float* x1, bf16_t* o0, bf16_t* o1, int lane) {
    const f32x4* xa = (const f32x4*)x0 + lane; const f32x4* xb = (const f32x4*)x1 + lane; f32x4 va[4], vb[4]; float sa = 0.f, sb = 0.f;
#pragma unroll
    for (int j = 0; j < 4; ++j) { va[j] = xa[64 * j]; vb[j] = xb[64 * j]; }
#pragma unroll
    for (int j = 0; j < 4; ++j) { sa += (va[j].x * va[j].x + va[j].y * va[j].y) + (va[j].z * va[j].z + va[j].w * va[j].w); sb += (vb[j].x * vb[j].x + vb[j].y * vb[j].y) + (vb[j].z * vb[j].z + vb[j].w * vb[j].w); }
    const float ra = 1.0f / sqrtf(wave_sum(sa) * (1.f / D) + EPS), rb = 1.0f / sqrtf(wave_sum(sb) * (1.f / D) + EPS);
    unsigned long long* pa = (unsigned long long*)o0 + lane; unsigned long long* pb = (unsigned long long*)o1 + lane;
#pragma unroll
    for (int j = 0; j < 4; ++j) { pa[64 * j] = (unsigned long long)pk2(va[j].x * ra, va[j].y * ra) | ((unsigned long long)pk2(va[j].z * ra, va[j].w * ra) << 32);
                                  pb[64 * j] = (unsigned long long)pk2(vb[j].x * rb, vb[j].y * rb) | ((unsigned long long)pk2(vb[j].z * rb, vb[j].w * rb) << 32); }
}
constexpr int I_GU = (D / 64) * (FF / 64), I_DN = (FF / 64) * (D / 64), I_IN = (D / 64) * ((1960 + 63) / 64), I_OUT = (D / 64) * (D / 64), I_UQ = (256 / 64) * (768 / 64), I_UKV = (128 / 64) * (1024 / 64);
__device__ __forceinline__ void p0_prologue(const Ctx& C, float* scr, int gw, int gwi, int NGW, int lane) {
    for (int it = gwi; it < 2 * I_GU + I_DN + I_IN; it += NGW) {
        int r = it;
        if (r < I_GU) { p0_transpose_item(C.w1g, D, FF, C.g_ffn1, C.W1GU, MapGate(), scr, r, lane); continue; } r -= I_GU;
        if (r < I_GU) { p0_transpose_item(C.w1u, D, FF, C.g_ffn1, C.W1GU, MapUp(), scr, r, lane); continue; } r -= I_GU;
        if (r < I_DN) { p0_transpose_item(C.w1d, FF, D, nullptr, C.W1D, MapId(), scr, r, lane); continue; } r -= I_DN;
        p0_transpose_item(C.w_in, D, 1960, C.g_mix, C.WIN, MapWin(), scr, r, lane);
    }
    for (int i = gw * 64 + lane; i < 88 * 128; i += NGW * 64) { const int row = 256 + 168 + i / 128, ch = i % 128; *(u32x4*)(C.WIN + (size_t)row * D + ch * 8) = (u32x4){0u, 0u, 0u, 0u}; }
    for (int m = gw; m < M / 2; m += NGW) rms_row2_to_bf16(C.x + (size_t)m * D, C.x + (size_t)(m + M / 2) * D, (bf16_t*)C.main.XN1 + (size_t)m * D, (bf16_t*)C.main.XN1 + (size_t)(m + M / 2) * D, lane);
    for (int m = gw; m < NMETA; m += NGW) rms_row_to_bf16(C.meta + (size_t)m * D, (bf16_t*)C.mt.XN1 + (size_t)m * D, lane);
    for (int i = gw * 64 + lane; i < NPOS * 16; i += NGW * 64) { const int pos = i >> 4, f = i & 15; float s, c; sincos_d((double)pos * INV_FREQ[f], s, c); C.ROPE[2 * i] = c; C.ROPE[2 * i + 1] = s; }
}
template <int PART> __device__ __forceinline__ void p0_late(const Ctx& C, float* scr, int gw, int NGW, int lane) {
    if (PART == 0) {
        for (int it = gw; it < I_OUT + I_UQ + I_UKV; it += NGW) {
            int r = it;
            if (r < I_OUT) { p0_transpose_item(C.w_out, D, D, nullptr, C.WOUT, MapId(), scr, r, lane); continue; } r -= I_OUT;
            if (r < I_UQ) { p0_transpose_item(C.w_uq, 256, 768, C.g_cq, C.WUQ, MapWuq(), scr, r, lane); continue; } r -= I_UQ;
            p0_transpose_item(C.w_ukv, 128, 1024, C.g_ckv, C.WUKV, MapWukv(), scr, r, lane);
        }
    } else {
        for (int it = gw; it < 2 * I_GU + I_DN; it += NGW) {
            int r = it;
            if (r < I_GU) { p0_transpose_item(C.w2g, D, FF, C.g_ffn2, C.W2GU, MapGate(), scr, r, lane); continue; } r -= I_GU;
            if (r < I_GU) { p0_transpose_item(C.w2u, D, FF, C.g_ffn2, C.W2GU, MapUp(), scr, r, lane); continue; } r -= I_GU;
            p0_transpose_item(C.w2d, FF, D, nullptr, C.W2D, MapId(), scr, r, lane);
        }
    }
}

template <int NT, int UNR>
__device__ __forceinline__ void wg_gemm16_steps(const bf16_t* ap, const bf16_t* const (&bp)[NT], int k0, f32x4 (&acc)[NT]) {
    bf16x8 a[UNR], b[UNR][NT];
#pragma unroll
    for (int u = 0; u < UNR; ++u) { a[u] = *(const bf16x8*)(ap + k0 + 32 * u);
#pragma unroll
        for (int t = 0; t < NT; ++t) b[u][t] = *(const bf16x8*)(bp[t] + k0 + 32 * u); }
#pragma unroll
    for (int u = 0; u < UNR; ++u)
#pragma unroll
        for (int t = 0; t < NT; ++t) acc[t] = __builtin_amdgcn_mfma_f32_16x16x32_bf16(a[u], b[u][t], acc[t], 0, 0, 0);
}
template <int NT, int NSPLIT, int UNR>
__device__ __forceinline__ void wg_gemm16(const bf16_t* ap, const bf16_t* const (&bp)[NT], int K, f32x4 (&acc)[NT], int wave, int lane, float* red) {
    const int ksl = K / NSPLIT, kb = wave * ksl, ke = kb + ksl;
    if (wave < NSPLIT) {
        int k0 = kb;
        for (; k0 + 32 * UNR <= ke; k0 += 32 * UNR) wg_gemm16_steps<NT, UNR>(ap, bp, k0, acc);
        { const int r = (ke - k0) >> 5;
          if (UNR > 3 && r == 3) wg_gemm16_steps<NT, 3>(ap, bp, k0, acc); else if (UNR > 2 && r == 2) wg_gemm16_steps<NT, 2>(ap, bp, k0, acc); else for (; k0 < ke; k0 += 32) wg_gemm16_steps<NT, 1>(ap, bp, k0, acc); }
#pragma unroll
        for (int t = 0; t < NT; ++t) *(f32x4*)(red + (size_t)((wave * NT + t) * 64 + lane) * 4) = acc[t];
    }
    __syncthreads();
    if (wave == 0) {
#pragma unroll
        for (int t = 0; t < NT; ++t) { f32x4 sum = *(const f32x4*)(red + (size_t)(t * 64 + lane) * 4);
#pragma unroll
            for (int w = 1; w < NSPLIT; ++w) sum += *(const f32x4*)(red + (size_t)((w * NT + t) * 64 + lane) * 4);
            acc[t] = sum; asm volatile("" ::: "memory"); }
    }
}
__device__ __forceinline__ void task_gateup(const bf16_t* A, const bf16_t* Wgu, const float* ssq, bf16_t* HB, int task, int lane, int wave, float* red) {
    asm volatile("" : "+v"(lane));
    const int ncb = FF / 16, rg = task / ncb, cb = task % ncb, c = lane & 15, q = lane >> 4, hc = cb * 16 + c;
    const bf16_t* ap = A + (size_t)(rg * 16 + c) * D + 8 * q;
    const bf16_t* g0 = Wgu + (size_t)gu_row_gate(hc) * D + 8 * q;
    const bf16_t* const bp[2] = {g0, g0 + (size_t)128 * D};
    f32x4 acc[2]; acc[0] = (f32x4){0.f, 0.f, 0.f, 0.f}; acc[1] = acc[0];
    wg_gemm16<2, 8, 4>(ap, bp, D, acc, wave, lane, red); if (wave != 0) return;
#pragma unroll
    for (int i = 0; i < 4; ++i) { const int row = rg * 16 + 4 * q + i; const float rs = ssq ? 1.0f / sqrtf(sum16f(ssq + (size_t)row * 16) * (1.f / D) + EPS) : 1.f;
        st_wt(HB + (size_t)row * FF + hc, (bf16_t)f2bf(silu_mul(acc[0][i] * rs, acc[1][i] * rs))); }
}
__device__ __forceinline__ void task_down(const bf16_t* A, int K, const bf16_t* Wt, const float* base, float* out, float scale, bf16_t* XN, float* SSQ, int task, int lane, int wave, float* red) {
    asm volatile("" : "+v"(lane));
    const int rg = task >> 4, cb = task & 15, c = lane & 15, q = lane >> 4;
    const bf16_t* ap = A + (size_t)(rg * 16 + c) * K + 8 * q;
    const bf16_t* b0 = Wt + (size_t)(cb * 64 + c) * K + 8 * q;
    const bf16_t* const bp[4] = {b0, b0 + (size_t)16 * K, b0 + (size_t)32 * K, b0 + (size_t)48 * K};
    f32x4 acc[4];
#pragma unroll
    for (int t = 0; t < 4; ++t) acc[t] = (f32x4){0.f, 0.f, 0.f, 0.f};
    wg_gemm16<4, 8, 4>(ap, bp, K, acc, wave, lane, red); if (wave != 0) return;
#pragma unroll
    for (int i = 0; i < 4; ++i) { const int row = rg * 16 + 4 * q + i; float sq = 0.f;
#pragma unroll
        for (int t = 0; t < 4; ++t) { const size_t o = (size_t)row * D + cb * 64 + t * 16 + c; const float v = base[o] + scale * acc[t][i]; st_wt(out + o, v); if (XN) st_wt(XN + o, (bf16_t)f2bf(v)); sq += v * v; }
        sq = rsum16(sq); if (SSQ && c == 0) st_wt(SSQ + (size_t)row * 16 + cb, sq); }
}
__device__ __forceinline__ void task_win(const Ctx& C, const RowSet& R, int rg, int job, int lane, int wave, float* red) {
    asm volatile("" : "+v"(lane));
    const int c = lane & 15, q = lane >> 4;
    const bf16_t* ap = R.XN + (size_t)(rg * 16 + c) * D + 8 * q;
    if (job == 0) {
        const bf16_t* bp[8];
#pragma unroll
        for (int t = 0; t < 8; ++t) bp[t] = C.WIN + (size_t)win_row(256 + 16 * t + c) * D + 8 * q;
        f32x4 acc[8];
#pragma unroll
        for (int t = 0; t < 8; ++t) acc[t] = (f32x4){0.f, 0.f, 0.f, 0.f};
        wg_gemm16<8, 8, 2>(ap, bp, D, acc, wave, lane, red); if (wave != 0) return;
#pragma unroll
        for (int i = 0; i < 4; ++i) { const int row = rg * 16 + 4 * q + i; const float rs = 1.0f / sqrtf(sum16f(R.SSQ1 + (size_t)row * 16) * (1.f / D) + EPS); float sq = 0.f;
#pragma unroll
            for (int t = 0; t < 8; ++t) { const float v = acc[t][i] * rs; sq += v * v; R.CKV[(size_t)row * 128 + 16 * t + c] = (bf16_t)f2bf(v); }
            sq = rsum16(sq); if (c == 0) *(f32x4*)(R.SSQCKV + (size_t)row * 4) = (f32x4){sq, 0.f, 0.f, 0.f}; }
    } else if (job == 1) {
        const bf16_t* bp[3];
#pragma unroll
        for (int t = 0; t < 2; ++t) bp[t] = C.WIN + (size_t)win_row(384 + 16 * t + c) * D + 8 * q;
        bp[2] = C.WIN + (size_t)(c < 8 ? win_row(1952 + c) : 256 + 168 + c) * D + 8 * q;
        f32x4 acc[3];
#pragma unroll
        for (int t = 0; t < 3; ++t) acc[t] = (f32x4){0.f, 0.f, 0.f, 0.f};
        wg_gemm16<3, 8, 4>(ap, bp, D, acc, wave, lane, red); if (wave != 0) return;
#pragma unroll
        for (int i = 0; i < 4; ++i) { const int row = rg * 16 + 4 * q + i; const float rs = 1.0f / sqrtf(sum16f(R.SSQ1 + (size_t)row * 16) * (1.f / D) + EPS); float sp = 0.f;
#pragma unroll
            for (int t = 0; t < 2; ++t) { const float v = acc[t][i] * rs; sp += v * v; R.KPE[(size_t)row * 32 + 16 * t + c] = v; }
            sp = rsum16(sp); if (c == 0) R.SSQKPE[row] = sp;
            if (c < 8) R.LOGF[(size_t)row * 8 + c] = log_sigmoid(acc[2][i] * rs + C.b_forget[c]); }
    } else {
        const int which = 1 + ((job - 2) >> 3), h = (job - 2) & 7;
        const bf16_t* bp[4];
#pragma unroll
        for (int t = 0; t < 4; ++t) bp[t] = C.WIN + (size_t)win_row(416 + which * 512 + h * 64 + 16 * t + c) * D + 8 * q;
        f32x4 acc[4];
#pragma unroll
        for (int t = 0; t < 4; ++t) acc[t] = (f32x4){0.f, 0.f, 0.f, 0.f};
        wg_gemm16<4, 8, 4>(ap, bp, D, acc, wave, lane, red); if (wave != 0) return;
#pragma unroll
        for (int i = 0; i < 4; ++i) { const int row = rg * 16 + 4 * q + i; const float rs = 1.0f / sqrtf(sum16f(R.SSQ1 + (size_t)row * 16) * (1.f / D) + EPS); float sq = 0.f; float v[4];
#pragma unroll
            for (int t = 0; t < 4; ++t) { v[t] = acc[t][i] * rs; sq += v[t] * v[t]; }
            sq = rsum16(sq); const float r = 1.0f / sqrtf(sq * (1.f / 64.f) + EPS);
#pragma unroll
            for (int t = 0; t < 4; ++t) { const int d = 16 * t + c;
                if (which == 1) C.MFK[(row * 8 + h) * 64 + d] = (bf16_t)f2bf(v[t] * r * C.g_k_fox[d]);
                else C.MFV[(row * 8 + h) * 64 + d] = (bf16_t)f2bf(v[t]); } }
    }
}
__device__ __forceinline__ void task_uqkv(const Ctx& C, const RowSet& R, int task, int lane, int wave, float* red) {
    asm volatile("" : "+v"(lane));
    const int rg = task >> 4, job = task & 15, h = job & 7, c = lane & 15, q = lane >> 4;
    int rows[4];
#pragma unroll
    for (int i = 0; i < 4; ++i) rows[i] = rg * 16 + 4 * q + i;
    {
        const bf16_t* ap = R.CKV + (size_t)(rg * 16 + c) * 128 + 8 * q;
        const bf16_t* bp[8];
#pragma unroll
        for (int t = 0; t < 8; ++t) bp[t] = C.WUKV + (size_t)wukv_row(h * 128 + 16 * t + c) * 128 + 8 * q;
        f32x4 acc[8];
#pragma unroll
        for (int t = 0; t < 8; ++t) acc[t] = (f32x4){0.f, 0.f, 0.f, 0.f};
        wg_gemm16<8, 4, 1>(ap, bp, 128, acc, wave, lane, red); if (wave != 0) return;
#pragma unroll
        for (int i = 0; i < 4; ++i) { const int row = rows[i]; const float rs = 1.0f / sqrtf(sum4f(R.SSQCKV + (size_t)row * 4) * (1.f / 128.f) + EPS);
            float v[8], s0 = 0.f;
#pragma unroll
            for (int t = 0; t < 8; ++t) { v[t] = acc[t][i] * rs; if (t < 4) s0 += v[t] * v[t]; }
            s0 = rsum16(s0); const float rk = 1.0f / sqrtf((s0 + R.SSQKPE[row]) * (1.f / 96.f) + EPS);
            const int p = R.meta ? 48 + row : 64 + (row & (T - 1)); const int b0 = R.meta ? 0 : row >> 13, b1 = R.meta ? 2 : b0 + 1;
            const float cs = C.ROPE[(size_t)(p - 48) * 32 + 2 * c], sn = C.ROPE[(size_t)(p - 48) * 32 + 2 * c + 1];
            const float x1 = R.KPE[(size_t)row * 32 + c] * rk * C.g_k_mla[64 + c], x2 = R.KPE[(size_t)row * 32 + 16 + c] * rk * C.g_k_mla[80 + c];
            for (int b = b0; b < b1; ++b) {
#pragma unroll
                for (int t = 0; t < 4; ++t) { C.KM[kaddr(b, h, p, 16 * t + c, DQM)] = (bf16_t)f2bf(v[t] * rk * C.g_k_mla[16 * t + c]); C.VM[vaddr(b, h, p, 16 * t + c)] = (bf16_t)f2bf(v[4 + t]); }
                C.KM[kaddr(b, h, p, 64 + c, DQM)] = (bf16_t)f2bf(x1 * cs - x2 * sn); C.KM[kaddr(b, h, p, 80 + c, DQM)] = (bf16_t)f2bf(x2 * cs + x1 * sn); } }
    }
}


namespace pg8 {
#define PG8_LAS __attribute__((address_space(3)))
typedef unsigned short bf16_t;
typedef short bf16x8 __attribute__((ext_vector_type(8)));
typedef float f32x4 __attribute__((ext_vector_type(4)));
typedef unsigned u32x4 __attribute__((ext_vector_type(4)));
constexpr int BM = 256, BK = 64, HALF = 128, HTB = HALF * BK * 2  , STAGE_BYTES = 8 * HTB, NXCD = 8, WGM = 8;

__host__ __device__ __forceinline__ int lds_byte(int r, int c) { const int st = (r >> 4) * 2 + (c >> 5), rr = r & 15, cc = c & 31, ob = rr * 64 + cc * 2; return st * 1024 + (ob ^ (((ob >> 9) & 1) << 5)); }
__host__ __device__ __forceinline__ void stage_rc(int b, int& R, int& C) { const int st = b / 1024, sb = b % 1024, swz = sb ^ (((sb >> 9) & 1) << 5); R = (st >> 1) * 16 + swz / 64; C = (st & 1) * 32 + (swz % 64) / 2; }
__host__ __device__ __forceinline__ int perm32(int rho) { const int n = rho >> 4, i = rho & 15; return 8 * (i >> 2) + 4 * n + (i & 3); }

struct Unit { int pm, pn, idx; };
struct Gemm { const bf16_t* A; const bf16_t* Bt; int M, N, K, lda; };

struct StaticOrder {
    int nM, nN, nwg, G, c, off, cnt;
    __host__ __device__ void init(int M, int N, int G_, int c_) { nM = M / BM; nN = N / BM; nwg = nM * nN; G = G_; c = c_; off = 0; cnt = 1 << 20; }
    __host__ __device__ bool next(int i, Unit& u) const {
        if (i >= cnt) return false; i += off;
        const long L = (long)i * G + c; if (L >= nwg) return false;
        int wgid = (int)L; { const int q = nwg / NXCD, r = nwg % NXCD, xcd = wgid % NXCD, off = wgid / NXCD; wgid = (xcd < r ? xcd * (q + 1) : r * (q + 1) + (xcd - r) * q) + off; }
        const int nig = WGM * nN, gid = wgid / nig, fm = gid * WGM, gsz = (nM - fm) < WGM ? (nM - fm) : WGM;
        u.pm = fm + ((wgid % nig) % gsz); u.pn = (wgid % nig) / gsz; u.idx = i; return true;
    }
    __device__ __forceinline__ void a_ready(const Unit&) const {}
    __device__ __forceinline__ void done(const Unit&) const {}
};
__device__ __forceinline__ unsigned cvt_pk_bf16(float lo, float hi) { unsigned r; asm volatile("v_cvt_pk_bf16_f32 %0, %1, %2" : "=v"(r) : "v"(lo), "v"(hi)); return r; }
typedef float f32x2 __attribute__((ext_vector_type(2)));
template <class Epi, class Sched, bool ALIGN_EPI = false, bool SP2 = false>
__device__ __forceinline__ void gemm_phase(PG8_LAS unsigned char* lds, const Gemm g, const Sched& S, const Epi& E, const int tid) {
    const int wid = __builtin_amdgcn_readfirstlane(tid >> 6), lane = tid & 63, wr = wid >> 2, wc = wid & 3, fr = lane & 15, fq = lane >> 4;
    const int K = g.K, nt = K / BK;
    unsigned voffA[2], voffB[2];
#pragma unroll
    for (int i = 0; i < 2; ++i) { int R, C; stage_rc(tid * 16 + i * 8192, R, C); const int Rb = Epi::PERM ? ((R & ~31) + perm32(R & 31)) : R;
        voffA[i] = (unsigned)(R * g.lda + C) * 2u; voffB[i] = (unsigned)(Rb * K + C) * 2u; }
    const size_t kstep = (size_t)(BK * 2);
    const size_t hstep = (size_t)HALF * K * 2, hstepA = (size_t)HALF * g.lda * 2;
    const size_t tstep = 2 * hstep, tstepA = 2 * hstepA;
    const unsigned ldsw = (unsigned)wid * 1024u;
    const int aoff = lds_byte(wr * 64 + fr, fq * 8), boff = lds_byte(wc * 32 + fr, fq * 8);
#define PG8_SA(b, h) (((b) * 2 + (h)) * HTB)
#define PG8_SB(b, h) ((4 + (b) * 2 + (h)) * HTB)
#define PG8_STAGE(bufoff, gbase, voff) do { _Pragma("unroll") for (int _i = 0; _i < 2; ++_i) \
        __builtin_amdgcn_global_load_lds((const unsigned*)((const char*)(gbase) + (voff)[_i]), (PG8_LAS unsigned*)(lds + (bufoff) + ldsw + _i * 8192), 16, 0, 0); } while (0)
#define PG8_LDA(dst, b, h) do { _Pragma("unroll") for (int m = 0; m < 4; ++m) _Pragma("unroll") for (int k = 0; k < 2; ++k) dst[m][k] = *(const PG8_LAS bf16x8*)(lds + PG8_SA(b, h) + aoff + m * 2048 + k * 1024); } while (0)
#define PG8_LDB(dst, b, h) do { _Pragma("unroll") for (int n = 0; n < 2; ++n) _Pragma("unroll") for (int k = 0; k < 2; ++k) dst[n][k] = *(const PG8_LAS bf16x8*)(lds + PG8_SB(b, h) + boff + n * 2048 + k * 1024); } while (0)
#define PG8_MMA(ai, bj, At, Bt) do { __builtin_amdgcn_s_setprio(1); _Pragma("unroll") for (int m = 0; m < 4; ++m) _Pragma("unroll") for (int n = 0; n < 2; ++n) _Pragma("unroll") for (int k = 0; k < 2; ++k) \
        acc[ai][bj][m][n] = __builtin_amdgcn_mfma_f32_16x16x32_bf16(Bt[n][k], At[m][k], acc[ai][bj][m][n], 0, 0, 0); __builtin_amdgcn_s_setprio(0); } while (0)
#define PG8_WAIT_V(n) asm volatile("s_waitcnt vmcnt(" #n ")" ::: "memory")
#define PG8_WAIT_L(n) asm volatile("s_waitcnt lgkmcnt(" #n ")" ::: "memory")
#define PG8_BAR __builtin_amdgcn_s_barrier()
#define PG8_SCHED __builtin_amdgcn_sched_barrier(0)
    Unit cur, nxt; int ui = 0;
    if (!S.next(0, cur)) return;
    f32x4 acc[2][2][4][2];
#pragma unroll
    for (int a = 0; a < 2; ++a)
#pragma unroll
        for (int b = 0; b < 2; ++b)
#pragma unroll
            for (int m = 0; m < 4; ++m)
#pragma unroll
                for (int n = 0; n < 2; ++n) acc[a][b][m][n] = (f32x4){0.f, 0.f, 0.f, 0.f};
    if constexpr (Epi::HAS_INIT) E.init(acc, cur, wr, wc, fr, fq);
    bf16x8 At[4][2], B0[2][2], B1[2][2];
    const char* cA = (const char*)g.A + (size_t)cur.pm * tstepA; const char* cB = (const char*)g.Bt + (size_t)cur.pn * tstep;
    S.a_ready(cur);
    if constexpr (SP2) {
        PG8_STAGE(PG8_SB(0, 0), cB, voffB); PG8_STAGE(PG8_SB(0, 1), cB + hstep, voffB); PG8_STAGE(PG8_SA(0, 0), cA, voffA); PG8_STAGE(PG8_SA(0, 1), cA + hstepA, voffA);
        if (wr == 1) PG8_BAR;
        PG8_WAIT_V(2); PG8_BAR;
        PG8_STAGE(PG8_SB(1, 0), cB + kstep, voffB); PG8_STAGE(PG8_SA(1, 0), cA + kstep, voffA); PG8_STAGE(PG8_SB(1, 1), cB + hstep + kstep, voffB);
        PG8_WAIT_V(6); PG8_BAR;
    } else {
        PG8_STAGE(PG8_SB(0, 0), cB, voffB); PG8_STAGE(PG8_SA(0, 0), cA, voffA); PG8_STAGE(PG8_SB(0, 1), cB + hstep, voffB); PG8_STAGE(PG8_SA(0, 1), cA + hstepA, voffA);
        if (wr == 1) PG8_BAR;
        PG8_WAIT_V(4); PG8_BAR;
        PG8_STAGE(PG8_SB(1, 0), cB + kstep, voffB); PG8_STAGE(PG8_SA(1, 0), cA + kstep, voffA); PG8_STAGE(PG8_SB(1, 1), cB + hstep + kstep, voffB);
        PG8_WAIT_V(6); PG8_BAR;
    }
    for (;;) {
        const bool has_next = S.next(ui + 1, nxt);
        const char* nA = has_next ? (const char*)g.A + (size_t)nxt.pm * tstepA : cA; const char* nB = has_next ? (const char*)g.Bt + (size_t)nxt.pn * tstep : cB;
        for (int t = 0; t < nt; t += 2) {
            const bool last = (t == nt - 2);
            const char* a1 = cA + (size_t)(t + 1) * kstep;
            const char* a2 = last ? nA : cA + (size_t)(t + 2) * kstep; const char* b2 = last ? nB : cB + (size_t)(t + 2) * kstep;
            const char* a3 = a2 + kstep; const char* b3 = b2 + kstep;
            if (last && has_next) S.a_ready(nxt);
            if constexpr (SP2) {
            PG8_LDB(B0, 0, 0); PG8_LDB(B1, 0, 1); PG8_SCHED; PG8_LDA(At, 0, 0); PG8_STAGE(PG8_SA(1, 1), a1 + hstepA, voffA);
            PG8_WAIT_V(8); PG8_WAIT_L(0); PG8_BAR; PG8_MMA(0, 0, At, B0); PG8_MMA(0, 1, At, B1); PG8_BAR; PG8_SCHED;
            PG8_LDA(At, 0, 1); PG8_STAGE(PG8_SB(0, 0), b2, voffB); PG8_STAGE(PG8_SB(0, 1), b2 + hstep, voffB); PG8_STAGE(PG8_SA(0, 0), a2, voffA);
            PG8_WAIT_V(8); PG8_WAIT_L(0); PG8_BAR; PG8_MMA(1, 0, At, B0); PG8_MMA(1, 1, At, B1); PG8_BAR; PG8_SCHED;
            PG8_LDB(B0, 1, 0); PG8_LDB(B1, 1, 1); PG8_SCHED; PG8_LDA(At, 1, 0); PG8_STAGE(PG8_SA(0, 1), a2 + hstepA, voffA);
            PG8_WAIT_V(8); PG8_WAIT_L(0); PG8_BAR; PG8_MMA(0, 0, At, B0); PG8_MMA(0, 1, At, B1); PG8_BAR; PG8_SCHED;
            PG8_LDA(At, 1, 1); PG8_STAGE(PG8_SB(1, 0), b3, voffB); PG8_STAGE(PG8_SB(1, 1), b3 + hstep, voffB); PG8_STAGE(PG8_SA(1, 0), a3, voffA);
            PG8_WAIT_V(8); PG8_WAIT_L(0); PG8_BAR; PG8_MMA(1, 0, At, B0); PG8_MMA(1, 1, At, B1); PG8_BAR; PG8_SCHED;
            } else {
            PG8_LDB(B0, 0, 0); PG8_SCHED; PG8_LDA(At, 0, 0); PG8_STAGE(PG8_SA(1, 1), a1 + hstepA, voffA);
            PG8_WAIT_L(8); PG8_BAR; PG8_WAIT_L(0); PG8_MMA(0, 0, At, B0); PG8_BAR; PG8_SCHED;
            PG8_LDB(B1, 0, 1); PG8_STAGE(PG8_SB(0, 0), b2, voffB);
            PG8_BAR; PG8_WAIT_L(0); PG8_MMA(0, 1, At, B1); PG8_BAR;
            PG8_LDA(At, 0, 1); PG8_STAGE(PG8_SA(0, 0), a2, voffA);
            PG8_BAR; PG8_WAIT_L(0); PG8_MMA(1, 0, At, B0); PG8_BAR; PG8_SCHED;
            PG8_STAGE(PG8_SB(0, 1), b2 + hstep, voffB);
            PG8_WAIT_V(6); PG8_BAR; PG8_MMA(1, 1, At, B1); PG8_BAR;
            PG8_LDB(B0, 1, 0); PG8_SCHED; PG8_LDA(At, 1, 0); PG8_STAGE(PG8_SA(0, 1), a2 + hstepA, voffA);
            PG8_WAIT_L(8); PG8_BAR; PG8_WAIT_L(0); PG8_MMA(0, 0, At, B0); PG8_BAR; PG8_SCHED;
            PG8_LDB(B1, 1, 1); PG8_STAGE(PG8_SB(1, 0), b3, voffB);
            PG8_BAR; PG8_WAIT_L(0); PG8_MMA(0, 1, At, B1); PG8_BAR;
            PG8_LDA(At, 1, 1); PG8_STAGE(PG8_SA(1, 0), a3, voffA);
            PG8_BAR; PG8_WAIT_L(0); PG8_MMA(1, 0, At, B0); PG8_BAR; PG8_SCHED;
            PG8_STAGE(PG8_SB(1, 1), b3 + hstep, voffB);
            PG8_WAIT_V(6); PG8_BAR; PG8_MMA(1, 1, At, B1); PG8_BAR;
            }
        }
        if constexpr (ALIGN_EPI) { if (wr == 0) PG8_BAR; }
        if constexpr (!Epi::AFTER_DRAIN) { E(acc, cur, wr, wc, fr, fq); S.done(cur); }
        if (!has_next) break;
#pragma unroll
        for (int a = 0; a < 2; ++a)
#pragma unroll
            for (int b = 0; b < 2; ++b)
#pragma unroll
                for (int m = 0; m < 4; ++m)
#pragma unroll
                    for (int n = 0; n < 2; ++n) acc[a][b][m][n] = (f32x4){0.f, 0.f, 0.f, 0.f};
        if constexpr (Epi::HAS_INIT) E.init(acc, nxt, wr, wc, fr, fq);
        cur = nxt; cA = nA; cB = nB; ++ui;
        if constexpr (ALIGN_EPI) { if (wr == 1) PG8_BAR; }
    }
    PG8_WAIT_V(0);
    if constexpr (!ALIGN_EPI) { if (wr == 0) PG8_BAR; }
    PG8_BAR;
    if constexpr (Epi::AFTER_DRAIN) { E.fused(acc, cur, wr, wc, fr, fq, lds, wid, lane); S.done(cur); }
#undef PG8_SA
#undef PG8_SB
#undef PG8_STAGE
#undef PG8_LDA
#undef PG8_LDB
#undef PG8_MMA
#undef PG8_WAIT_V
#undef PG8_WAIT_L
#undef PG8_BAR
#undef PG8_SCHED
}
}

namespace pg8 {
__device__ __forceinline__ float fq_sum(float v) { v += __shfl_xor(v, 16); v += __shfl_xor(v, 32); return v; }
__device__ __forceinline__ u32x4 pack8(const f32x4& a, const f32x4& b) { u32x4 w; w.x = cvt_pk_bf16(a[0], a[1]); w.y = cvt_pk_bf16(a[2], a[3]); w.z = cvt_pk_bf16(b[0], b[1]); w.w = cvt_pk_bf16(b[2], b[3]); return w; }
__device__ __forceinline__ f32x4 silu4(const f32x4& g, const f32x4& u) { f32x4 o;
#pragma unroll
    for (int j = 0; j < 4; ++j) o[j] = g[j] * __builtin_amdgcn_rcpf(1.0f + __builtin_amdgcn_exp2f(-LOG2E * g[j])) * u[j];
    return o; }

template <int NP> __device__ __forceinline__ void rs_rows(const float* ssq, int row0, int fq, float inv_n, float (&rs)[2][4]) {
    f32x4 t[2][4];
#pragma unroll
    for (int ai = 0; ai < 2; ++ai)
#pragma unroll
        for (int m = 0; m < 4; ++m) t[ai][m] = *(const f32x4*)(ssq + (size_t)(row0 + ai * HALF + m * 16) * NP + (NP == 16 ? 4 * fq : 0));
#pragma unroll
    for (int ai = 0; ai < 2; ++ai)
#pragma unroll
        for (int m = 0; m < 4; ++m) { float v = (t[ai][m][0] + t[ai][m][1]) + (t[ai][m][2] + t[ai][m][3]); if (NP == 16) v = fq_sum(v); rs[ai][m] = __builtin_amdgcn_rsqf(v * inv_n + EPS); }
}
struct EpiSwiglu {
    static constexpr bool PERM = true, AFTER_DRAIN = false, HAS_INIT = false;
    bf16_t* HB; const PG8_LAS float* rs_lds;
    __device__ __forceinline__ void operator()(const f32x4 (&acc)[2][2][4][2], const Unit& u, int wr, int wc, int fr, int fq) const {
        const int col0 = u.pn * 128 + wc * 32 + 8 * fq, row0 = u.pm * BM + wr * 64 + fr;
        float rs[2][4];
#pragma unroll
        for (int ai = 0; ai < 2; ++ai)
#pragma unroll
            for (int m = 0; m < 4; ++m) rs[ai][m] = rs_lds ? rs_lds[u.idx * BM + ai * HALF + wr * 64 + m * 16 + fr] : 1.f;
#pragma unroll
        for (int ai = 0; ai < 2; ++ai)
#pragma unroll
            for (int m = 0; m < 4; ++m) { const int row = row0 + ai * HALF + m * 16; const float r = rs[ai][m];
                const f32x4 h0 = silu4(acc[ai][0][m][0] * r, acc[ai][1][m][0] * r), h1 = silu4(acc[ai][0][m][1] * r, acc[ai][1][m][1] * r);
                *(u32x4*)(HB + (size_t)row * FF + col0) = pack8(h0, h1); }
    }
};
template <class Sched> __device__ __forceinline__ void rs_table_fill(const float* ssq, const Sched& S, PG8_LAS float* table, int tid) {
    Unit u; int n = 0; while (S.next(n, u)) ++n;
    for (int e = tid; e < n * BM; e += 512) { S.next(e >> 8, u); table[e] = 1.0f / sqrtf(sum16f(ssq + (size_t)(u.pm * BM + (e & 255)) * 16) * (1.f / D) + EPS); }
    __syncthreads();
}
template <int HALF_SCALE, int BASE_BF16> struct EpiResid {
    static constexpr bool PERM = true, AFTER_DRAIN = false, HAS_INIT = true;
    const void* base; float* out; bf16_t* XN; float* SSQ;
    __device__ __forceinline__ void init(f32x4 (&acc)[2][2][4][2], const Unit& u, int wr, int wc, int fr, int fq) const {
        const int col0 = u.pn * BM + wc * 32 + 8 * fq; const float inv = HALF_SCALE ? 2.0f : 1.0f;
#pragma unroll
        for (int ai = 0; ai < 2; ++ai)
#pragma unroll
            for (int m = 0; m < 4; ++m) { const int row = u.pm * BM + ai * HALF + wr * 64 + m * 16 + fr;
#pragma unroll
                for (int bj = 0; bj < 2; ++bj) { const size_t o = (size_t)row * D + col0 + bj * HALF;
                    if (BASE_BF16) { const u32x4 w = *(const u32x4*)((const bf16_t*)base + o);
                        acc[ai][bj][m][0] = (f32x4){__uint_as_float(w.x << 16), __uint_as_float(w.x & 0xffff0000u), __uint_as_float(w.y << 16), __uint_as_float(w.y & 0xffff0000u)} * inv;
                        acc[ai][bj][m][1] = (f32x4){__uint_as_float(w.z << 16), __uint_as_float(w.z & 0xffff0000u), __uint_as_float(w.w << 16), __uint_as_float(w.w & 0xffff0000u)} * inv; }
                    else { acc[ai][bj][m][0] = *(const f32x4*)((const float*)base + o) * inv; acc[ai][bj][m][1] = *(const f32x4*)((const float*)base + o + 4) * inv; } } }
    }
    __device__ __forceinline__ void operator()(const f32x4 (&acc)[2][2][4][2], const Unit& u, int wr, int wc, int fr, int fq) const {
        const int col0 = u.pn * BM + wc * 32 + 8 * fq; const float scale = HALF_SCALE ? 0.5f : 1.0f;
#pragma unroll
        for (int ai = 0; ai < 2; ++ai)
#pragma unroll
            for (int m = 0; m < 4; ++m) { const int row = u.pm * BM + ai * HALF + wr * 64 + m * 16 + fr; float sq = 0.f;
#pragma unroll
                for (int bj = 0; bj < 2; ++bj) { const size_t o = (size_t)row * D + col0 + bj * HALF;
                    const f32x4 v0 = acc[ai][bj][m][0] * scale, v1 = acc[ai][bj][m][1] * scale;
                    if (out) { *(f32x4*)(out + o) = v0; *(f32x4*)(out + o + 4) = v1; }
                    if (XN) *(u32x4*)(XN + o) = pack8(v0, v1);
                    sq += (v0[0] * v0[0] + v0[1] * v0[1]) + (v0[2] * v0[2] + v0[3] * v0[3]) + (v1[0] * v1[0] + v1[1] * v1[1]) + (v1[2] * v1[2] + v1[3] * v1[3]); }
                if (SSQ) { sq = fq_sum(sq); if (fq == 0) SSQ[(size_t)row * 16 + u.pn * 4 + wc] = sq; } }
    }
};
struct EpiWin {
    static constexpr bool PERM = true, AFTER_DRAIN = false, HAS_INIT = false;
    Ctx C; const PG8_LAS float* rs_lds; const PG8_LAS float* gt;
    __device__ __forceinline__ void operator()(const f32x4 (&acc)[2][2][4][2], const Unit& u, int wr, int wc, int fr, int fq) const {
        const RowSet& R = C.main; const int pn = u.pn;
        f32x4 bfg[2]; if (pn == 1) { bfg[0] = *(const f32x4*)(C.b_forget); bfg[1] = *(const f32x4*)(C.b_forget + 4); }
        float rsr[2][4];
#pragma unroll
        for (int ai = 0; ai < 2; ++ai)
#pragma unroll
            for (int m = 0; m < 4; ++m) rsr[ai][m] = rs_lds[u.idx * BM + ai * HALF + wr * 64 + m * 16 + fr];
#pragma unroll
        for (int ai = 0; ai < 2; ++ai)
#pragma unroll
            for (int m = 0; m < 4; ++m) { const int row = u.pm * BM + ai * HALF + wr * 64 + m * 16 + fr; const float rs = rsr[ai][m];
                f32x4 v[2][2];
#pragma unroll
                for (int bj = 0; bj < 2; ++bj)
#pragma unroll
                    for (int n = 0; n < 2; ++n) v[bj][n] = acc[ai][bj][m][n] * rs;
                float sq[2];
#pragma unroll
                for (int bj = 0; bj < 2; ++bj) sq[bj] = (v[bj][0][0] * v[bj][0][0] + v[bj][0][1] * v[bj][0][1]) + (v[bj][0][2] * v[bj][0][2] + v[bj][0][3] * v[bj][0][3]) +
                                                        (v[bj][1][0] * v[bj][1][0] + v[bj][1][1] * v[bj][1][1]) + (v[bj][1][2] * v[bj][1][2] + v[bj][1][3] * v[bj][1][3]);
                if (pn == 0) {
#pragma unroll
                    for (int bj = 0; bj < 2; ++bj) *(u32x4*)(R.CQ + (size_t)row * 256 + bj * HALF + wc * 32 + 8 * fq) = pack8(v[bj][0], v[bj][1]);
                    const float s = fq_sum(sq[0] + sq[1]); if (fq == 0) R.SSQCQ[(size_t)row * 4 + wc] = s;
                } else if (pn == 1) {
                    *(u32x4*)(R.CKV + (size_t)row * 128 + wc * 32 + 8 * fq) = pack8(v[0][0], v[0][1]);
                    const float s = fq_sum(sq[0]); if (fq == 0) R.SSQCKV[(size_t)row * 4 + wc] = s;
                    if (wc == 0) { *(f32x4*)(R.KPE + (size_t)row * 32 + 4 * fq) = v[1][0]; *(f32x4*)(R.KPE + (size_t)row * 32 + 16 + 4 * fq) = v[1][1];
                        const float sp = fq_sum(sq[1]); if (fq == 0) R.SSQKPE[row] = sp; }
                    if (wc == 1 && fq == 0) { f32x4 l0, l1;
#pragma unroll
                        for (int j = 0; j < 4; ++j) { l0[j] = log_sigmoid(v[1][0][j] + bfg[0][j]); l1[j] = log_sigmoid(v[1][1][j] + bfg[1][j]); }
                        *(f32x4*)(R.LOGF + (size_t)row * 8) = l0; *(f32x4*)(R.LOGF + (size_t)row * 8 + 4) = l1; }
                } else {
                    const int which = (pn - 2) >> 1, h = ((pn - 2) & 1) * 4 + wc; const int b = row >> 13, p = 64 + (row & (T - 1));
                    if (which < 2) { const float r = __builtin_amdgcn_rsqf(fq_sum(sq[0] + sq[1]) * (1.f / 64.f) + EPS) * (which == 0 ? C2F : 1.f); const PG8_LAS float* g = gt + (which == 0 ? 0 : 64);
#pragma unroll
                        for (int bj = 0; bj < 2; ++bj) { v[bj][0] = v[bj][0] * *(const PG8_LAS f32x4*)(g + 32 * bj + 8 * fq) * r; v[bj][1] = v[bj][1] * *(const PG8_LAS f32x4*)(g + 32 * bj + 8 * fq + 4) * r; } }
#pragma unroll
                    for (int bj = 0; bj < 2; ++bj) { bf16_t* dst = (which == 0) ? C.FQ + arow(b, h, p) * 64 + 32 * bj + 8 * fq : (which == 1) ? C.FK + kaddr(b, h, p, 32 * bj + 8 * fq, DFK) : C.FV + vaddr(b, h, p, 32 * bj + 8 * fq);
                        *(u32x4*)dst = pack8(v[bj][0], v[bj][1]); }
                }
                if (m & 1) asm volatile("" ::: "memory"); }
    }
};
struct EpiUq {
    static constexpr bool PERM = true, AFTER_DRAIN = false, HAS_INIT = false;
    const PG8_LAS float* g_q_mla; const float* SSQCQ; float* SSQQ; bf16_t* QM; const float* ROPE;
    __device__ __forceinline__ void operator()(const f32x4 (&acc)[2][2][4][2], const Unit& u, int wr, int wc, int fr, int fq) const {
        const int pn = u.pn;
        float rsr[2][4]; rs_rows<4>(SSQCQ, u.pm * BM + wr * 64 + fr, fq, 1.f / 256.f, rsr);
#pragma unroll
        for (int ai = 0; ai < 2; ++ai)
#pragma unroll
            for (int m = 0; m < 4; ++m) { const int row = u.pm * BM + ai * HALF + wr * 64 + m * 16 + fr; const float rs = rsr[ai][m];
                const int b = row >> 13, p = 64 + (row & (T - 1));
                if (pn < 2) { const int h = pn * 4 + wc; bf16_t* dst = QM + arow(b, h, p) * DQM; float sq = 0.f;
#pragma unroll
                    for (int bj = 0; bj < 2; ++bj) { const f32x4 v0 = acc[ai][bj][m][0] * rs, v1 = acc[ai][bj][m][1] * rs;
                        sq += (v0[0] * v0[0] + v0[1] * v0[1]) + (v0[2] * v0[2] + v0[3] * v0[3]) + (v1[0] * v1[0] + v1[1] * v1[1]) + (v1[2] * v1[2] + v1[3] * v1[3]);
                        const f32x4 g0 = *(const PG8_LAS f32x4*)(g_q_mla + 32 * bj + 8 * fq), g1 = *(const PG8_LAS f32x4*)(g_q_mla + 32 * bj + 8 * fq + 4);
                        *(u32x4*)(dst + 32 * bj + 8 * fq) = pack8(v0 * g0, v1 * g1); }
                    sq = fq_sum(sq); if (fq == 0) SSQQ[(size_t)row * 16 + 2 * h] = sq;
                } else { const float* rp = ROPE + ((size_t)(p - 48) * 16 + 4 * fq) * 2; const f32x4 t0 = *(const f32x4*)rp, t1 = *(const f32x4*)(rp + 4);
                    const f32x4 cs = {t0[0], t0[2], t1[0], t1[2]}, sn = {t0[1], t0[3], t1[1], t1[3]};
                    const f32x4 g0 = *(const PG8_LAS f32x4*)(g_q_mla + 64 + 4 * fq), g1 = *(const PG8_LAS f32x4*)(g_q_mla + 80 + 4 * fq);
#pragma unroll
                    for (int bj = 0; bj < 2; ++bj) { const int h = 2 * wc + bj; const f32x4 v0 = acc[ai][bj][m][0] * rs, v1 = acc[ai][bj][m][1] * rs;
                        float sq = (v0[0] * v0[0] + v0[1] * v0[1]) + (v0[2] * v0[2] + v0[3] * v0[3]) + (v1[0] * v1[0] + v1[1] * v1[1]) + (v1[2] * v1[2] + v1[3] * v1[3]);
                        sq = fq_sum(sq); if (fq == 0) SSQQ[(size_t)row * 16 + 2 * h + 1] = sq;
                        const f32x4 y1 = v0 * g0, y2 = v1 * g1; const f32x4 o1 = y1 * cs - y2 * sn, o2 = y2 * cs + y1 * sn;
                        bf16_t* dst = QM + arow(b, h, p) * DQM; u32x2 w1, w2; w1.x = cvt_pk_bf16(o1[0], o1[1]); w1.y = cvt_pk_bf16(o1[2], o1[3]); w2.x = cvt_pk_bf16(o2[0], o2[1]); w2.y = cvt_pk_bf16(o2[2], o2[3]);
                        *(u32x2*)(dst + 64 + 4 * fq) = w1; *(u32x2*)(dst + 80 + 4 * fq) = w2; } }
                if (m & 1) asm volatile("" ::: "memory"); }
    }
};
struct EpiUkv {
    static constexpr bool PERM = true, AFTER_DRAIN = false, HAS_INIT = false;
    const PG8_LAS float* g_k_mla; const float* SSQCKV; const float* SSQKPE; const float* KPE; bf16_t* KM; bf16_t* VM; const float* ROPE;
    __device__ __forceinline__ void operator()(const f32x4 (&acc)[2][2][4][2], const Unit& u, int wr, int wc, int fr, int fq) const {
        const int pn = u.pn, h = (pn & 1) * 4 + wc;
        float rsr[2][4]; rs_rows<4>(SSQCKV, u.pm * BM + wr * 64 + fr, fq, 1.f / 128.f, rsr);
#pragma unroll
        for (int ai = 0; ai < 2; ++ai)
#pragma unroll
            for (int m = 0; m < 4; ++m) { const int row = u.pm * BM + ai * HALF + wr * 64 + m * 16 + fr; const float rs = rsr[ai][m];
                const int b = row >> 13, p = 64 + (row & (T - 1));
                if (pn < 2) { float sq = 0.f;
#pragma unroll
                    for (int bj = 0; bj < 2; ++bj)
#pragma unroll
                        for (int n = 0; n < 2; ++n) { const f32x4 v = acc[ai][bj][m][n] * rs; sq += (v[0] * v[0] + v[1] * v[1]) + (v[2] * v[2] + v[3] * v[3]); }
                    const float rk = __builtin_amdgcn_rsqf((fq_sum(sq) + SSQKPE[row]) * (1.f / 96.f) + EPS); const float rr = rs * rk;
#pragma unroll
                    for (int bj = 0; bj < 2; ++bj) { const f32x4 g0 = *(const PG8_LAS f32x4*)(g_k_mla + 32 * bj + 8 * fq), g1 = *(const PG8_LAS f32x4*)(g_k_mla + 32 * bj + 8 * fq + 4);
                        *(u32x4*)(KM + kaddr(b, h, p, 32 * bj + 8 * fq, DQM)) = pack8(acc[ai][bj][m][0] * g0 * rr, acc[ai][bj][m][1] * g1 * rr); }
                    const float* rp = ROPE + ((size_t)(p - 48) * 16 + 4 * fq) * 2; const f32x4 t0 = *(const f32x4*)rp, t1 = *(const f32x4*)(rp + 4);
                    const f32x4 cs = {t0[0], t0[2], t1[0], t1[2]}, sn = {t0[1], t0[3], t1[1], t1[3]};
                    const f32x4 y1 = *(const f32x4*)(KPE + (size_t)row * 32 + 4 * fq) * *(const PG8_LAS f32x4*)(g_k_mla + 64 + 4 * fq) * rk, y2 = *(const f32x4*)(KPE + (size_t)row * 32 + 16 + 4 * fq) * *(const PG8_LAS f32x4*)(g_k_mla + 80 + 4 * fq) * rk;
                    const f32x4 o1 = y1 * cs - y2 * sn, o2 = y2 * cs + y1 * sn; u32x2 w1, w2; w1.x = cvt_pk_bf16(o1[0], o1[1]); w1.y = cvt_pk_bf16(o1[2], o1[3]); w2.x = cvt_pk_bf16(o2[0], o2[1]); w2.y = cvt_pk_bf16(o2[2], o2[3]);
                    *(u32x2*)(KM + kaddr(b, h, p, 64 + 4 * fq, DQM)) = w1; *(u32x2*)(KM + kaddr(b, h, p, 80 + 4 * fq, DQM)) = w2;
                } else {
#pragma unroll
                    for (int bj = 0; bj < 2; ++bj) *(u32x4*)(VM + vaddr(b, h, p, 32 * bj + 8 * fq)) = pack8(acc[ai][bj][m][0] * rs, acc[ai][bj][m][1] * rs); }
                if (m & 1) asm volatile("" ::: "memory"); }
    }
};
}


namespace att {
typedef short s16x4 __attribute__((ext_vector_type(4)));
typedef float f32x16 __attribute__((ext_vector_type(16)));
constexpr int NW = 8, QBLK = 32, QB = QBLK * NW, KVBLK = 64;
constexpr int KSLOT = 12288, NKSLOT = 4, VSLOT = 8192, NVSLOT = 3;
constexpr int LDS_K = 0, LDS_V = NKSLOT * KSLOT, LDS_WS = LDS_V + NVSLOT * VSLOT, LDS_OST = LDS_WS + NW * 256, LDS_BYTES = LDS_OST + NW * 4096;
__device__ __forceinline__ int crow(int r, int hi) { return (r & 3) + 8 * (r >> 2) + 4 * hi; }
#define SBAR() __builtin_amdgcn_sched_barrier(0)
__device__ __forceinline__ void cmask(f32x16& p0, f32x16& p1, int jb, int qrel, int hi) {
    const float NEG = -INFINITY; const int kb = 64 * jb + 4 * hi;
#pragma unroll
    for (int r = 0; r < 16; ++r) { const int kv = kb + (r & 3) + 8 * (r >> 2); if (kv > qrel) p0[r] = NEG; if (kv + 32 > qrel) p1[r] = NEG; }
}
__device__ __forceinline__ void glds16(const void* gsrc, unsigned lds_dst) { unsigned keep;
    asm volatile("s_mov_b32 %0, m0\n\ts_mov_b32 m0, %2\n\ts_nop 0\n\tglobal_load_lds_dwordx4 %1, off\n\ts_mov_b32 m0, %0" : "=&s"(keep) : "v"(gsrc), "s"(lds_dst) : "memory"); }
typedef float f32x2_t __attribute__((ext_vector_type(2))); typedef __bf16 bf16x2_t __attribute__((ext_vector_type(2)));
__device__ __forceinline__ unsigned cvtpk_s(float lo, float hi) { f32x2_t v = {lo, hi}; bf16x2_t b = __builtin_convertvector(v, bf16x2_t); return __builtin_bit_cast(unsigned, b); }
#define WAIT_BAR(N) asm volatile("s_waitcnt vmcnt(" #N ") lgkmcnt(0)\n\ts_barrier" ::: "memory")
typedef __attribute__((address_space(3))) const char* lds_cptr;
typedef short v4i16_t __attribute__((ext_vector_type(4)));
#define LDSV8(p) (*(const __attribute__((address_space(3))) bf16x8*)(p))
__device__ __forceinline__ void kload2(bf16x8* kf, lds_cptr kp, int j) { kf[2 * j] = LDSV8(kp + j * 2048); kf[2 * j + 1] = LDSV8(kp + j * 2048 + 512); }
__device__ __forceinline__ s16x4 vtr(lds_cptr p) { return __builtin_bit_cast(s16x4, __builtin_amdgcn_ds_read_tr16_b64_v4i16((__attribute__((address_space(3))) v4i16_t*)p)); }
#define MX3(a, b, c) __builtin_fmaxf(__builtin_fmaxf((a), (b)), (c))
__device__ __forceinline__ float rowmax(const f32x16& p0, const f32x16& p1) {
    float a = MX3(p0[0], p0[1], p1[0]), b = MX3(p0[2], p0[3], p1[1]); a = MX3(a, p1[2], p1[3]);
#pragma unroll
    for (int r = 4; r < 16; r += 4) { a = MX3(a, p0[r], p0[r + 1]); b = MX3(b, p0[r + 2], p0[r + 3]); a = MX3(a, p1[r], p1[r + 1]); b = MX3(b, p1[r + 2], p1[r + 3]); }
    float m = __builtin_fmaxf(a, b); auto rr = __builtin_amdgcn_permlane32_swap(__float_as_uint(m), __float_as_uint(m), false, false);
    return __builtin_fmaxf(__uint_as_float(rr[0]), __uint_as_float(rr[1])); }
__device__ __forceinline__ void pv(f32x16* o, int vb, bf16x8 pa0, bf16x8 pa1, bf16x8 pa2, bf16x8 pa3) {
#pragma unroll
    for (int d0 = 0; d0 < 2; ++d0) { s16x4 lo[4], hi[4];
#pragma unroll
        for (int ks = 0; ks < 4; ++ks) {
            asm volatile("ds_read_b64_tr_b16 %0,%1 offset:%c2" : "=&v"(lo[ks]) : "v"(vb), "i"(d0 * 4096 + ks * 1024) : "memory");
            asm volatile("ds_read_b64_tr_b16 %0,%1 offset:%c2" : "=&v"(hi[ks]) : "v"(vb), "i"(d0 * 4096 + ks * 1024 + 512) : "memory"); }
        asm volatile("s_waitcnt lgkmcnt(0)" ::: "memory"); SBAR();
#define PK(k) (bf16x8){lo[k][0], lo[k][1], lo[k][2], lo[k][3], hi[k][0], hi[k][1], hi[k][2], hi[k][3]}
        o[d0] = __builtin_amdgcn_mfma_f32_32x32x16_bf16(pa0, PK(0), o[d0], 0, 0, 0);
        o[d0] = __builtin_amdgcn_mfma_f32_32x32x16_bf16(pa1, PK(1), o[d0], 0, 0, 0);
        o[d0] = __builtin_amdgcn_mfma_f32_32x32x16_bf16(pa2, PK(2), o[d0], 0, 0, 0);
        o[d0] = __builtin_amdgcn_mfma_f32_32x32x16_bf16(pa3, PK(3), o[d0], 0, 0, 0);
#undef PK
    }
}
#ifndef ATTN_STORE16
#define ATTN_STORE16(p, v) (*(u32x4*)(p) = (v))
#endif
#define MFMA32(a, b, c) __builtin_amdgcn_mfma_f32_32x32x16_bf16(a, b, c, 0, 0, 0)
template <int NKS, bool FOX, int THRL>
__device__ __forceinline__ void attn_unit(int b, int h, int qb, const bf16_t* Qb, const bf16_t* __restrict__ Kb, const bf16_t* __restrict__ Vb, const float* aux, bf16_t* O, int ocol, char* shm, float m0, int tb) {
    constexpr int DK = NKS * 16, NX = NKS * 2 - 8;
    int tid = threadIdx.x; asm volatile("" : "+v"(tid));
    const int lane = tid & 63, r32 = lane & 31, hi = lane >> 5; const int wid = __builtin_amdgcn_readfirstlane(tid >> 6);
    const size_t hb = (size_t)(b * 8 + h) * PR; const int q0 = qb * QB;
    if (wid >= 4) __builtin_amdgcn_s_setprio(1);
    const bf16_t* Kh = Kb + (hb + (size_t)(64 * tb)) * DK; const bf16_t* Vh = Vb + (hb + (size_t)(64 * tb)) * 64;
    const unsigned lds0 = (unsigned)(uintptr_t)shm;
    float* wsf = (float*)(shm + LDS_WS) + wid * 64;
    const bf16_t* ksrc1 = Kh + wid * 512 + lane * 8;
    const bf16_t* ksrc2 = Kh + 4096 + wid * NX * 64 + lane * 8;
    const bf16_t* vsrc = Vh + wid * 512 + lane * 8;
    const unsigned kdst1 = lds0 + LDS_K + wid * 1024, kdst2 = lds0 + LDS_K + 8192 + wid * NX * 128, vdst = lds0 + LDS_V + wid * 1024;
    const bool x2 = lane < NX * 8;
#define DMA_K(t, slot) do { glds16(ksrc1 + (size_t)(t) * KVBLK * DK, (unsigned)__builtin_amdgcn_readfirstlane(kdst1 + (slot))); if (x2) glds16(ksrc2 + (size_t)(t) * KVBLK * DK, (unsigned)__builtin_amdgcn_readfirstlane(kdst2 + (slot))); } while (0)
#define DMA_V(t, slot) glds16(vsrc + (size_t)(t) * KVBLK * 64, (unsigned)__builtin_amdgcn_readfirstlane(vdst + (slot)))
    const int vb0 = (int)(lds0 + LDS_V) + ((lane >> 4) & 1) * 32 + (lane & 3) * 8 + (4 * hi + ((lane & 15) >> 2)) * 64;
    bf16x8 kf[12];
    const lds_cptr shm3 = (lds_cptr)shm; const lds_cptr kp0 = shm3 + LDS_K + hi * 1024 + r32 * 16; const lds_cptr vp0 = shm3 + LDS_V + ((lane >> 4) & 1) * 32 + (lane & 3) * 8 + (4 * hi + ((lane & 15) >> 2)) * 64;
    const int NT = 4 * qb + 5 - tb;
    DMA_K(0, 0); DMA_V(0, 0); DMA_K(1, KSLOT);
    bf16x8 qr[NKS]; float cqv = 0.f;
    { const int prow = 64 + q0 + wid * QBLK + r32; const bf16_t* Qrow = Qb + (hb + prow) * (FOX ? 64 : 96);
      if (FOX) {
#pragma unroll
          for (int d0 = 0; d0 < 4; ++d0) qr[d0] = *(const bf16x8*)(Qrow + d0 * 16 + hi * 8);
          const short one = hi ? (short)0 : (short)0x3f80; qr[NKS - 1] = (bf16x8){one, one, one, 0, 0, 0, 0, 0};
          cqv = aux[hb + prow] * LOG2E;
      } else { const int row = b * T + q0 + wid * QBLK + r32; const float rq = C2M / sqrtf((aux[(size_t)row * 16 + 2 * h] + aux[(size_t)row * 16 + 2 * h + 1]) * (1.f / 96.f) + EPS);
#pragma unroll
          for (int d0 = 0; d0 < NKS; ++d0) { const bf16x8 raw = *(const bf16x8*)(Qrow + d0 * 16 + hi * 8); u32x4 w;
#pragma unroll
              for (int j = 0; j < 4; ++j) w[j] = cvtpk_s(bf2f((bf16_t)raw[2 * j]) * rq, bf2f((bf16_t)raw[2 * j + 1]) * rq);
              qr[d0] = __builtin_bit_cast(bf16x8, w); } } }
    float mhat = 0.f, l_reg = 0.f; f32x16 o[2]; o[0] = f32x16{}; o[1] = f32x16{}; f32x16 negm;
#pragma unroll
    for (int r = 0; r < 16; ++r) negm[r] = cqv;
    asm volatile("" : "+v"(negm));
    const int qrel = wid * QBLK + r32;
#define CMASK(P0, P1, t) do { int jb_ = (t) - (NT - 4); if (jb_ >= 0) cmask(P0, P1, jb_, qrel, hi); } while (0)
    bool resc = false; const bool bounded = m0 < 40.f;
#define RESC() do { if (resc) { asm volatile("s_waitcnt lgkmcnt(0)" ::: "memory"); \
        _Pragma("unroll") for (int d_ = 0; d_ < 2; ++d_) _Pragma("unroll") for (int r = 0; r < 16; ++r) o[d_][r] *= wsf[crow(r, hi)]; } } while (0)
    f32x16 pA0, pA1, pB0, pB1;
    int ks_prev = 3 * KSLOT, ks_cur = 0, ks_next = KSLOT, vs_prev = 2 * VSLOT, vs_cur = 0, vs_next = VSLOT;
#define ROT() do { ks_prev = ks_cur; ks_cur = ks_next; ks_next = (ks_next == (NKSLOT - 1) * KSLOT) ? 0 : ks_next + KSLOT; vs_prev = vs_cur; vs_cur = vs_next; vs_next = (vs_next == (NVSLOT - 1) * VSLOT) ? 0 : vs_next + VSLOT; } while (0)
    DMA_K(2, 2 * KSLOT);
    WAIT_BAR(2);
    { const lds_cptr kb = kp0;
#pragma unroll
      for (int d0 = 0; d0 < NKS; ++d0) { const bf16x8 b0 = LDSV8(kb + d0 * 2048), b1 = LDSV8(kb + d0 * 2048 + 512);
          if (d0 == 0) { pB0 = MFMA32(b0, qr[0], negm); pB1 = MFMA32(b1, qr[0], negm); } else { pB0 = MFMA32(b0, qr[d0], pB0); pB1 = MFMA32(b1, qr[d0], pB1); } }
      if (tb == 0) {
#pragma unroll
          for (int r = 0; r < 16; ++r) pB0[r] = -INFINITY;
#pragma unroll
          for (int r = 0; r < 8; ++r) pB1[r] = -INFINITY; }
      const float rm = bounded ? m0 : rowmax(pB0, pB1); mhat = rm;
#pragma unroll
      for (int r = 0; r < 16; ++r) { pB0[r] = __builtin_amdgcn_exp2f(pB0[r] - rm); pB1[r] = __builtin_amdgcn_exp2f(pB1[r] - rm); }
#pragma unroll
      for (int r = 0; r < 16; ++r) negm[r] = cqv - mhat;
      asm volatile("" : "+v"(negm)); }
    WAIT_BAR(0);
    DMA_K(3, ks_prev); DMA_V(1, vs_next);
    ROT();
    kload2(kf, kp0 + ks_cur, 0); kload2(kf, kp0 + ks_cur, 1);
    s16x4 vlo[8], vhi[8]; u32x4 pw0, pw1, pw2, pw3;
#define PKW(P, B) cvtpk_s(P[B], P[B + 1])
#define PAF(k) __builtin_bit_cast(bf16x8, pw##k)
#define VFR(i) (bf16x8){vlo[i][0], vlo[i][1], vlo[i][2], vlo[i][3], vhi[i][0], vhi[i][1], vhi[i][2], vhi[i][3]}
#define PIN(x) asm volatile("" : "+v"(x))
#define GAPA(MF, A0, A1, A2, A3, W0, W1, PW) do { MF; sacc += A0; sacc += A1; sacc += A2; sacc += A3; PIN(sacc); W0; W1; PIN(PW); SBAR(); } while (0)
#define EX(v) __builtin_amdgcn_exp2f(v)
#define GAPB(MF, X, B) do { MF; X[B] = EX(X[B]); X[B + 1] = EX(X[B + 1]); X[B + 2] = EX(X[B + 2]); X[B + 3] = EX(X[B + 3]); PIN(X); SBAR(); } while (0)
#define VRD(i) do { vlo[i] = vtr(vp_ + (((i) >> 2) * 4096 + ((i) & 3) * 1024)); vhi[i] = vtr(vp_ + (((i) >> 2) * 4096 + ((i) & 3) * 1024 + 512)); } while (0)
#define KRD(G, j) do { if (G) { kload2(kf, kp0 + ks_next, j); SBAR(); } } while (0)
#define KLD(f) do { kf[f] = LDSV8(kx_ + ((f) >> 1) * 2048 + ((f) & 1) * 512); } while (0)
#define STEP(C0, C1, P0, P1, t, GK, GV, GL) do { SBAR(); \
    const lds_cptr vp_ = vp0 + vs_prev; const lds_cptr kx_ = kp0 + ks_cur; \
    VRD(0); KLD(4); SBAR(); float sacc = (P0[0] + P0[1]); \
    GAPA(C0 = MFMA32(kf[0], qr[0], negm), P0[2], P0[3], P0[4], P0[5],     pw0[0] = PKW(P0, 0), pw0[1] = PKW(P0, 2), pw0); \
    VRD(4); KLD(5); SBAR(); GAPA(C1 = MFMA32(kf[1], qr[0], negm), P0[6], P0[7], P0[8], P0[9],     pw0[2] = PKW(P0, 4), pw0[3] = PKW(P0, 6), pw0); \
    VRD(1); KLD(6); SBAR(); GAPA(C0 = MFMA32(kf[2], qr[1], C0),   P0[10], P0[11], P0[12], P0[13], pw1[0] = PKW(P0, 8), pw1[1] = PKW(P0, 10), pw1); \
    VRD(5); KLD(7); SBAR(); GAPA(C1 = MFMA32(kf[3], qr[1], C1),   P0[14], P0[15], P1[0], P1[1],   pw1[2] = PKW(P0, 12), pw1[3] = PKW(P0, 14), pw1); \
    VRD(2); KLD(8); SBAR(); GAPA(C0 = MFMA32(kf[4], qr[2], C0),   P1[2], P1[3], P1[4], P1[5],     pw2[0] = PKW(P1, 0), pw2[1] = PKW(P1, 2), pw2); \
    VRD(6); KLD(9); SBAR(); GAPA(C1 = MFMA32(kf[5], qr[2], C1),   P1[6], P1[7], P1[8], P1[9],     pw2[2] = PKW(P1, 4), pw2[3] = PKW(P1, 6), pw2); \
    VRD(3); if (NKS == 6) KLD(10); SBAR(); GAPA(C0 = MFMA32(kf[6], qr[3], C0),   P1[10], P1[11], P1[12], P1[13], pw3[0] = PKW(P1, 8), pw3[1] = PKW(P1, 10), pw3); \
    VRD(7); if (NKS == 6) KLD(11); SBAR(); GAPA(C1 = MFMA32(kf[7], qr[3], C1),   P1[14], P1[15], 0.f, 0.f,       pw3[2] = PKW(P1, 12), pw3[3] = PKW(P1, 14), pw3); \
    C0 = MFMA32(kf[8], qr[4], C0); C1 = MFMA32(kf[9], qr[4], C1); if (NKS == 6) { C0 = MFMA32(kf[10], qr[NKS - 1], C0); C1 = MFMA32(kf[11], qr[NKS - 1], C1); } \
    l_reg += sacc; \
    if (GK) { DMA_K((t) + 3, ks_prev); } if (GV) { DMA_V((t) + 1, vs_next); } \
    CMASK(C0, C1, t); \
    resc = false; \
    if (!bounded) { float a = MX3(C0[0], C0[1], C1[0]), b_ = MX3(C0[2], C0[3], C1[1]); a = MX3(a, C1[2], C1[3]); \
      _Pragma("unroll") for (int r = 4; r < 16; r += 4) { a = MX3(a, C0[r], C0[r + 1]); b_ = MX3(b_, C0[r + 2], C0[r + 3]); a = MX3(a, C1[r], C1[r + 1]); b_ = MX3(b_, C1[r + 2], C1[r + 3]); } \
      float rm = __builtin_fmaxf(a, b_); { auto rr = __builtin_amdgcn_permlane32_swap(__float_as_uint(rm), __float_as_uint(rm), false, false); rm = __builtin_fmaxf(__uint_as_float(rr[0]), __uint_as_float(rr[1])); } \
      if (__builtin_expect(__any(rm > (float)THRL), 0)) { const float dl = __builtin_fmaxf(rm, 0.f); mhat += dl; \
        _Pragma("unroll") for (int r = 0; r < 16; ++r) { C0[r] -= dl; C1[r] -= dl; } \
        _Pragma("unroll") for (int r = 0; r < 16; ++r) negm[r] = cqv - mhat; asm volatile("" : "+v"(negm)); \
        const float f = __builtin_amdgcn_exp2f(-dl); l_reg *= f; if (hi == 0) wsf[r32] = f; resc = true; } } \
    SBAR(); \
    GAPB(o[0] = MFMA32(PAF(0), VFR(0), o[0]), C0, 0); \
    GAPB(o[1] = MFMA32(PAF(0), VFR(4), o[1]), C0, 4); \
    KRD(GL, 0); GAPB(o[0] = MFMA32(PAF(1), VFR(1), o[0]), C0, 8); \
    KRD(GL, 1); GAPB(o[1] = MFMA32(PAF(1), VFR(5), o[1]), C0, 12); \
    GAPB(o[0] = MFMA32(PAF(2), VFR(2), o[0]), C1, 0); \
    GAPB(o[1] = MFMA32(PAF(2), VFR(6), o[1]), C1, 4); \
    GAPB(o[0] = MFMA32(PAF(3), VFR(3), o[0]), C1, 8); \
    GAPB(o[1] = MFMA32(PAF(3), VFR(7), o[1]), C1, 12); \
    } while (0)
#define ENDW(tt) do { if ((tt) + 3 < NT) { WAIT_BAR(3); } else if ((tt) + 2 < NT) { WAIT_BAR(1); } else { WAIT_BAR(0); } } while (0)
    WAIT_BAR(3);
    STEP(pA0, pA1, pB0, pB1, 1, true, true, true); ENDW(1); RESC(); ROT();
    int t = 2;
#undef CMASK
#define CMASK(P0, P1, t) do { } while (0)
    for (; t + 5 < NT; t += 2) {
        STEP(pB0, pB1, pA0, pA1, t, true, true, true);     WAIT_BAR(3); RESC(); ROT();
        STEP(pA0, pA1, pB0, pB1, t + 1, true, true, true); WAIT_BAR(3); RESC(); ROT();
    }
#undef CMASK
#define CMASK(P0, P1, t) do { int jb_ = (t) - (NT - 4); if (jb_ >= 0) cmask(P0, P1, jb_, qrel, hi); } while (0)
    for (; t + 1 < NT; t += 2) {
        STEP(pB0, pB1, pA0, pA1, t, (t + 3 < NT), (t + 1 < NT), (t + 1 < NT));         ENDW(t);     RESC(); ROT();
        STEP(pA0, pA1, pB0, pB1, t + 1, (t + 4 < NT), (t + 2 < NT), (t + 2 < NT));     ENDW(t + 1); RESC(); ROT();
    }
    STEP(pB0, pB1, pA0, pA1, NT - 1, false, false, false); RESC();
    { float sacc = pB0[0] + pB0[1];
#pragma unroll
      for (int r = 2; r < 16; ++r) sacc += pB0[r];
#pragma unroll
      for (int r = 0; r < 16; ++r) sacc += pB1[r];
      l_reg += sacc;
      pw0 = (u32x4){PKW(pB0, 0), PKW(pB0, 2), PKW(pB0, 4), PKW(pB0, 6)}; pw1 = (u32x4){PKW(pB0, 8), PKW(pB0, 10), PKW(pB0, 12), PKW(pB0, 14)};
      pw2 = (u32x4){PKW(pB1, 0), PKW(pB1, 2), PKW(pB1, 4), PKW(pB1, 6)}; pw3 = (u32x4){PKW(pB1, 8), PKW(pB1, 10), PKW(pB1, 12), PKW(pB1, 14)};
      SBAR(); pv(o, vb0 + vs_cur, PAF(0), PAF(1), PAF(2), PAF(3)); }
#undef PKW
#undef PAF
#undef VFR
#undef PIN
#undef GAPA
#undef GAPB
#undef EX
#undef VRD
#undef KRD
#undef STEP
#undef KLD
#undef ENDW
    { auto rr = __builtin_amdgcn_permlane32_swap(__float_as_uint(l_reg), __float_as_uint(l_reg), false, false); l_reg = __uint_as_float(rr[0]) + __uint_as_float(rr[1]); }
    if (hi == 0) wsf[32 + r32] = l_reg; asm volatile("s_waitcnt lgkmcnt(0)" ::: "memory");
    float rli[16];
#pragma unroll
    for (int r = 0; r < 16; ++r) rli[r] = __builtin_amdgcn_rcpf(wsf[32 + crow(r, hi)]);
    bf16_t* Ow = O + (size_t)(b * T + q0 + wid * QBLK) * D + ocol;
    { bf16_t* stg = (bf16_t*)(shm + LDS_OST) + wid * 2048;
#pragma unroll
      for (int r = 0; r < 16; ++r) { const int orow = crow(r, hi);
#pragma unroll
          for (int d0 = 0; d0 < 2; ++d0) stg[orow * 64 + d0 * 32 + r32] = (bf16_t)f2bf(o[d0][r] * rli[r]); }
      asm volatile("s_waitcnt lgkmcnt(0)" ::: "memory");
#pragma unroll
      for (int i = 0; i < 4; ++i) { const int row = i * 8 + (lane >> 3), ch = lane & 7; const u32x4 v = *(const u32x4*)(stg + row * 64 + ch * 8); ATTN_STORE16(Ow + (size_t)row * D + ch * 8, v); } }
    asm volatile("s_waitcnt lgkmcnt(0)\n\ts_barrier" ::: "memory");
    __builtin_amdgcn_s_setprio(0);
#undef DMA_K
#undef DMA_V
#undef CMASK
#undef RESC
#undef ROT
}
#undef SBAR
#undef WAIT_BAR
#undef MFMA32
#undef MX3
#undef LDSV8
}
constexpr int CW_QATT = 13312, CW_QCONV = CW_QATT + 64 * 8;
__device__ __forceinline__ int wg_dequeue(unsigned* head, volatile __attribute__((address_space(3))) unsigned* slot) {
    __syncthreads();
    if (threadIdx.x == 0) *slot = __hip_atomic_fetch_add(head, 1u, __ATOMIC_RELAXED, __HIP_MEMORY_SCOPE_AGENT);
    __syncthreads();
    return (int)*slot;
}
__device__ __forceinline__ void attn_phase(const Ctx& C, char* shm, unsigned* ctl, unsigned xcc, volatile __attribute__((address_space(3))) unsigned* slot) {
    float m0_mla, m0_fox;
    { const int l = threadIdx.x & 63; float a = fmaxf(fabsf(C.g_q_mla[l]), l < 32 ? fabsf(C.g_q_mla[64 + l]) : 0.f), b2 = fmaxf(fabsf(C.g_k_mla[l]), l < 32 ? fabsf(C.g_k_mla[64 + l]) : 0.f), c = fabsf(C.g_q_fox[l]), d = fabsf(C.g_k_fox[l]);
#pragma unroll
      for (int o = 1; o < 64; o <<= 1) { a = fmaxf(a, __shfl_xor(a, o)); b2 = fmaxf(b2, __shfl_xor(b2, o)); c = fmaxf(c, __shfl_xor(c, o)); d = fmaxf(d, __shfl_xor(d, o)); }
      m0_mla = 9.797958971f * a * b2 * LOG2E * 1.02f; m0_fox = 8.0f * c * d * LOG2E * 1.02f; }
    const float prune = -(2.0f * m0_fox + 40.0f);
    unsigned pre = 128u;
    if (threadIdx.x == 0) pre = __hip_atomic_fetch_add(ctl + CW_QATT + 64 * (int)(xcc & 7u), 1u, __ATOMIC_RELAXED, __HIP_MEMORY_SCOPE_AGENT);
    for (bool own = true;;) {
        __syncthreads();
        if (threadIdx.x == 0) { int grp = (int)(xcc & 7u); unsigned tk = 128u;
            if (own) tk = pre;
            if (tk >= 128u) { unsigned hd[8];
#pragma unroll
                for (int g = 0; g < 8; ++g) hd[g] = __hip_atomic_load(ctl + CW_QATT + 64 * g, __ATOMIC_RELAXED, __HIP_MEMORY_SCOPE_AGENT);
                int pick = -1;
#pragma unroll
                for (int g = 7; g >= 0; --g) { const int gg = (int)((xcc + 1u + (unsigned)g) & 7u); unsigned hv = 0u;
#pragma unroll
                    for (int q = 0; q < 8; ++q) hv = (q == gg) ? hd[q] : hv;
                    if (hv < 128u) pick = gg; }
                if (pick >= 0) { grp = pick; tk = __hip_atomic_fetch_add(ctl + CW_QATT + 64 * grp, 1u, __ATOMIC_RELAXED, __HIP_MEMORY_SCOPE_AGENT); } else tk = 0xffffu; }
            *slot = (tk << 8) | (unsigned)grp; }
        __syncthreads();
        const unsigned sv = *slot; const int grp = (int)(sv & 7u), i = (int)(sv >> 8);
        if (i >= 0xffff) break;
        if (i >= 128) { own = false; continue; }
        if (grp != (int)(xcc & 7u)) own = false;
        if (own && threadIdx.x == 0) pre = __hip_atomic_fetch_add(ctl + CW_QATT + 64 * grp, 1u, __ATOMIC_RELAXED, __HIP_MEMORY_SCOPE_AGENT);
        {
            const int fox = i >> 6, j = i & 63, st = 4 * grp + 2 * (j & 1) + fox, qb = 31 - (j >> 1), bh = st >> 1, b = bh >> 3, h = bh & 7;
            if (!fox) att::attn_unit<6, false, 8>(b, h, qb, C.QM, C.KM, C.VM, C.main.SSQQ, C.O, h * 64, shm, m0_mla, 0);
            else { const int lane = threadIdx.x & 63, cand = 2 * lane; const size_t hb = (size_t)bh * PR;
                bool ok = cand <= 4 * qb;
                if (ok && cand > 0) ok = (C.CUM[hb + 64 + 256 * qb] - C.CUM[hb + 64 * cand - 1]) * LOG2E < prune;
                const unsigned long long m = __ballot(ok); const int tb = 2 * (63 - __builtin_clzll(m));
                att::attn_unit<5, true, 8>(b, h, qb, C.FQ, C.FK, C.FV, C.CUM, C.O, 512 + h * 64, shm, m0_fox, __builtin_amdgcn_readfirstlane(tb)); } } }
    constexpr int NCHUNK = (2 * I_GU + I_DN + 7) / 8;
    for (;;) { const int c = wg_dequeue(ctl + CW_QCONV, slot); if (c >= NCHUNK) break;
        const int w_ = __builtin_amdgcn_readfirstlane(threadIdx.x >> 6); p0_late<1>(C, (float*)shm + w_ * TSCR, c * 8 + w_, NCHUNK * 8, threadIdx.x & 63); }
}
#define LAS __attribute__((address_space(3)))
constexpr int CW_BAR = 1024;
constexpr size_t CTL_ZERO_BYTES = 65536;
constexpr int LDSCTL_OFF = 131072, MISC_OFF = LDSCTL_OFF + 320;
#define XB_TMO      128
#define XB_XCNT(j)  (256  + 64 * (j))
#define XB_XSUB(j)  (1280 + 64 * (j))
#define XB_XGEN(j)  (2304 + 64 * (j))
#define XB_TOP      3328
#define XB_TOPGEN   3392
#define XCD_BAR_WORDS 3456
#define XB_SPIN_CAP (1u << 18)

__device__ __forceinline__ unsigned xb_ld(unsigned* p)              { return __hip_atomic_load(p, __ATOMIC_RELAXED, __HIP_MEMORY_SCOPE_AGENT); }
__device__ __forceinline__ unsigned xb_add(unsigned* p, unsigned v) { return __hip_atomic_fetch_add(p, v, __ATOMIC_RELAXED, __HIP_MEMORY_SCOPE_AGENT); }
__device__ __forceinline__ unsigned xb_xcc_id() { return (unsigned)__builtin_amdgcn_s_getreg((3 << 11) | 20) & 0xFu; }
#define XB_SPIN(cond, bar) do { unsigned _sp = 0; while (cond) { __builtin_amdgcn_s_sleep(1); \
    if ((++_sp & 255u) == 0u) { if (xb_ld(&(bar)[XB_TMO])) break; if (_sp > XB_SPIN_CAP) { atomicAdd(&(bar)[XB_TMO], 1u); break; } } } } while (0)

constexpr int CW_SIDE = 12288;
__device__ __forceinline__ void side_wait(unsigned* w, unsigned target, unsigned* bar) {
    if (threadIdx.x == 0) { XB_SPIN(xb_ld(w) < target, bar); __builtin_amdgcn_fence(__ATOMIC_ACQUIRE, "agent"); asm volatile("s_waitcnt vmcnt(0)" ::: "memory"); }
    __syncthreads();
}
struct XcdBarrier {
    unsigned* bar; unsigned x;
    volatile LAS unsigned* st;
};

__device__ __forceinline__ XcdBarrier xcd_barrier_post(unsigned* bar, volatile LAS unsigned* st) {
    XcdBarrier b; b.bar = bar; b.x = xb_xcc_id(); b.st = st;
    if (threadIdx.x == 0) (void)xb_add(&bar[XB_XCNT(b.x)], 1u);
    return b;
}
__device__ __forceinline__ void xcd_barrier_complete(unsigned* bar, unsigned x, unsigned& nloc, unsigned& nx) {
    const unsigned G = gridDim.x * gridDim.y * gridDim.z;
    unsigned sum, cnt, mine, sp = 0u;
    for (;;) {
        sum = 0u; cnt = 0u; mine = 0u;
#pragma unroll
        for (unsigned j = 0; j < 16; ++j) { const unsigned c = xb_ld(&bar[XB_XCNT(j)]); sum += c; cnt += (c > 0u) ? 1u : 0u; mine = (j == x) ? c : mine; }
        if (sum == G) break;
        __builtin_amdgcn_s_sleep(1);
        if ((++sp & 255u) == 0u) { if (xb_ld(&bar[XB_TMO])) break; if (sp > XB_SPIN_CAP) { atomicAdd(&bar[XB_TMO], 1u); break; } }
    }
    nloc = mine > 0u ? mine : 1u; nx = cnt > 0u ? cnt : 1u;
}

__device__ __forceinline__ void xcd_barrier(const XcdBarrier& b) {
    asm volatile("s_waitcnt vmcnt(0)" ::: "memory");
    __syncthreads();
    if (threadIdx.x == 0) {
        unsigned* bar = b.bar;
        __builtin_amdgcn_s_waitcnt(0);
        unsigned nloc = b.st[0], nx = b.st[1];
        if (nloc == 0u) { xcd_barrier_complete(bar, b.x, nloc, nx); b.st[0] = nloc; b.st[1] = nx; }
        const unsigned old = xb_add(&bar[XB_XSUB(b.x)], 1u);
        const unsigned gen = old / nloc;
        if (old + 1u == (gen + 1u) * nloc) {
            __builtin_amdgcn_fence(__ATOMIC_RELEASE, "agent");
            asm volatile("s_waitcnt vmcnt(0)" ::: "memory");
            const unsigned og = xb_add(&bar[XB_TOP], 1u);
            const unsigned tg = og / nx;
            if (og + 1u == (tg + 1u) * nx) xb_add(&bar[XB_TOPGEN], 1u);
            else XB_SPIN(xb_ld(&bar[XB_TOPGEN]) == tg, bar);
            __builtin_amdgcn_fence(__ATOMIC_ACQUIRE, "agent");
            xb_add(&bar[XB_XGEN(b.x)], 1u);
            asm volatile("s_waitcnt vmcnt(0)" ::: "memory");
        } else {
            XB_SPIN(xb_ld(&bar[XB_XGEN(b.x)]) == gen, bar);
            __builtin_amdgcn_fence(__ATOMIC_ACQUIRE, "agent");
            asm volatile("s_waitcnt vmcnt(0)" ::: "memory");
        }
    }
    __syncthreads();
}

constexpr int NWAVES = 8, LDS_BYTES = 147456;
__device__ __forceinline__ void fk_aug(const Ctx& C, int b, int h, int p, float cum) {
    C.CUM[arow(b, h, p)] = cum;
    const float cc = -cum * LOG2E; const unsigned hi = f2bf(cc); const float r1 = cc - __uint_as_float(hi << 16); const unsigned mid = f2bf(r1); const float r2 = r1 - __uint_as_float(mid << 16); const unsigned lo = f2bf(r2);
    *(u32x4*)(C.FK + kaddr(b, h, p, 64, DFK)) = (u32x4){hi | (mid << 16), lo, 0u, 0u}; *(u32x4*)(C.FK + kaddr(b, h, p, 72, DFK)) = (u32x4){0u, 0u, 0u, 0u};
}
__device__ __forceinline__ void scan_block(const Ctx& C, int bh, float* lds_f, int tid) {
    const int b = bh >> 3, h = bh & 7, lane = tid & 63, w = tid >> 6; constexpr int PER = 16;
    float v[PER]; const int e0 = tid * PER;
#pragma unroll
    for (int i = 0; i < PER; ++i) v[i] = C.main.LOGF[(size_t)(b * T + e0 + i) * 8 + h];
#pragma unroll
    for (int i = 1; i < PER; ++i) v[i] += v[i - 1];
    float s = v[PER - 1];
#pragma unroll
    for (int o = 1; o < 64; o <<= 1) { const float n = __shfl_up(s, o); if (lane >= o) s += n; }
    if (lane == 63) lds_f[w] = s;
    __syncthreads();
    float off = s - v[PER - 1];
#pragma unroll
    for (int j = 0; j < 8; ++j) if (j < w) off += lds_f[j];
#pragma unroll
    for (int i = 0; i < PER; ++i) fk_aug(C, b, h, 64 + e0 + i, off + v[i]);
    if (tid < 16) { float c = 0.f; for (int r = tid + 1; r < 16; ++r) c += C.mt.LOGF[r * 8 + h]; fk_aug(C, b, h, 48 + tid, -c); }
    if (tid >= 256) { const int r = (tid >> 3) & 15, ch = tid & 7;
        if (tid < 384) *(u32x4*)(C.FK + kaddr(b, h, 48 + r, 8 * ch, DFK)) = *(const u32x4*)(C.MFK + (r * 8 + h) * 64 + 8 * ch);
        else *(u32x4*)(C.FV + vaddr(b, h, 48 + r, 8 * ch)) = *(const u32x4*)(C.MFV + (r * 8 + h) * 64 + 8 * ch); }
    if (tid < 48) { const int p = tid; C.CUM[arow(b, h, p)] = 0.f;
        const u32x4 z = {0u, 0u, 0u, 0u};
        for (int j = 0; j < DFK / 8; ++j) *(u32x4*)(C.FK + kaddr(b, h, p, 8 * j, DFK)) = z;
        for (int j = 0; j < DQM / 8; ++j) *(u32x4*)(C.KM + kaddr(b, h, p, 8 * j, DQM)) = z;
        for (int j = 0; j < 8; ++j) { *(u32x4*)(C.FV + vaddr(b, h, p, 8 * j)) = z; *(u32x4*)(C.VM + vaddr(b, h, p, 8 * j)) = z; } }
    __syncthreads();
}
#define GEMM_PHASE(g, E) do { int t_ = threadIdx.x; asm volatile("" : "+v"(t_)); pg8::StaticOrder S_; S_.init((g).M, (g).N, G, (int)blockIdx.x); \
    pg8::gemm_phase<std::remove_cv_t<std::remove_reference_t<decltype(E)>>, pg8::StaticOrder, true, true>(ldsp, g, S_, E, t_); } while (0)
__global__ void __launch_bounds__(NWAVES * 64, 2) mega_fwd(KArgs a) {
    extern __shared__ __attribute__((aligned(16))) unsigned char lds[];
    const Ctx C = make_ctx(a);
    PG8_LAS unsigned char* ldsp = (PG8_LAS unsigned char*)lds;
    const int tid = threadIdx.x, lane = tid & 63, wave = __builtin_amdgcn_readfirstlane(tid >> 6);
    const int G = gridDim.x, gw = blockIdx.x * NWAVES + wave, NGW = G * NWAVES;
    for (int u = tid; u < (LDS_BYTES - LDSCTL_OFF) / 4; u += NWAVES * 64) ((LAS unsigned*)((LAS unsigned char*)lds + LDSCTL_OFF))[u] = 0u;
    __syncthreads();
    PG8_LAS float* const gtab = (PG8_LAS float*)(ldsp + LDSCTL_OFF + 8192);
    if (tid < 320) gtab[tid] = tid < 64 ? C.g_q_fox[tid] : tid < 128 ? C.g_k_fox[tid - 64] : tid < 224 ? C.g_q_mla[tid - 128] : C.g_k_mla[tid - 224];
    __syncthreads();
    unsigned* const ctl = (unsigned*)(a.ws + WS_CTL);
    const XcdBarrier bar = xcd_barrier_post(ctl + CW_BAR, (volatile LAS unsigned*)((LAS unsigned char*)lds + MISC_OFF) + 8);
    p0_prologue(C, (float*)lds + wave * TSCR, gw, wave * G + (int)blockIdx.x, NGW, lane);
    xcd_barrier(bar);
    { const int s_ = (int)blockIdx.x - G / 2, NS = G - G / 2; unsigned* const side = ctl + CW_SIDE;
      const bool dn = s_ >= NS - 16, wn = s_ >= 48 && s_ < 66;
      if (s_ >= 0) {
          for (int t = s_; t < FF / 16; t += NS) { task_gateup(C.mt.XN1, C.W1GU, nullptr, C.mt.HB, t, lane, wave, (float*)lds); __syncthreads(); }
          if (wave == 0) { asm volatile("s_waitcnt vmcnt(0)" ::: "memory"); if (tid == 0) xb_add(side, 1u); } }
      const pg8::Gemm g{C.main.XN1, C.W1GU, M, 2 * FF, D, D}; const pg8::EpiSwiglu E{C.main.HB, nullptr};
      const int cut = dn ? 1 : wn ? 2 : 1 << 20; int nseg = 2; asm volatile("" : "+s"(nseg));
      for (int seg = 0; seg < nseg; ++seg) {
          { int t_ = threadIdx.x; asm volatile("" : "+v"(t_)); pg8::StaticOrder S_; S_.init(g.M, g.N, G, (int)blockIdx.x); S_.off = seg ? cut : 0; S_.cnt = seg ? 1 << 20 : cut;
            pg8::gemm_phase<pg8::EpiSwiglu, pg8::StaticOrder, true, true>(ldsp, g, S_, E, t_); }
          if (seg == 0 && dn) { side_wait(side, NS, ctl + CW_BAR);
              task_down(C.mt.HB, FF, C.W1D, C.mt.base1, C.mt.H, 0.5f, C.mt.XN, C.mt.SSQ1, s_ - (NS - 16), lane, wave, (float*)lds);
              if (wave == 0) { asm volatile("s_waitcnt vmcnt(0)" ::: "memory"); if (tid == 0) xb_add(side + 64, 1u); }
              __syncthreads(); }
          if (seg == 0 && wn) { side_wait(side + 64, 16, ctl + CW_BAR); task_win(C, C.mt, 0, s_ - 48, lane, wave, (float*)lds); __syncthreads(); } }
      if (s_ >= 0 && !dn && !wn) p0_late<0>(C, (float*)lds + wave * TSCR, (s_ < 48 ? s_ : s_ - 18) * NWAVES + wave, (NS - 34) * NWAVES, lane); }
    xcd_barrier(bar);
    { const pg8::Gemm g{C.main.HB, C.W1D, M, D, FF, FF}; const pg8::EpiResid<1, 0> E{C.main.base1, nullptr, C.main.XN, C.main.SSQ1}; GEMM_PHASE(g, E); }
    xcd_barrier(bar);
    { const pg8::Gemm g{C.main.XN, C.WIN, M, 2048, D, D}; PG8_LAS float* rst = (PG8_LAS float*)(ldsp + LDSCTL_OFF + 1024);
      { pg8::StaticOrder S_; S_.init(g.M, g.N, G, (int)blockIdx.x); pg8::rs_table_fill(C.main.SSQ1, S_, rst, tid); }
      const pg8::EpiWin E{C, rst, gtab}; GEMM_PHASE(g, E); }
    xcd_barrier(bar);
    { int k_ = 128; asm volatile("" : "+s"(k_)); const pg8::Gemm g{C.main.CKV, C.WUKV, M, 1024, k_, k_}; const pg8::EpiUkv E{gtab + 224, C.main.SSQCKV, C.main.SSQKPE, C.main.KPE, C.KM, C.VM, C.ROPE}; GEMM_PHASE(g, E); }
    { const int sb = (int)blockIdx.x - (G - 24);
      if (sb >= 0 && sb < 16) scan_block(C, sb, (float*)lds, tid);
      if (sb >= 16) { task_uqkv(C, C.mt, 8 + (sb - 16), lane, wave, (float*)lds); __syncthreads(); } }
    { int k_ = 256; asm volatile("" : "+s"(k_)); const pg8::Gemm g{C.main.CQ, C.WUQ, M, 768, k_, k_}; const pg8::EpiUq E{gtab + 128, C.main.SSQCQ, C.main.SSQQ, C.QM, C.ROPE}; GEMM_PHASE(g, E); }
    xcd_barrier(bar);
    { static_assert(MISC_OFF + 64 <= LDS_BYTES && att::LDS_BYTES <= LDSCTL_OFF, "attention LDS");
      attn_phase(C, (char*)lds, ctl, bar.x, (volatile LAS unsigned*)((LAS unsigned char*)lds + MISC_OFF) + 12); }
    xcd_barrier(bar);
    { const pg8::Gemm g{C.O, C.WOUT, M, D, D, D}; const pg8::EpiResid<0, 1> E{C.main.XN, nullptr, C.main.XN, C.SSQ2}; GEMM_PHASE(g, E); }
    xcd_barrier(bar);
    { const pg8::Gemm g{C.main.XN, C.W2GU, M, 2 * FF, D, D}; PG8_LAS float* rst = (PG8_LAS float*)(ldsp + LDSCTL_OFF + 1024);
      { pg8::StaticOrder S_; S_.init(g.M, g.N, G, (int)blockIdx.x); pg8::rs_table_fill(C.SSQ2, S_, rst, tid); }
      const pg8::EpiSwiglu E{C.main.HB, rst}; GEMM_PHASE(g, E); }
    xcd_barrier(bar);
    { const pg8::Gemm g{C.main.HB, C.W2D, M, D, FF, FF}; const pg8::EpiResid<1, 1> E{C.main.XN, C.out, nullptr, nullptr}; GEMM_PHASE(g, E); }
}

extern "C" void kernel_launch(void* const* d_in, const int* in_sizes, int n_in, void* d_out, int out_size, void* d_ws, size_t ws_size, hipStream_t stream) {
    static int grid = 0;
    if (grid == 0) {
        if (n_in != 22 || in_sizes[0] != M * D || out_size != M * D || ws_size < WS_END) { fprintf(stderr, "kernel_launch: unexpected shapes (n_in %d, in0 %d, out %d, ws %zu)\n", n_in, n_in > 0 ? in_sizes[0] : -1, out_size, ws_size); grid = -1; return; }
        int dev = 0, cus = 0, per_cu = 0;
        if (hipGetDevice(&dev) != hipSuccess || hipDeviceGetAttribute(&cus, hipDeviceAttributeMultiprocessorCount, dev) != hipSuccess) { grid = -1; return; }
        if (hipFuncSetAttribute((const void*)mega_fwd, hipFuncAttributeMaxDynamicSharedMemorySize, LDS_BYTES) != hipSuccess) { fprintf(stderr, "kernel_launch: hipFuncSetAttribute failed\n"); grid = -1; return; }
        if (hipOccupancyMaxActiveBlocksPerMultiprocessor(&per_cu, (const void*)mega_fwd, NWAVES * 64, LDS_BYTES) != hipSuccess || per_cu < 1) { fprintf(stderr, "kernel_launch: occupancy query reports %d blocks per CU\n", per_cu); grid = -1; return; }
        grid = cus;
    }
    if (grid < 0) return;
    if (hipMemsetAsync((char*)d_ws + WS_CTL, 0, CTL_ZERO_BYTES, stream) != hipSuccess) { fprintf(stderr, "kernel_launch: hipMemsetAsync of the control words failed\n"); return; }
    KArgs a{}; for (int i = 0; i < 22; ++i) a.in[i] = (const float*)d_in[i]; a.out = (float*)d_out; a.ws = (unsigned char*)d_ws;
    void* args[] = {&a};
    const hipError_t e = hipLaunchCooperativeKernel((const void*)mega_fwd, dim3(grid), dim3(NWAVES * 64), args, LDS_BYTES, stream);
    if (e != hipSuccess) fprintf(stderr, "kernel_launch: cooperative launch failed: %s (grid %d)\n", hipGetErrorString(e), grid);
}
```

```cpp
#include <hip/hip_runtime.h>
#include <cstdint>
#include <cstdio>
#include <type_traits>

typedef unsigned short bf16_t;
typedef short bf16x8 __attribute__((ext_vector_type(8)));
typedef float f32x4 __attribute__((ext_vector_type(4)));
typedef unsigned u32x4 __attribute__((ext_vector_type(4)));
typedef unsigned u32x2 __attribute__((ext_vector_type(2)));

constexpr int NB = 2, T = 8192, D = 1024, FF = 2816, M = NB * T, NMETA = 16;
constexpr int PR = 64 + T;
constexpr int NPOS = 16 + T;
constexpr int DQM = 96, DFK = 80, DV = 64;
constexpr float EPS = 1e-6f;
constexpr float LOG2E = 1.4426950408889634f;
constexpr float C2F = 0.125f * LOG2E;
constexpr float C2M = 0.10206207261596577f * LOG2E;

constexpr size_t KiB = 1024, MiB = 1u << 20;
constexpr size_t WS_CTL = 0;
constexpr size_t WS_W1GU = 1 * MiB, WS_W1D = 12 * MiB, WS_W2GU = 18 * MiB, WS_W2D = 29 * MiB, WS_WIN = 35 * MiB, WS_WOUT = 39 * MiB;
constexpr size_t WS_WUQ = 41 * MiB, WS_WUKV = 41 * MiB + 512 * KiB, WS_ROPE = 42 * MiB;
constexpr size_t WS_META = 43 * MiB + 512 * KiB;
constexpr size_t WS_XN = 44 * MiB, WS_CQ = 76 * MiB, WS_CKV = 84 * MiB, WS_KPE = 88 * MiB, WS_LOGF = 90 * MiB, WS_CUM = 90 * MiB + 512 * KiB;
constexpr size_t WS_SSQ1 = 91 * MiB + 256 * KiB, WS_SSQ2 = 92 * MiB + 256 * KiB, WS_SSQCQ = 93 * MiB + 256 * KiB, WS_SSQCKV = 93 * MiB + 512 * KiB, WS_SSQKPE = 93 * MiB + 768 * KiB, WS_SSQQ = 94 * MiB;
constexpr size_t WS_HB = 95 * MiB;
constexpr size_t WS_FQ = 95 * MiB, WS_FK = 111 * MiB + 256 * KiB, WS_FV = 131 * MiB + 512 * KiB, WS_QM = 147 * MiB + 768 * KiB, WS_KM = 172 * MiB, WS_VM = 196 * MiB + 256 * KiB, WS_O = 212 * MiB + 512 * KiB;
constexpr size_t WS_END = 256 * MiB;
static_assert(WS_FQ + (size_t)NB * 8 * PR * 64 * 2 <= WS_FK && WS_FK + (size_t)NB * 8 * PR * DFK * 2 <= WS_FV && WS_FV + (size_t)NB * 8 * PR * 64 * 2 <= WS_QM, "ws map 1");
static_assert(WS_QM + (size_t)NB * 8 * PR * DQM * 2 <= WS_KM && WS_KM + (size_t)NB * 8 * PR * DQM * 2 <= WS_VM && WS_VM + (size_t)NB * 8 * PR * 64 * 2 <= WS_O && WS_O + (size_t)M * D * 2 <= WS_END, "ws map 2");
static_assert(WS_ROPE + (size_t)NPOS * 16 * 8 <= WS_META && WS_CUM + (size_t)NB * 8 * PR * 4 <= WS_SSQ1 && WS_HB + (size_t)M * FF * 2 <= WS_END, "ws map 3");
constexpr size_t MO_XNM = 0, MO_HB = 32 * KiB, MO_H = 128 * KiB, MO_XN = 192 * KiB, MO_SSQ1 = 224 * KiB, MO_CQ = 228 * KiB, MO_SSQCQ = 236 * KiB, MO_CKV = 237 * KiB, MO_SSQCKV = 241 * KiB,
                 MO_KPE = 242 * KiB, MO_SSQKPE = 244 * KiB, MO_LOGF = 245 * KiB, MO_SSQQ = 246 * KiB, MO_FKS = 256 * KiB, MO_FVS = 272 * KiB;

__device__ __forceinline__ float bf2f(bf16_t v) { return __uint_as_float((unsigned)v << 16); }
__device__ __forceinline__ unsigned f2bf(float f) { unsigned u = __float_as_uint(f); return (u + 0x7fffu + ((u >> 16) & 1u)) >> 16; }
__device__ __forceinline__ unsigned pk2(float lo, float hi) { return f2bf(lo) | (f2bf(hi) << 16); }
__device__ __forceinline__ float rsum16(float v) { v += __shfl_xor(v, 1); v += __shfl_xor(v, 2); v += __shfl_xor(v, 4); v += __shfl_xor(v, 8); return v; }
__device__ __forceinline__ float wave_sum(float v) {
#pragma unroll
    for (int o = 1; o < 64; o <<= 1) v += __shfl_xor(v, o);
    return v;
}
__device__ __forceinline__ float sum16f(const float* p) { const f32x4 a = ((const f32x4*)p)[0], b = ((const f32x4*)p)[1], c = ((const f32x4*)p)[2], d = ((const f32x4*)p)[3];
    return ((a[0] + a[1]) + (a[2] + a[3])) + ((b[0] + b[1]) + (b[2] + b[3])) + ((c[0] + c[1]) + (c[2] + c[3])) + ((d[0] + d[1]) + (d[2] + d[3])); }
__device__ __forceinline__ float sum4f(const float* p) { const f32x4 a = *(const f32x4*)p; return (a[0] + a[1]) + (a[2] + a[3]); }
__device__ __forceinline__ float silu_mul(float g, float u) { return g / (1.0f + __expf(-g)) * u; }
__device__ __forceinline__ float log_sigmoid(float x) { return fminf(x, 0.f) - 0.6931471805599453f * __builtin_amdgcn_logf(1.0f + __builtin_amdgcn_exp2f(-LOG2E * fabsf(x))); }

__host__ __device__ __forceinline__ int gu_row_gate(int c) { return 256 * (c >> 7) + (c & 127); }
__host__ __device__ __forceinline__ int rope_slot(int dd) { return 8 * ((dd & 15) >> 2) + 4 * (dd >> 4) + (dd & 3); }
__host__ __device__ __forceinline__ int win_row(int s) {
    if (s < 256) return s;
    if (s < 384) return 256 + (s - 256);
    if (s < 416) return 256 + 128 + rope_slot(s - 384);
    if (s < 1952) { const int i = s - 416, which = i >> 9, head = (i & 511) >> 6, d = i & 63; return 256 * (2 + which * 2 + (head >> 2)) + 128 * (d >> 5) + 32 * (head & 3) + (d & 31); }
    return 256 + 160 + (s - 1952);
}
__host__ __device__ __forceinline__ int wuq_row(int s) { const int h = s / 96, d = s % 96;
    if (d < 64) return 256 * (h >> 2) + 128 * (d >> 5) + 32 * (h & 3) + (d & 31);
    return 512 + 128 * (h & 1) + 32 * (h >> 1) + rope_slot(d - 64); }
__host__ __device__ __forceinline__ int wukv_row(int s) { const int h = s >> 7, d = s & 127;
    if (d < 64) return 256 * (h >> 2) + 128 * (d >> 5) + 32 * (h & 3) + (d & 31);
    const int e = d - 64; return 256 * (2 + (h >> 2)) + 128 * (e >> 5) + 32 * (h & 3) + (e & 31); }

struct KArgs { const float* in[22]; float* out; unsigned char* ws; };
struct RowSet {
    int nrows, meta;
    const bf16_t* XN1; const float* base1; bf16_t* HB; float* H; bf16_t* XN; float* SSQ1;
    bf16_t* CQ; float* SSQCQ; bf16_t* CKV; float* SSQCKV; float* KPE; float* SSQKPE; float* LOGF; float* SSQQ;
};
struct Ctx {
    const float *x, *meta, *g_ffn1, *w1g, *w1u, *w1d, *g_mix, *w_in, *g_cq, *w_uq, *g_ckv, *w_ukv, *g_q_mla, *g_k_mla, *b_forget, *g_q_fox, *g_k_fox, *w_out, *g_ffn2, *w2g, *w2u, *w2d;
    float* out; unsigned char* ws;
    bf16_t *W1GU, *W1D, *W2GU, *W2D, *WIN, *WOUT, *WUQ, *WUKV; float* ROPE;
    bf16_t *FQ, *FK, *FV, *QM, *KM, *VM, *O; float* CUM; float* SSQ2; bf16_t *MFK, *MFV;
    RowSet main, mt;
};
__device__ __forceinline__ Ctx make_ctx(const KArgs& a) {
    Ctx c;
    c.x = a.in[0]; c.meta = a.in[1]; c.g_ffn1 = a.in[2]; c.w1g = a.in[3]; c.w1u = a.in[4]; c.w1d = a.in[5]; c.g_mix = a.in[6]; c.w_in = a.in[7]; c.g_cq = a.in[8]; c.w_uq = a.in[9]; c.g_ckv = a.in[10];
    c.w_ukv = a.in[11]; c.g_q_mla = a.in[12]; c.g_k_mla = a.in[13]; c.b_forget = a.in[14]; c.g_q_fox = a.in[15]; c.g_k_fox = a.in[16]; c.w_out = a.in[17]; c.g_ffn2 = a.in[18]; c.w2g = a.in[19]; c.w2u = a.in[20]; c.w2d = a.in[21];
    c.out = a.out; c.ws = a.ws; unsigned char* ws = a.ws;
    c.W1GU = (bf16_t*)(ws + WS_W1GU); c.W1D = (bf16_t*)(ws + WS_W1D); c.W2GU = (bf16_t*)(ws + WS_W2GU); c.W2D = (bf16_t*)(ws + WS_W2D); c.WIN = (bf16_t*)(ws + WS_WIN); c.WOUT = (bf16_t*)(ws + WS_WOUT);
    c.WUQ = (bf16_t*)(ws + WS_WUQ); c.WUKV = (bf16_t*)(ws + WS_WUKV); c.ROPE = (float*)(ws + WS_ROPE);
    c.FQ = (bf16_t*)(ws + WS_FQ); c.FK = (bf16_t*)(ws + WS_FK); c.FV = (bf16_t*)(ws + WS_FV); c.QM = (bf16_t*)(ws + WS_QM); c.KM = (bf16_t*)(ws + WS_KM); c.VM = (bf16_t*)(ws + WS_VM); c.O = (bf16_t*)(ws + WS_O);
    c.CUM = (float*)(ws + WS_CUM); c.SSQ2 = (float*)(ws + WS_SSQ2);
    RowSet& m = c.main; m.nrows = M; m.meta = 0; m.XN1 = (bf16_t*)(ws + WS_XN); m.base1 = c.x; m.HB = (bf16_t*)(ws + WS_HB); m.H = a.out; m.XN = (bf16_t*)(ws + WS_XN); m.SSQ1 = (float*)(ws + WS_SSQ1);
    m.CQ = (bf16_t*)(ws + WS_CQ); m.SSQCQ = (float*)(ws + WS_SSQCQ); m.CKV = (bf16_t*)(ws + WS_CKV); m.SSQCKV = (float*)(ws + WS_SSQCKV); m.KPE = (float*)(ws + WS_KPE); m.SSQKPE = (float*)(ws + WS_SSQKPE);
    m.LOGF = (float*)(ws + WS_LOGF); m.SSQQ = (float*)(ws + WS_SSQQ);
    unsigned char* mw = ws + WS_META; RowSet& t = c.mt; t.nrows = NMETA; t.meta = 1; t.XN1 = (bf16_t*)(mw + MO_XNM); t.base1 = c.meta; t.HB = (bf16_t*)(mw + MO_HB); t.H = (float*)(mw + MO_H); t.XN = (bf16_t*)(mw + MO_XN);
    t.SSQ1 = (float*)(mw + MO_SSQ1); t.CQ = (bf16_t*)(mw + MO_CQ); t.SSQCQ = (float*)(mw + MO_SSQCQ); t.CKV = (bf16_t*)(mw + MO_CKV); t.SSQCKV = (float*)(mw + MO_SSQCKV); t.KPE = (float*)(mw + MO_KPE);
    t.SSQKPE = (float*)(mw + MO_SSQKPE); t.LOGF = (float*)(mw + MO_LOGF); t.SSQQ = (float*)(mw + MO_SSQQ);
    c.MFK = (bf16_t*)(mw + MO_FKS); c.MFV = (bf16_t*)(mw + MO_FVS);
    return c;
}
__device__ __forceinline__ size_t arow(int b, int h, int p) { return (size_t)((b * 8 + h) * PR + p); }
__device__ __forceinline__ size_t kaddr(int b, int h, int p, int d, int DK) { return ((size_t)((b * 8 + h) * PR + (p & ~63))) * DK + (size_t)((d >> 3) * 512 + (p & 63) * 8 + (d & 7)); }
__device__ __forceinline__ size_t vaddr(int b, int h, int p, int d) { return ((size_t)((b * 8 + h) * PR + (p & ~63))) * 64 + (size_t)((d >> 5) * 2048 + (p & 63) * 32 + (d & 31)); }

constexpr int TSCR = 32 * 68;
__device__ __forceinline__ void st_wt(bf16_t* p, bf16_t v) { __hip_atomic_store(p, v, __ATOMIC_RELAXED, __HIP_MEMORY_SCOPE_AGENT); }
__device__ __forceinline__ void st_wt(float* p, float v) { __hip_atomic_store(p, v, __ATOMIC_RELAXED, __HIP_MEMORY_SCOPE_AGENT); }
template <class MapF>
__device__ __forceinline__ void p0_transpose_item(const float* W, int K, int N, const float* gain, bf16_t* WT, MapF map, float* scr_, int item, int lane) {
    asm volatile("" : "+v"(lane));
    unsigned* scr = (unsigned*)scr_;
    const int nblk = (N + 63) / 64, kb = item / nblk, nb = item % nblk, k0 = 64 * kb, n0 = 64 * nb;
    const int x = lane & 15, kr = lane >> 4, nq = n0 + 4 * x;
    f32x4 e[8], o[8];
#pragma unroll
    for (int j = 0; j < 8; ++j) { const int k = k0 + 8 * j + 2 * kr;
        if (nq < N) { e[j] = *(const f32x4*)(W + (size_t)k * N + nq); o[j] = *(const f32x4*)(W + (size_t)(k + 1) * N + nq); } else { e[j] = (f32x4){0.f, 0.f, 0.f, 0.f}; o[j] = e[j]; } }
#pragma unroll
    for (int j = 0; j < 8; ++j) { const int k = k0 + 8 * j + 2 * kr; float ge = 1.f, go = 1.f; if (gain) { ge = gain[k]; go = gain[k + 1]; }
        u32x4 p; p.x = pk2(e[j].x * ge, o[j].x * go); p.y = pk2(e[j].y * ge, o[j].y * go); p.z = pk2(e[j].z * ge, o[j].z * go); p.w = pk2(e[j].w * ge, o[j].w * go);
        *(u32x4*)(scr + (4 * j + kr) * 68 + 4 * x) = p; }
    asm volatile("s_waitcnt vmcnt(0) lgkmcnt(0)" ::: "memory");
    const int c = lane >> 3;
#pragma unroll
    for (int j = 0; j < 8; ++j) { const int n = (lane & 7) + 8 * j; if (n0 + n < N) { const unsigned* t = scr + (4 * c) * 68 + n;
        const u32x4 v = {t[0], t[68], t[136], t[204]};
        *(u32x4*)(WT + (size_t)map(n0 + n) * K + k0 + 8 * c) = v; } }
    asm volatile("s_waitcnt vmcnt(0) lgkmcnt(0)" ::: "memory");
}
struct MapId { __device__ int operator()(int n) const { return n; } };
struct MapGate { __device__ int operator()(int n) const { return gu_row_gate(n); } };
struct MapUp { __device__ int operator()(int n) const { return gu_row_gate(n) + 128; } };
struct MapWin { __device__ int operator()(int n) const { return win_row(n); } };
struct MapWuq { __device__ int operator()(int n) const { return wuq_row(n); } };
struct MapWukv { __device__ int operator()(int n) const { return wukv_row(n); } };

__device__ __constant__ double INV_FREQ[16] = {1.0, 0.5623413251903491, 0.31622776601683794, 0.1778279410038923, 0.1, 0.05623413251903491, 0.03162277660168379, 0.01778279410038923,
                                               0.01, 0.005623413251903491, 0.0031622776601683794, 0.0017782794100389228, 0.001, 0.0005623413251903491, 0.00031622776601683794, 0.00017782794100389227};
__device__ __forceinline__ void sincos_d(double x, float& s, float& c) {
    const double k = rint(x * 0.15915494309189535); const double r = fma(-k, 6.283185307179586, x) - k * 2.4492935982947064e-16; const double r2 = r * r;
    double ss = 1.0 / 15511210043330985984000000.0, cc = 1.0 / 620448401733239439360000.0;
    const double sf[12] = {1.0 / 25852016738884976640000.0, 1.0 / 51090942171709440000.0, 1.0 / 121645100408832000.0, 1.0 / 355687428096000.0, 1.0 / 1307674368000.0, 1.0 / 6227020800.0, 1.0 / 39916800.0,
                           1.0 / 362880.0, 1.0 / 5040.0, 1.0 / 120.0, 1.0 / 6.0, 1.0};
    const double cf[12] = {1.0 / 1124000727777607680000.0, 1.0 / 2432902008176640000.0, 1.0 / 6402373705728000.0, 1.0 / 20922789888000.0, 1.0 / 87178291200.0, 1.0 / 479001600.0, 1.0 / 3628800.0,
                           1.0 / 40320.0, 1.0 / 720.0, 1.0 / 24.0, 1.0 / 2.0, 1.0};
#pragma unroll
    for (int i = 0; i < 12; ++i) { ss = fma(-ss, r2, sf[i]); cc = fma(-cc, r2, cf[i]); }
    s = (float)(ss * r); c = (float)cc;
}
__device__ __forceinline__ void rms_row_to_bf16(const float* xrow, bf16_t* orow, int lane) {
    const f32x4* xr = (const f32x4*)xrow + lane; f32x4 v[4]; float s = 0.f;
#pragma unroll
    for (int j = 0; j < 4; ++j) { v[j] = xr[64 * j]; s += (v[j].x * v[j].x + v[j].y * v[j].y) + (v[j].z * v[j].z + v[j].w * v[j].w); }
    const float rstd = 1.0f / sqrtf(wave_sum(s) * (1.f / D) + EPS);
    unsigned long long* o8 = (unsigned long long*)orow + lane;
#pragma unroll
    for (int j = 0; j < 4; ++j) o8[64 * j] = (unsigned long long)pk2(v[j].x * rstd, v[j].y * rstd) | ((unsigned long long)pk2(v[j].z * rstd, v[j].w * rstd) << 32);
}
__device__ __forceinline__ void rms_row2_to_bf16(const float* x0, const float* x1, bf16_t* o0, bf16_t* o1, int lane) {
    const f32x4* xa = (const f32x4*)x0 + lane; const f32x4* xb = (const f32x4*)x1 + lane; f32x4 va[4], vb[4]; float sa = 0.f, sb = 0.f;
#pragma unroll
    for (int j = 0; j < 4; ++j) { va[j] = xa[64 * j]; vb[j] = xb[64 * j]; }
#pragma unroll
    for (int j = 0; j < 4; ++j) { sa += (va[j].x * va[j].x + va[j].y * va[j].y) + (va[j].z * va[j].z + va[j].w * va[j].w); sb += (vb[j].x * vb[j].x + vb[j].y * vb[j].y) + (vb[j].z * vb[j].z + vb[j].w * vb[j].w); }
    const float ra = 1.0f / sqrtf(wave_sum(sa) * (1.f / D) + EPS), rb = 1.0f / sqrtf(wave_sum(sb) * (1.f / D) + EPS);
    unsigned long long* pa = (unsigned long long*)o0 + lane; unsigned long long* pb = (unsigned long long*)o1 + lane;
#pragma unroll
    for (int j = 0; j < 4; ++j) { pa[64 * j] = (unsigned long long)pk2(va[j].x * ra, va[j].y * ra) | ((unsigned long long)pk2(va[j].z * ra, va[j].w * ra) << 32);
                                  pb[64 * j] = (unsigned long long)pk2(vb[j].x * rb, vb[j].y * rb) | ((unsigned long long)pk2(vb[j].z * rb, vb[j].w * rb) << 32); }
}
template <int NR> __device__ __forceinline__ void rms_rows_load(const float* x, const int (&r)[NR], f32x4 (&v)[NR][4], int lane) {
#pragma unroll
    for (int i = 0; i < NR; ++i) { const f32x4* p = (const f32x4*)(x + (size_t)r[i] * D) + lane;
#pragma unroll
        for (int j = 0; j < 4; ++j) v[i][j] = p[64 * j]; }
}
template <int NR> __device__ __forceinline__ void rms_rows_finish(bf16_t* out, const int (&r)[NR], const f32x4 (&v)[NR][4], int lane) {
#pragma unroll
    for (int i = 0; i < NR; ++i) { float s = 0.f;
#pragma unroll
        for (int j = 0; j < 4; ++j) s += (v[i][j].x * v[i][j].x + v[i][j].y * v[i][j].y) + (v[i][j].z * v[i][j].z + v[i][j].w * v[i][j].w);
        const float rs = 1.0f / sqrtf(wave_sum(s) * (1.f / D) + EPS); unsigned long long* po = (unsigned long long*)(out + (size_t)r[i] * D) + lane;
#pragma unroll
        for (int j = 0; j < 4; ++j) po[64 * j] = (unsigned long long)pk2(v[i][j].x * rs, v[i][j].y * rs) | ((unsigned long long)pk2(v[i][j].z * rs, v[i][j].w * rs) << 32); }
}
constexpr int I_GU = (D / 64) * (FF / 64), I_DN = (FF / 64) * (D / 64), I_IN = (D / 64) * ((1960 + 63) / 64), I_OUT = (D / 64) * (D / 64), I_UQ = (256 / 64) * (768 / 64), I_UKV = (128 / 64) * (1024 / 64);
__device__ __forceinline__ void p0_prologue(const Ctx& C, float* scr, int gw, int gwi, int NGW, int lane) {
    const bool fast = NGW * 8 == M;
    f32x4 va[2][4]; const int ra[2] = {gw, gw + M / 2};
    if (fast) rms_rows_load<2>(C.x, ra, va, lane);
    for (int it = gwi; it < 2 * I_GU + I_DN + I_IN; it += NGW) {
        int r = it;
        if (r < I_GU) { p0_transpose_item(C.w1g, D, FF, C.g_ffn1, C.W1GU, MapGate(), scr, r, lane); continue; } r -= I_GU;
        if (r < I_GU) { p0_transpose_item(C.w1u, D, FF, C.g_ffn1, C.W1GU, MapUp(), scr, r, lane); continue; } r -= I_GU;
        if (r < I_DN) { p0_transpose_item(C.w1d, FF, D, nullptr, C.W1D, MapId(), scr, r, lane); continue; } r -= I_DN;
        p0_transpose_item(C.w_in, D, 1960, C.g_mix, C.WIN, MapWin(), scr, r, lane);
    }
    for (int i = gw * 64 + lane; i < 88 * 128; i += NGW * 64) { const int row = 256 + 168 + i / 128, ch = i % 128; *(u32x4*)(C.WIN + (size_t)row * D + ch * 8) = (u32x4){0u, 0u, 0u, 0u}; }
    if (fast) { f32x4 vb[4][4], vc[2][4]; const int rb[4] = {gw + NGW, gw + NGW + M / 2, gw + 2 * NGW, gw + 2 * NGW + M / 2}, rc[2] = {gw + 3 * NGW, gw + 3 * NGW + M / 2};
        rms_rows_load<4>(C.x, rb, vb, lane); rms_rows_finish<2>((bf16_t*)C.main.XN1, ra, va, lane);
        rms_rows_load<2>(C.x, rc, vc, lane); rms_rows_finish<4>((bf16_t*)C.main.XN1, rb, vb, lane); rms_rows_finish<2>((bf16_t*)C.main.XN1, rc, vc, lane); }
    else for (int m = gw; m < M / 2; m += NGW) rms_row2_to_bf16(C.x + (size_t)m * D, C.x + (size_t)(m + M / 2) * D, (bf16_t*)C.main.XN1 + (size_t)m * D, (bf16_t*)C.main.XN1 + (size_t)(m + M / 2) * D, lane);
    for (int m = gw; m < NMETA; m += NGW) rms_row_to_bf16(C.meta + (size_t)m * D, (bf16_t*)C.mt.XN1 + (size_t)m * D, lane);
    for (int i = gw * 64 + lane; i < NPOS * 16; i += NGW * 64) { const int pos = i >> 4, f = i & 15; float s, c; sincos_d((double)pos * INV_FREQ[f], s, c); C.ROPE[2 * i] = c; C.ROPE[2 * i + 1] = s; }
}
template <int PART> __device__ __forceinline__ void p0_late(const Ctx& C, float* scr, int gw, int NGW, int lane) {
    if (PART == 0) {
        for (int it = gw; it < I_OUT + I_UQ + I_UKV; it += NGW) {
            int r = it;
            if (r < I_OUT) { p0_transpose_item(C.w_out, D, D, nullptr, C.WOUT, MapId(), scr, r, lane); continue; } r -= I_OUT;
            if (r < I_UQ) { p0_transpose_item(C.w_uq, 256, 768, C.g_cq, C.WUQ, MapWuq(), scr, r, lane); continue; } r -= I_UQ;
            p0_transpose_item(C.w_ukv, 128, 1024, C.g_ckv, C.WUKV, MapWukv(), scr, r, lane);
        }
    } else {
        for (int it = gw; it < 2 * I_GU + I_DN; it += NGW) {
            int r = it;
            if (r < I_GU) { p0_transpose_item(C.w2g, D, FF, C.g_ffn2, C.W2GU, MapGate(), scr, r, lane); continue; } r -= I_GU;
            if (r < I_GU) { p0_transpose_item(C.w2u, D, FF, C.g_ffn2, C.W2GU, MapUp(), scr, r, lane); continue; } r -= I_GU;
            p0_transpose_item(C.w2d, FF, D, nullptr, C.W2D, MapId(), scr, r, lane);
        }
    }
}

template <int NT, int UNR>
__device__ __forceinline__ void wg_gemm16_steps(const bf16_t* ap, const bf16_t* const (&bp)[NT], int k0, f32x4 (&acc)[NT]) {
    bf16x8 a[UNR], b[UNR][NT];
#pragma unroll
    for (int u = 0; u < UNR; ++u) { a[u] = *(const bf16x8*)(ap + k0 + 32 * u);
#pragma unroll
        for (int t = 0; t < NT; ++t) b[u][t] = *(const bf16x8*)(bp[t] + k0 + 32 * u); }
#pragma unroll
    for (int u = 0; u < UNR; ++u)
#pragma unroll
        for (int t = 0; t < NT; ++t) acc[t] = __builtin_amdgcn_mfma_f32_16x16x32_bf16(a[u], b[u][t], acc[t], 0, 0, 0);
}
template <int NT, int NSPLIT, int UNR>
__device__ __forceinline__ void wg_gemm16(const bf16_t* ap, const bf16_t* const (&bp)[NT], int K, f32x4 (&acc)[NT], int wave, int lane, float* red) {
    const int ksl = K / NSPLIT, kb = wave * ksl, ke = kb + ksl;
    if (wave < NSPLIT) {
        int k0 = kb;
        for (; k0 + 32 * UNR <= ke; k0 += 32 * UNR) wg_gemm16_steps<NT, UNR>(ap, bp, k0, acc);
        { const int r = (ke - k0) >> 5;
          if (UNR > 3 && r == 3) wg_gemm16_steps<NT, 3>(ap, bp, k0, acc); else if (UNR > 2 && r == 2) wg_gemm16_steps<NT, 2>(ap, bp, k0, acc); else for (; k0 < ke; k0 += 32) wg_gemm16_steps<NT, 1>(ap, bp, k0, acc); }
#pragma unroll
        for (int t = 0; t < NT; ++t) *(f32x4*)(red + (size_t)((wave * NT + t) * 64 + lane) * 4) = acc[t];
    }
    __syncthreads();
    if (wave == 0) {
#pragma unroll
        for (int t = 0; t < NT; ++t) { f32x4 sum = *(const f32x4*)(red + (size_t)(t * 64 + lane) * 4);
#pragma unroll
            for (int w = 1; w < NSPLIT; ++w) sum += *(const f32x4*)(red + (size_t)((w * NT + t) * 64 + lane) * 4);
            acc[t] = sum; asm volatile("" ::: "memory"); }
    }
}
__device__ __forceinline__ void task_gateup(const bf16_t* A, const bf16_t* Wgu, const float* ssq, bf16_t* HB, int task, int lane, int wave, float* red) {
    asm volatile("" : "+v"(lane));
    const int ncb = FF / 16, rg = task / ncb, cb = task % ncb, c = lane & 15, q = lane >> 4, hc = cb * 16 + c;
    const bf16_t* ap = A + (size_t)(rg * 16 + c) * D + 8 * q;
    const bf16_t* g0 = Wgu + (size_t)gu_row_gate(hc) * D + 8 * q;
    const bf16_t* const bp[2] = {g0, g0 + (size_t)128 * D};
    f32x4 acc[2]; acc[0] = (f32x4){0.f, 0.f, 0.f, 0.f}; acc[1] = acc[0];
    wg_gemm16<2, 8, 4>(ap, bp, D, acc, wave, lane, red); if (wave != 0) return;
#pragma unroll
    for (int i = 0; i < 4; ++i) { const int row = rg * 16 + 4 * q + i; const float rs = ssq ? 1.0f / sqrtf(sum16f(ssq + (size_t)row * 16) * (1.f / D) + EPS) : 1.f;
        st_wt(HB + (size_t)row * FF + hc, (bf16_t)f2bf(silu_mul(acc[0][i] * rs, acc[1][i] * rs))); }
}
__device__ __forceinline__ void task_down(const bf16_t* A, int K, const bf16_t* Wt, const float* base, float* out, float scale, bf16_t* XN, float* SSQ, int task, int lane, int wave, float* red) {
    asm volatile("" : "+v"(lane));
    const int rg = task >> 4, cb = task & 15, c = lane & 15, q = lane >> 4;
    const bf16_t* ap = A + (size_t)(rg * 16 + c) * K + 8 * q;
    const bf16_t* b0 = Wt + (size_t)(cb * 64 + c) * K + 8 * q;
    const bf16_t* const bp[4] = {b0, b0 + (size_t)16 * K, b0 + (size_t)32 * K, b0 + (size_t)48 * K};
    f32x4 acc[4];
#pragma unroll
    for (int t = 0; t < 4; ++t) acc[t] = (f32x4){0.f, 0.f, 0.f, 0.f};
    wg_gemm16<4, 8, 4>(ap, bp, K, acc, wave, lane, red); if (wave != 0) return;
#pragma unroll
    for (int i = 0; i < 4; ++i) { const int row = rg * 16 + 4 * q + i; float sq = 0.f;
#pragma unroll
        for (int t = 0; t < 4; ++t) { const size_t o = (size_t)row * D + cb * 64 + t * 16 + c; const float v = base[o] + scale * acc[t][i]; st_wt(out + o, v); if (XN) st_wt(XN + o, (bf16_t)f2bf(v)); sq += v * v; }
        sq = rsum16(sq); if (SSQ && c == 0) st_wt(SSQ + (size_t)row * 16 + cb, sq); }
}
__device__ __forceinline__ void task_win(const Ctx& C, const RowSet& R, int rg, int job, int lane, int wave, float* red) {
    asm volatile("" : "+v"(lane));
    const int c = lane & 15, q = lane >> 4;
    const bf16_t* ap = R.XN + (size_t)(rg * 16 + c) * D + 8 * q;
    if (job == 0) {
        const bf16_t* bp[8];
#pragma unroll
        for (int t = 0; t < 8; ++t) bp[t] = C.WIN + (size_t)win_row(256 + 16 * t + c) * D + 8 * q;
        f32x4 acc[8];
#pragma unroll
        for (int t = 0; t < 8; ++t) acc[t] = (f32x4){0.f, 0.f, 0.f, 0.f};
        wg_gemm16<8, 8, 2>(ap, bp, D, acc, wave, lane, red); if (wave != 0) return;
#pragma unroll
        for (int i = 0; i < 4; ++i) { const int row = rg * 16 + 4 * q + i; const float rs = 1.0f / sqrtf(sum16f(R.SSQ1 + (size_t)row * 16) * (1.f / D) + EPS); float sq = 0.f;
#pragma unroll
            for (int t = 0; t < 8; ++t) { const float v = acc[t][i] * rs; sq += v * v; R.CKV[(size_t)row * 128 + 16 * t + c] = (bf16_t)f2bf(v); }
            sq = rsum16(sq); if (c == 0) *(f32x4*)(R.SSQCKV + (size_t)row * 4) = (f32x4){sq, 0.f, 0.f, 0.f}; }
    } else if (job == 1) {
        const bf16_t* bp[3];
#pragma unroll
        for (int t = 0; t < 2; ++t) bp[t] = C.WIN + (size_t)win_row(384 + 16 * t + c) * D + 8 * q;
        bp[2] = C.WIN + (size_t)(c < 8 ? win_row(1952 + c) : 256 + 168 + c) * D + 8 * q;
        f32x4 acc[3];
#pragma unroll
        for (int t = 0; t < 3; ++t) acc[t] = (f32x4){0.f, 0.f, 0.f, 0.f};
        wg_gemm16<3, 8, 4>(ap, bp, D, acc, wave, lane, red); if (wave != 0) return;
#pragma unroll
        for (int i = 0; i < 4; ++i) { const int row = rg * 16 + 4 * q + i; const float rs = 1.0f / sqrtf(sum16f(R.SSQ1 + (size_t)row * 16) * (1.f / D) + EPS); float sp = 0.f;
#pragma unroll
            for (int t = 0; t < 2; ++t) { const float v = acc[t][i] * rs; sp += v * v; R.KPE[(size_t)row * 32 + 16 * t + c] = v; }
            sp = rsum16(sp); if (c == 0) R.SSQKPE[row] = sp;
            if (c < 8) R.LOGF[(size_t)row * 8 + c] = log_sigmoid(acc[2][i] * rs + C.b_forget[c]); }
    } else {
        const int which = 1 + ((job - 2) >> 3), h = (job - 2) & 7;
        const bf16_t* bp[4];
#pragma unroll
        for (int t = 0; t < 4; ++t) bp[t] = C.WIN + (size_t)win_row(416 + which * 512 + h * 64 + 16 * t + c) * D + 8 * q;
        f32x4 acc[4];
#pragma unroll
        for (int t = 0; t < 4; ++t) acc[t] = (f32x4){0.f, 0.f, 0.f, 0.f};
        wg_gemm16<4, 8, 4>(ap, bp, D, acc, wave, lane, red); if (wave != 0) return;
#pragma unroll
        for (int i = 0; i < 4; ++i) { const int row = rg * 16 + 4 * q + i; const float rs = 1.0f / sqrtf(sum16f(R.SSQ1 + (size_t)row * 16) * (1.f / D) + EPS); float sq = 0.f; float v[4];
#pragma unroll
            for (int t = 0; t < 4; ++t) { v[t] = acc[t][i] * rs; sq += v[t] * v[t]; }
            sq = rsum16(sq); const float r = 1.0f / sqrtf(sq * (1.f / 64.f) + EPS);
#pragma unroll
            for (int t = 0; t < 4; ++t) { const int d = 16 * t + c;
                if (which == 1) C.MFK[(row * 8 + h) * 64 + d] = (bf16_t)f2bf(v[t] * r * C.g_k_fox[d]);
                else C.MFV[(row * 8 + h) * 64 + d] = (bf16_t)f2bf(v[t]); } }
    }
}
__device__ __forceinline__ void task_uqkv(const Ctx& C, const RowSet& R, int task, int lane, int wave, float* red) {
    asm volatile("" : "+v"(lane));
    const int rg = task >> 4, job = task & 15, h = job & 7, c = lane & 15, q = lane >> 4;
    int rows[4];
#pragma unroll
    for (int i = 0; i < 4; ++i) rows[i] = rg * 16 + 4 * q + i;
    {
        const bf16_t* ap = R.CKV + (size_t)(rg * 16 + c) * 128 + 8 * q;
        const bf16_t* bp[8];
#pragma unroll
        for (int t = 0; t < 8; ++t) bp[t] = C.WUKV + (size_t)wukv_row(h * 128 + 16 * t + c) * 128 + 8 * q;
        f32x4 acc[8];
#pragma unroll
        for (int t = 0; t < 8; ++t) acc[t] = (f32x4){0.f, 0.f, 0.f, 0.f};
        wg_gemm16<8, 4, 1>(ap, bp, 128, acc, wave, lane, red); if (wave != 0) return;
#pragma unroll
        for (int i = 0; i < 4; ++i) { const int row = rows[i]; const float rs = 1.0f / sqrtf(sum4f(R.SSQCKV + (size_t)row * 4) * (1.f / 128.f) + EPS);
            float v[8], s0 = 0.f;
#pragma unroll
            for (int t = 0; t < 8; ++t) { v[t] = acc[t][i] * rs; if (t < 4) s0 += v[t] * v[t]; }
            s0 = rsum16(s0); const float rk = 1.0f / sqrtf((s0 + R.SSQKPE[row]) * (1.f / 96.f) + EPS);
            const int p = R.meta ? 48 + row : 64 + (row & (T - 1)); const int b0 = R.meta ? 0 : row >> 13, b1 = R.meta ? 2 : b0 + 1;
            const float cs = C.ROPE[(size_t)(p - 48) * 32 + 2 * c], sn = C.ROPE[(size_t)(p - 48) * 32 + 2 * c + 1];
            const float x1 = R.KPE[(size_t)row * 32 + c] * rk * C.g_k_mla[64 + c], x2 = R.KPE[(size_t)row * 32 + 16 + c] * rk * C.g_k_mla[80 + c];
            for (int b = b0; b < b1; ++b) {
#pragma unroll
                for (int t = 0; t < 4; ++t) { C.KM[kaddr(b, h, p, 16 * t + c, DQM)] = (bf16_t)f2bf(v[t] * rk * C.g_k_mla[16 * t + c]); C.VM[vaddr(b, h, p, 16 * t + c)] = (bf16_t)f2bf(v[4 + t]); }
                C.KM[kaddr(b, h, p, 64 + c, DQM)] = (bf16_t)f2bf(x1 * cs - x2 * sn); C.KM[kaddr(b, h, p, 80 + c, DQM)] = (bf16_t)f2bf(x2 * cs + x1 * sn); } }
    }
}


namespace pg8 {
#define PG8_LAS __attribute__((address_space(3)))
typedef unsigned short bf16_t;
typedef short bf16x8 __attribute__((ext_vector_type(8)));
typedef float f32x4 __attribute__((ext_vector_type(4)));
typedef unsigned u32x4 __attribute__((ext_vector_type(4)));
constexpr int BM = 256, BK = 64, HALF = 128, HTB = HALF * BK * 2  , STAGE_BYTES = 8 * HTB, NXCD = 8, WGM = 8;

__host__ __device__ __forceinline__ int lds_byte(int r, int c) { const int st = (r >> 4) * 2 + (c >> 5), rr = r & 15, cc = c & 31, ob = rr * 64 + cc * 2; return st * 1024 + (ob ^ (((ob >> 9) & 1) << 5)); }
__host__ __device__ __forceinline__ void stage_rc(int b, int& R, int& C) { const int st = b / 1024, sb = b % 1024, swz = sb ^ (((sb >> 9) & 1) << 5); R = (st >> 1) * 16 + swz / 64; C = (st & 1) * 32 + (swz % 64) / 2; }
__host__ __device__ __forceinline__ int perm32(int rho) { const int n = rho >> 4, i = rho & 15; return 8 * (i >> 2) + 4 * n + (i & 3); }

struct Unit { int pm, pn, idx; };
struct Gemm { const bf16_t* A; const bf16_t* Bt; int M, N, K, lda; };

struct StaticOrder {
    int nM, nN, nwg, G, c, off, cnt;
    __host__ __device__ void init(int M, int N, int G_, int c_) { nM = M / BM; nN = N / BM; nwg = nM * nN; G = G_; c = c_; off = 0; cnt = 1 << 20; }
    __host__ __device__ bool next(int i, Unit& u) const {
        if (i >= cnt) return false; i += off;
        const long L = (long)i * G + c; if (L >= nwg) return false;
        int wgid = (int)L; { const int q = nwg / NXCD, r = nwg % NXCD, xcd = wgid % NXCD, off = wgid / NXCD; wgid = (xcd < r ? xcd * (q + 1) : r * (q + 1) + (xcd - r) * q) + off; }
        const int nig = WGM * nN, gid = wgid / nig, fm = gid * WGM, gsz = (nM - fm) < WGM ? (nM - fm) : WGM;
        u.pm = fm + ((wgid % nig) % gsz); u.pn = (wgid % nig) / gsz; u.idx = i; return true;
    }
    __device__ __forceinline__ void a_ready(const Unit&) const {}
    __device__ __forceinline__ void done(const Unit&) const {}
};
__device__ __forceinline__ unsigned cvt_pk_bf16(float lo, float hi) { unsigned r; asm volatile("v_cvt_pk_bf16_f32 %0, %1, %2" : "=v"(r) : "v"(lo), "v"(hi)); return r; }
typedef float f32x2 __attribute__((ext_vector_type(2)));
template <class Epi, class Sched, bool ALIGN_EPI = false, bool SP2 = false>
__device__ __forceinline__ void gemm_phase(PG8_LAS unsigned char* lds, const Gemm g, const Sched& S, const Epi& E, const int tid) {
    const int wid = __builtin_amdgcn_readfirstlane(tid >> 6), lane = tid & 63, wr = wid >> 2, wc = wid & 3, fr = lane & 15, fq = lane >> 4;
    const int K = g.K, nt = K / BK;
    unsigned voffA[2], voffB[2];
#pragma unroll
    for (int i = 0; i < 2; ++i) { int R, C; stage_rc(tid * 16 + i * 8192, R, C); const int Rb = Epi::PERM ? ((R & ~31) + perm32(R & 31)) : R;
        voffA[i] = (unsigned)(R * g.lda + C) * 2u; voffB[i] = (unsigned)(Rb * K + C) * 2u; }
    const size_t kstep = (size_t)(BK * 2);
    const size_t hstep = (size_t)HALF * K * 2, hstepA = (size_t)HALF * g.lda * 2;
    const size_t tstep = 2 * hstep, tstepA = 2 * hstepA;
    const unsigned ldsw = (unsigned)wid * 1024u;
    const int aoff = lds_byte(wr * 64 + fr, fq * 8), boff = lds_byte(wc * 32 + fr, fq * 8);
#define PG8_SA(b, h) (((b) * 2 + (h)) * HTB)
#define PG8_SB(b, h) ((4 + (b) * 2 + (h)) * HTB)
#define PG8_STAGE(bufoff, gbase, voff) do { _Pragma("unroll") for (int _i = 0; _i < 2; ++_i) \
        __builtin_amdgcn_global_load_lds((const unsigned*)((const char*)(gbase) + (voff)[_i]), (PG8_LAS unsigned*)(lds + (bufoff) + ldsw + _i * 8192), 16, 0, 0); } while (0)
#define PG8_LDA(dst, b, h) do { _Pragma("unroll") for (int m = 0; m < 4; ++m) _Pragma("unroll") for (int k = 0; k < 2; ++k) dst[m][k] = *(const PG8_LAS bf16x8*)(lds + PG8_SA(b, h) + aoff + m * 2048 + k * 1024); } while (0)
#define PG8_LDB(dst, b, h) do { _Pragma("unroll") for (int n = 0; n < 2; ++n) _Pragma("unroll") for (int k = 0; k < 2; ++k) dst[n][k] = *(const PG8_LAS bf16x8*)(lds + PG8_SB(b, h) + boff + n * 2048 + k * 1024); } while (0)
#define PG8_MMA(ai, bj, At, Bt) do { __builtin_amdgcn_s_setprio(1); _Pragma("unroll") for (int m = 0; m < 4; ++m) _Pragma("unroll") for (int n = 0; n < 2; ++n) _Pragma("unroll") for (int k = 0; k < 2; ++k) \
        acc[ai][bj][m][n] = __builtin_amdgcn_mfma_f32_16x16x32_bf16(Bt[n][k], At[m][k], acc[ai][bj][m][n], 0, 0, 0); __builtin_amdgcn_s_setprio(0); } while (0)
#define PG8_WAIT_V(n) asm volatile("s_waitcnt vmcnt(" #n ")" ::: "memory")
#define PG8_WAIT_L(n) asm volatile("s_waitcnt lgkmcnt(" #n ")" ::: "memory")
#define PG8_BAR __builtin_amdgcn_s_barrier()
#define PG8_SCHED __builtin_amdgcn_sched_barrier(0)
    Unit cur, nxt; int ui = 0;
    if (!S.next(0, cur)) return;
    f32x4 acc[2][2][4][2];
#pragma unroll
    for (int a = 0; a < 2; ++a)
#pragma unroll
        for (int b = 0; b < 2; ++b)
#pragma unroll
            for (int m = 0; m < 4; ++m)
#pragma unroll
                for (int n = 0; n < 2; ++n) acc[a][b][m][n] = (f32x4){0.f, 0.f, 0.f, 0.f};
    if constexpr (Epi::HAS_INIT) E.init(acc, cur, wr, wc, fr, fq);
    bf16x8 At[4][2], B0[2][2], B1[2][2];
    const char* cA = (const char*)g.A + (size_t)cur.pm * tstepA; const char* cB = (const char*)g.Bt + (size_t)cur.pn * tstep;
    S.a_ready(cur);
    if constexpr (SP2) {
        PG8_STAGE(PG8_SB(0, 0), cB, voffB); PG8_STAGE(PG8_SB(0, 1), cB + hstep, voffB); PG8_STAGE(PG8_SA(0, 0), cA, voffA); PG8_STAGE(PG8_SA(0, 1), cA + hstepA, voffA);
        if (wr == 1) PG8_BAR;
        PG8_WAIT_V(2); PG8_BAR;
        PG8_STAGE(PG8_SB(1, 0), cB + kstep, voffB); PG8_STAGE(PG8_SA(1, 0), cA + kstep, voffA); PG8_STAGE(PG8_SB(1, 1), cB + hstep + kstep, voffB);
        PG8_WAIT_V(6); PG8_BAR;
    } else {
        PG8_STAGE(PG8_SB(0, 0), cB, voffB); PG8_STAGE(PG8_SA(0, 0), cA, voffA); PG8_STAGE(PG8_SB(0, 1), cB + hstep, voffB); PG8_STAGE(PG8_SA(0, 1), cA + hstepA, voffA);
        if (wr == 1) PG8_BAR;
        PG8_WAIT_V(4); PG8_BAR;
        PG8_STAGE(PG8_SB(1, 0), cB + kstep, voffB); PG8_STAGE(PG8_SA(1, 0), cA + kstep, voffA); PG8_STAGE(PG8_SB(1, 1), cB + hstep + kstep, voffB);
        PG8_WAIT_V(6); PG8_BAR;
    }
    for (;;) {
        const bool has_next = S.next(ui + 1, nxt);
        const char* nA = has_next ? (const char*)g.A + (size_t)nxt.pm * tstepA : cA; const char* nB = has_next ? (const char*)g.Bt + (size_t)nxt.pn * tstep : cB;
        for (int t = 0; t < nt; t += 2) {
            const bool last = (t == nt - 2);
            const char* a1 = cA + (size_t)(t + 1) * kstep;
            const char* a2 = last ? nA : cA + (size_t)(t + 2) * kstep; const char* b2 = last ? nB : cB + (size_t)(t + 2) * kstep;
            const char* a3 = a2 + kstep; const char* b3 = b2 + kstep;
            if (last && has_next) S.a_ready(nxt);
            if constexpr (SP2) {
            PG8_LDB(B0, 0, 0); PG8_LDB(B1, 0, 1); PG8_SCHED; PG8_LDA(At, 0, 0); PG8_STAGE(PG8_SA(1, 1), a1 + hstepA, voffA);
            PG8_WAIT_V(8); PG8_WAIT_L(0); PG8_BAR; PG8_MMA(0, 0, At, B0); PG8_MMA(0, 1, At, B1); PG8_BAR; PG8_SCHED;
            PG8_LDA(At, 0, 1); PG8_STAGE(PG8_SB(0, 0), b2, voffB); PG8_STAGE(PG8_SB(0, 1), b2 + hstep, voffB); PG8_STAGE(PG8_SA(0, 0), a2, voffA);
            PG8_WAIT_V(8); PG8_WAIT_L(0); PG8_BAR; PG8_MMA(1, 0, At, B0); PG8_MMA(1, 1, At, B1); PG8_BAR; PG8_SCHED;
            PG8_LDB(B0, 1, 0); PG8_LDB(B1, 1, 1); PG8_SCHED; PG8_LDA(At, 1, 0); PG8_STAGE(PG8_SA(0, 1), a2 + hstepA, voffA);
            PG8_WAIT_V(8); PG8_WAIT_L(0); PG8_BAR; PG8_MMA(0, 0, At, B0); PG8_MMA(0, 1, At, B1); PG8_BAR; PG8_SCHED;
            PG8_LDA(At, 1, 1); PG8_STAGE(PG8_SB(1, 0), b3, voffB); PG8_STAGE(PG8_SB(1, 1), b3 + hstep, voffB); PG8_STAGE(PG8_SA(1, 0), a3, voffA);
            PG8_WAIT_V(8); PG8_WAIT_L(0); PG8_BAR; PG8_MMA(1, 0, At, B0); PG8_MMA(1, 1, At, B1); PG8_BAR; PG8_SCHED;
            } else {
            PG8_LDB(B0, 0, 0); PG8_SCHED; PG8_LDA(At, 0, 0); PG8_STAGE(PG8_SA(1, 1), a1 + hstepA, voffA);
            PG8_WAIT_L(8); PG8_BAR; PG8_WAIT_L(0); PG8_MMA(0, 0, At, B0); PG8_BAR; PG8_SCHED;
            PG8_LDB(B1, 0, 1); PG8_STAGE(PG8_SB(0, 0), b2, voffB);
            PG8_BAR; PG8_WAIT_L(0); PG8_MMA(0, 1, At, B1); PG8_BAR;
            PG8_LDA(At, 0, 1); PG8_STAGE(PG8_SA(0, 0), a2, voffA);
            PG8_BAR; PG8_WAIT_L(0); PG8_MMA(1, 0, At, B0); PG8_BAR; PG8_SCHED;
            PG8_STAGE(PG8_SB(0, 1), b2 + hstep, voffB);
            PG8_WAIT_V(6); PG8_BAR; PG8_MMA(1, 1, At, B1); PG8_BAR;
            PG8_LDB(B0, 1, 0); PG8_SCHED; PG8_LDA(At, 1, 0); PG8_STAGE(PG8_SA(0, 1), a2 + hstepA, voffA);
            PG8_WAIT_L(8); PG8_BAR; PG8_WAIT_L(0); PG8_MMA(0, 0, At, B0); PG8_BAR; PG8_SCHED;
            PG8_LDB(B1, 1, 1); PG8_STAGE(PG8_SB(1, 0), b3, voffB);
            PG8_BAR; PG8_WAIT_L(0); PG8_MMA(0, 1, At, B1); PG8_BAR;
            PG8_LDA(At, 1, 1); PG8_STAGE(PG8_SA(1, 0), a3, voffA);
            PG8_BAR; PG8_WAIT_L(0); PG8_MMA(1, 0, At, B0); PG8_BAR; PG8_SCHED;
            PG8_STAGE(PG8_SB(1, 1), b3 + hstep, voffB);
            PG8_WAIT_V(6); PG8_BAR; PG8_MMA(1, 1, At, B1); PG8_BAR;
            }
        }
        if constexpr (ALIGN_EPI) { if (wr == 0) PG8_BAR; }
        if constexpr (!Epi::AFTER_DRAIN) { E(acc, cur, wr, wc, fr, fq); S.done(cur); }
        if (!has_next) break;
#pragma unroll
        for (int a = 0; a < 2; ++a)
#pragma unroll
            for (int b = 0; b < 2; ++b)
#pragma unroll
                for (int m = 0; m < 4; ++m)
#pragma unroll
                    for (int n = 0; n < 2; ++n) acc[a][b][m][n] = (f32x4){0.f, 0.f, 0.f, 0.f};
        if constexpr (Epi::HAS_INIT) E.init(acc, nxt, wr, wc, fr, fq);
        cur = nxt; cA = nA; cB = nB; ++ui;
        if constexpr (ALIGN_EPI) { if (wr == 1) PG8_BAR; }
    }
    PG8_WAIT_V(0);
    if constexpr (!ALIGN_EPI) { if (wr == 0) PG8_BAR; }
    PG8_BAR;
    if constexpr (Epi::AFTER_DRAIN) { E.fused(acc, cur, wr, wc, fr, fq, lds, wid, lane); S.done(cur); }
#undef PG8_SA
#undef PG8_SB
#undef PG8_STAGE
#undef PG8_LDA
#undef PG8_LDB
#undef PG8_MMA
#undef PG8_WAIT_V
#undef PG8_WAIT_L
#undef PG8_BAR
#undef PG8_SCHED
}
}

namespace pg8 {
__device__ __forceinline__ float fq_sum(float v) { v += __shfl_xor(v, 16); v += __shfl_xor(v, 32); return v; }
__device__ __forceinline__ u32x4 pack8(const f32x4& a, const f32x4& b) { u32x4 w; w.x = cvt_pk_bf16(a[0], a[1]); w.y = cvt_pk_bf16(a[2], a[3]); w.z = cvt_pk_bf16(b[0], b[1]); w.w = cvt_pk_bf16(b[2], b[3]); return w; }
__device__ __forceinline__ f32x4 silu4(const f32x4& g, const f32x4& u) { f32x4 o;
#pragma unroll
    for (int j = 0; j < 4; ++j) o[j] = g[j] * __builtin_amdgcn_rcpf(1.0f + __builtin_amdgcn_exp2f(-LOG2E * g[j])) * u[j];
    return o; }

template <int NP> __device__ __forceinline__ void rs_rows(const float* ssq, int row0, int fq, float inv_n, float (&rs)[2][4]) {
    f32x4 t[2][4];
#pragma unroll
    for (int ai = 0; ai < 2; ++ai)
#pragma unroll
        for (int m = 0; m < 4; ++m) t[ai][m] = *(const f32x4*)(ssq + (size_t)(row0 + ai * HALF + m * 16) * NP + (NP == 16 ? 4 * fq : 0));
#pragma unroll
    for (int ai = 0; ai < 2; ++ai)
#pragma unroll
        for (int m = 0; m < 4; ++m) { float v = (t[ai][m][0] + t[ai][m][1]) + (t[ai][m][2] + t[ai][m][3]); if (NP == 16) v = fq_sum(v); rs[ai][m] = __builtin_amdgcn_rsqf(v * inv_n + EPS); }
}
struct EpiSwiglu {
    static constexpr bool PERM = true, AFTER_DRAIN = false, HAS_INIT = false;
    bf16_t* HB; const PG8_LAS float* rs_lds;
    __device__ __forceinline__ void operator()(const f32x4 (&acc)[2][2][4][2], const Unit& u, int wr, int wc, int fr, int fq) const {
        const int col0 = u.pn * 128 + wc * 32 + 8 * fq, row0 = u.pm * BM + wr * 64 + fr;
        float rs[2][4];
#pragma unroll
        for (int ai = 0; ai < 2; ++ai)
#pragma unroll
            for (int m = 0; m < 4; ++m) rs[ai][m] = rs_lds ? rs_lds[u.idx * BM + ai * HALF + wr * 64 + m * 16 + fr] : 1.f;
#pragma unroll
        for (int ai = 0; ai < 2; ++ai)
#pragma unroll
            for (int m = 0; m < 4; ++m) { const int row = row0 + ai * HALF + m * 16; const float r = rs[ai][m];
                const f32x4 h0 = silu4(acc[ai][0][m][0] * r, acc[ai][1][m][0] * r), h1 = silu4(acc[ai][0][m][1] * r, acc[ai][1][m][1] * r);
                *(u32x4*)(HB + (size_t)row * FF + col0) = pack8(h0, h1); }
    }
};
template <class Sched> __device__ __forceinline__ void rs_table_fill(const float* ssq, const Sched& S, PG8_LAS float* table, int tid) {
    Unit u; int n = 0; while (S.next(n, u)) ++n;
    for (int e = tid; e < n * BM; e += 512) { S.next(e >> 8, u); table[e] = 1.0f / sqrtf(sum16f(ssq + (size_t)(u.pm * BM + (e & 255)) * 16) * (1.f / D) + EPS); }
    __syncthreads();
}
template <int HALF_SCALE, int BASE_BF16> struct EpiResid {
    static constexpr bool PERM = true, AFTER_DRAIN = false, HAS_INIT = true;
    const void* base; float* out; bf16_t* XN; float* SSQ;
    __device__ __forceinline__ void init(f32x4 (&acc)[2][2][4][2], const Unit& u, int wr, int wc, int fr, int fq) const {
        const int col0 = u.pn * BM + wc * 32 + 8 * fq; const float inv = HALF_SCALE ? 2.0f : 1.0f;
#pragma unroll
        for (int ai = 0; ai < 2; ++ai)
#pragma unroll
            for (int m = 0; m < 4; ++m) { const int row = u.pm * BM + ai * HALF + wr * 64 + m * 16 + fr;
#pragma unroll
                for (int bj = 0; bj < 2; ++bj) { const size_t o = (size_t)row * D + col0 + bj * HALF;
                    if (BASE_BF16) { const u32x4 w = *(const u32x4*)((const bf16_t*)base + o);
                        acc[ai][bj][m][0] = (f32x4){__uint_as_float(w.x << 16), __uint_as_float(w.x & 0xffff0000u), __uint_as_float(w.y << 16), __uint_as_float(w.y & 0xffff0000u)} * inv;
                        acc[ai][bj][m][1] = (f32x4){__uint_as_float(w.z << 16), __uint_as_float(w.z & 0xffff0000u), __uint_as_float(w.w << 16), __uint_as_float(w.w & 0xffff0000u)} * inv; }
                    else { acc[ai][bj][m][0] = *(const f32x4*)((const float*)base + o) * inv; acc[ai][bj][m][1] = *(const f32x4*)((const float*)base + o + 4) * inv; } } }
    }
    __device__ __forceinline__ void operator()(const f32x4 (&acc)[2][2][4][2], const Unit& u, int wr, int wc, int fr, int fq) const {
        const int col0 = u.pn * BM + wc * 32 + 8 * fq; const float scale = HALF_SCALE ? 0.5f : 1.0f;
#pragma unroll
        for (int ai = 0; ai < 2; ++ai)
#pragma unroll
            for (int m = 0; m < 4; ++m) { const int row = u.pm * BM + ai * HALF + wr * 64 + m * 16 + fr; float sq = 0.f;
#pragma unroll
                for (int bj = 0; bj < 2; ++bj) { const size_t o = (size_t)row * D + col0 + bj * HALF;
                    const f32x4 v0 = acc[ai][bj][m][0] * scale, v1 = acc[ai][bj][m][1] * scale;
                    if (out) { *(f32x4*)(out + o) = v0; *(f32x4*)(out + o + 4) = v1; }
                    if (XN) *(u32x4*)(XN + o) = pack8(v0, v1);
                    sq += (v0[0] * v0[0] + v0[1] * v0[1]) + (v0[2] * v0[2] + v0[3] * v0[3]) + (v1[0] * v1[0] + v1[1] * v1[1]) + (v1[2] * v1[2] + v1[3] * v1[3]); }
                if (SSQ) { sq = fq_sum(sq); if (fq == 0) SSQ[(size_t)row * 16 + u.pn * 4 + wc] = sq; } }
    }
};
struct EpiWin {
    static constexpr bool PERM = true, AFTER_DRAIN = false, HAS_INIT = false;
    Ctx C; const PG8_LAS float* rs_lds; const PG8_LAS float* gt;
    __device__ __forceinline__ void operator()(const f32x4 (&acc)[2][2][4][2], const Unit& u, int wr, int wc, int fr, int fq) const {
        const RowSet& R = C.main; const int pn = u.pn;
        f32x4 bfg[2]; if (pn == 1) { bfg[0] = *(const f32x4*)(C.b_forget); bfg[1] = *(const f32x4*)(C.b_forget + 4); }
        float rsr[2][4];
#pragma unroll
        for (int ai = 0; ai < 2; ++ai)
#pragma unroll
            for (int m = 0; m < 4; ++m) rsr[ai][m] = rs_lds[u.idx * BM + ai * HALF + wr * 64 + m * 16 + fr];
#pragma unroll
        for (int ai = 0; ai < 2; ++ai)
#pragma unroll
            for (int m = 0; m < 4; ++m) { const int row = u.pm * BM + ai * HALF + wr * 64 + m * 16 + fr; const float rs = rsr[ai][m];
                f32x4 v[2][2];
#pragma unroll
                for (int bj = 0; bj < 2; ++bj)
#pragma unroll
                    for (int n = 0; n < 2; ++n) v[bj][n] = acc[ai][bj][m][n] * rs;
                float sq[2];
#pragma unroll
                for (int bj = 0; bj < 2; ++bj) sq[bj] = (v[bj][0][0] * v[bj][0][0] + v[bj][0][1] * v[bj][0][1]) + (v[bj][0][2] * v[bj][0][2] + v[bj][0][3] * v[bj][0][3]) +
                                                        (v[bj][1][0] * v[bj][1][0] + v[bj][1][1] * v[bj][1][1]) + (v[bj][1][2] * v[bj][1][2] + v[bj][1][3] * v[bj][1][3]);
                if (pn == 0) {
#pragma unroll
                    for (int bj = 0; bj < 2; ++bj) *(u32x4*)(R.CQ + (size_t)row * 256 + bj * HALF + wc * 32 + 8 * fq) = pack8(v[bj][0], v[bj][1]);
                    const float s = fq_sum(sq[0] + sq[1]); if (fq == 0) R.SSQCQ[(size_t)row * 4 + wc] = s;
                } else if (pn == 1) {
                    *(u32x4*)(R.CKV + (size_t)row * 128 + wc * 32 + 8 * fq) = pack8(v[0][0], v[0][1]);
                    const float s = fq_sum(sq[0]); if (fq == 0) R.SSQCKV[(size_t)row * 4 + wc] = s;
                    if (wc == 0) { *(f32x4*)(R.KPE + (size_t)row * 32 + 4 * fq) = v[1][0]; *(f32x4*)(R.KPE + (size_t)row * 32 + 16 + 4 * fq) = v[1][1];
                        const float sp = fq_sum(sq[1]); if (fq == 0) R.SSQKPE[row] = sp; }
                    if (wc == 1 && fq == 0) { f32x4 l0, l1;
#pragma unroll
                        for (int j = 0; j < 4; ++j) { l0[j] = log_sigmoid(v[1][0][j] + bfg[0][j]); l1[j] = log_sigmoid(v[1][1][j] + bfg[1][j]); }
                        *(f32x4*)(R.LOGF + (size_t)row * 8) = l0; *(f32x4*)(R.LOGF + (size_t)row * 8 + 4) = l1; }
                } else {
                    const int which = (pn - 2) >> 1, h = ((pn - 2) & 1) * 4 + wc; const int b = row >> 13, p = 64 + (row & (T - 1));
                    if (which < 2) { const float r = __builtin_amdgcn_rsqf(fq_sum(sq[0] + sq[1]) * (1.f / 64.f) + EPS) * (which == 0 ? C2F : 1.f); const PG8_LAS float* g = gt + (which == 0 ? 0 : 64);
#pragma unroll
                        for (int bj = 0; bj < 2; ++bj) { v[bj][0] = v[bj][0] * *(const PG8_LAS f32x4*)(g + 32 * bj + 8 * fq) * r; v[bj][1] = v[bj][1] * *(const PG8_LAS f32x4*)(g + 32 * bj + 8 * fq + 4) * r; } }
#pragma unroll
                    for (int bj = 0; bj < 2; ++bj) { bf16_t* dst = (which == 0) ? C.FQ + arow(b, h, p) * 64 + 32 * bj + 8 * fq : (which == 1) ? C.FK + kaddr(b, h, p, 32 * bj + 8 * fq, DFK) : C.FV + vaddr(b, h, p, 32 * bj + 8 * fq);
                        *(u32x4*)dst = pack8(v[bj][0], v[bj][1]); }
                }
                if (m & 1) asm volatile("" ::: "memory"); }
    }
};
struct EpiUq {
    static constexpr bool PERM = true, AFTER_DRAIN = false, HAS_INIT = false;
    const PG8_LAS float* g_q_mla; const float* SSQCQ; float* SSQQ; bf16_t* QM; const float* ROPE;
    __device__ __forceinline__ void operator()(const f32x4 (&acc)[2][2][4][2], const Unit& u, int wr, int wc, int fr, int fq) const {
        const int pn = u.pn;
        float rsr[2][4]; rs_rows<4>(SSQCQ, u.pm * BM + wr * 64 + fr, fq, 1.f / 256.f, rsr);
#pragma unroll
        for (int ai = 0; ai < 2; ++ai)
#pragma unroll
            for (int m = 0; m < 4; ++m) { const int row = u.pm * BM + ai * HALF + wr * 64 + m * 16 + fr; const float rs = rsr[ai][m];
                const int b = row >> 13, p = 64 + (row & (T - 1));
                if (pn < 2) { const int h = pn * 4 + wc; bf16_t* dst = QM + arow(b, h, p) * DQM; float sq = 0.f;
#pragma unroll
                    for (int bj = 0; bj < 2; ++bj) { const f32x4 v0 = acc[ai][bj][m][0] * rs, v1 = acc[ai][bj][m][1] * rs;
                        sq += (v0[0] * v0[0] + v0[1] * v0[1]) + (v0[2] * v0[2] + v0[3] * v0[3]) + (v1[0] * v1[0] + v1[1] * v1[1]) + (v1[2] * v1[2] + v1[3] * v1[3]);
                        const f32x4 g0 = *(const PG8_LAS f32x4*)(g_q_mla + 32 * bj + 8 * fq), g1 = *(const PG8_LAS f32x4*)(g_q_mla + 32 * bj + 8 * fq + 4);
                        *(u32x4*)(dst + 32 * bj + 8 * fq) = pack8(v0 * g0, v1 * g1); }
                    sq = fq_sum(sq); if (fq == 0) SSQQ[(size_t)row * 16 + 2 * h] = sq;
                } else { const float* rp = ROPE + ((size_t)(p - 48) * 16 + 4 * fq) * 2; const f32x4 t0 = *(const f32x4*)rp, t1 = *(const f32x4*)(rp + 4);
                    const f32x4 cs = {t0[0], t0[2], t1[0], t1[2]}, sn = {t0[1], t0[3], t1[1], t1[3]};
                    const f32x4 g0 = *(const PG8_LAS f32x4*)(g_q_mla + 64 + 4 * fq), g1 = *(const PG8_LAS f32x4*)(g_q_mla + 80 + 4 * fq);
#pragma unroll
                    for (int bj = 0; bj < 2; ++bj) { const int h = 2 * wc + bj; const f32x4 v0 = acc[ai][bj][m][0] * rs, v1 = acc[ai][bj][m][1] * rs;
                        float sq = (v0[0] * v0[0] + v0[1] * v0[1]) + (v0[2] * v0[2] + v0[3] * v0[3]) + (v1[0] * v1[0] + v1[1] * v1[1]) + (v1[2] * v1[2] + v1[3] * v1[3]);
                        sq = fq_sum(sq); if (fq == 0) SSQQ[(size_t)row * 16 + 2 * h + 1] = sq;
                        const f32x4 y1 = v0 * g0, y2 = v1 * g1; const f32x4 o1 = y1 * cs - y2 * sn, o2 = y2 * cs + y1 * sn;
                        bf16_t* dst = QM + arow(b, h, p) * DQM; u32x2 w1, w2; w1.x = cvt_pk_bf16(o1[0], o1[1]); w1.y = cvt_pk_bf16(o1[2], o1[3]); w2.x = cvt_pk_bf16(o2[0], o2[1]); w2.y = cvt_pk_bf16(o2[2], o2[3]);
                        *(u32x2*)(dst + 64 + 4 * fq) = w1; *(u32x2*)(dst + 80 + 4 * fq) = w2; } }
                if (m & 1) asm volatile("" ::: "memory"); }
    }
};
struct EpiUkv {
    static constexpr bool PERM = true, AFTER_DRAIN = false, HAS_INIT = false;
    const PG8_LAS float* g_k_mla; const float* SSQCKV; const float* SSQKPE; const float* KPE; bf16_t* KM; bf16_t* VM; const float* ROPE;
    __device__ __forceinline__ void operator()(const f32x4 (&acc)[2][2][4][2], const Unit& u, int wr, int wc, int fr, int fq) const {
        const int pn = u.pn, h = (pn & 1) * 4 + wc;
        float rsr[2][4]; rs_rows<4>(SSQCKV, u.pm * BM + wr * 64 + fr, fq, 1.f / 128.f, rsr);
#pragma unroll
        for (int ai = 0; ai < 2; ++ai)
#pragma unroll
            for (int m = 0; m < 4; ++m) { const int row = u.pm * BM + ai * HALF + wr * 64 + m * 16 + fr; const float rs = rsr[ai][m];
                const int b = row >> 13, p = 64 + (row & (T - 1));
                if (pn < 2) { float sq = 0.f;
#pragma unroll
                    for (int bj = 0; bj < 2; ++bj)
#pragma unroll
                        for (int n = 0; n < 2; ++n) { const f32x4 v = acc[ai][bj][m][n] * rs; sq += (v[0] * v[0] + v[1] * v[1]) + (v[2] * v[2] + v[3] * v[3]); }
                    const float rk = __builtin_amdgcn_rsqf((fq_sum(sq) + SSQKPE[row]) * (1.f / 96.f) + EPS); const float rr = rs * rk;
#pragma unroll
                    for (int bj = 0; bj < 2; ++bj) { const f32x4 g0 = *(const PG8_LAS f32x4*)(g_k_mla + 32 * bj + 8 * fq), g1 = *(const PG8_LAS f32x4*)(g_k_mla + 32 * bj + 8 * fq + 4);
                        *(u32x4*)(KM + kaddr(b, h, p, 32 * bj + 8 * fq, DQM)) = pack8(acc[ai][bj][m][0] * g0 * rr, acc[ai][bj][m][1] * g1 * rr); }
                    const float* rp = ROPE + ((size_t)(p - 48) * 16 + 4 * fq) * 2; const f32x4 t0 = *(const f32x4*)rp, t1 = *(const f32x4*)(rp + 4);
                    const f32x4 cs = {t0[0], t0[2], t1[0], t1[2]}, sn = {t0[1], t0[3], t1[1], t1[3]};
                    const f32x4 y1 = *(const f32x4*)(KPE + (size_t)row * 32 + 4 * fq) * *(const PG8_LAS f32x4*)(g_k_mla + 64 + 4 * fq) * rk, y2 = *(const f32x4*)(KPE + (size_t)row * 32 + 16 + 4 * fq) * *(const PG8_LAS f32x4*)(g_k_mla + 80 + 4 * fq) * rk;
                    const f32x4 o1 = y1 * cs - y2 * sn, o2 = y2 * cs + y1 * sn; u32x2 w1, w2; w1.x = cvt_pk_bf16(o1[0], o1[1]); w1.y = cvt_pk_bf16(o1[2], o1[3]); w2.x = cvt_pk_bf16(o2[0], o2[1]); w2.y = cvt_pk_bf16(o2[2], o2[3]);
                    *(u32x2*)(KM + kaddr(b, h, p, 64 + 4 * fq, DQM)) = w1; *(u32x2*)(KM + kaddr(b, h, p, 80 + 4 * fq, DQM)) = w2;
                } else {
#pragma unroll
                    for (int bj = 0; bj < 2; ++bj) *(u32x4*)(VM + vaddr(b, h, p, 32 * bj + 8 * fq)) = pack8(acc[ai][bj][m][0] * rs, acc[ai][bj][m][1] * rs); }
                if (m & 1) asm volatile("" ::: "memory"); }
    }
};
}


namespace att {
typedef short s16x4 __attribute__((ext_vector_type(4)));
typedef float f32x16 __attribute__((ext_vector_type(16)));
constexpr int NW = 8, QBLK = 32, QB = QBLK * NW, KVBLK = 64;
constexpr int KSLOT = 12288, NKSLOT = 4, VSLOT = 8192, NVSLOT = 3;
constexpr int LDS_K = 0, LDS_V = NKSLOT * KSLOT, LDS_WS = LDS_V + NVSLOT * VSLOT, LDS_OST = LDS_WS + NW * 256, LDS_BYTES = LDS_OST + NW * 4096;
__device__ __forceinline__ int crow(int r, int hi) { return (r & 3) + 8 * (r >> 2) + 4 * hi; }
#define SBAR() __builtin_amdgcn_sched_barrier(0)
__device__ __forceinline__ void cmask(f32x16& p0, f32x16& p1, int jb, int qrel, int hi) {
    const float NEG = -INFINITY; const int kb = 64 * jb + 4 * hi;
#pragma unroll
    for (int r = 0; r < 16; ++r) { const int kv = kb + (r & 3) + 8 * (r >> 2); if (kv > qrel) p0[r] = NEG; if (kv + 32 > qrel) p1[r] = NEG; }
}
__device__ __forceinline__ void glds16(const void* gsrc, unsigned lds_dst) { unsigned keep;
    asm volatile("s_mov_b32 %0, m0\n\ts_mov_b32 m0, %2\n\ts_nop 0\n\tglobal_load_lds_dwordx4 %1, off\n\ts_mov_b32 m0, %0" : "=&s"(keep) : "v"(gsrc), "s"(lds_dst) : "memory"); }
typedef float f32x2_t __attribute__((ext_vector_type(2))); typedef __bf16 bf16x2_t __attribute__((ext_vector_type(2)));
__device__ __forceinline__ unsigned cvtpk_s(float lo, float hi) { f32x2_t v = {lo, hi}; bf16x2_t b = __builtin_convertvector(v, bf16x2_t); return __builtin_bit_cast(unsigned, b); }
#define WAIT_BAR(N) asm volatile("s_waitcnt vmcnt(" #N ") lgkmcnt(0)\n\ts_barrier" ::: "memory")
typedef __attribute__((address_space(3))) const char* lds_cptr;
typedef short v4i16_t __attribute__((ext_vector_type(4)));
#define LDSV8(p) (*(const __attribute__((address_space(3))) bf16x8*)(p))
__device__ __forceinline__ void kload2(bf16x8* kf, lds_cptr kp, int j) { kf[2 * j] = LDSV8(kp + j * 2048); kf[2 * j + 1] = LDSV8(kp + j * 2048 + 512); }
__device__ __forceinline__ s16x4 vtr(lds_cptr p) { return __builtin_bit_cast(s16x4, __builtin_amdgcn_ds_read_tr16_b64_v4i16((__attribute__((address_space(3))) v4i16_t*)p)); }
#define MX3(a, b, c) __builtin_fmaxf(__builtin_fmaxf((a), (b)), (c))
__device__ __forceinline__ float rowmax(const f32x16& p0, const f32x16& p1) {
    float a = MX3(p0[0], p0[1], p1[0]), b = MX3(p0[2], p0[3], p1[1]); a = MX3(a, p1[2], p1[3]);
#pragma unroll
    for (int r = 4; r < 16; r += 4) { a = MX3(a, p0[r], p0[r + 1]); b = MX3(b, p0[r + 2], p0[r + 3]); a = MX3(a, p1[r], p1[r + 1]); b = MX3(b, p1[r + 2], p1[r + 3]); }
    float m = __builtin_fmaxf(a, b); auto rr = __builtin_amdgcn_permlane32_swap(__float_as_uint(m), __float_as_uint(m), false, false);
    return __builtin_fmaxf(__uint_as_float(rr[0]), __uint_as_float(rr[1])); }
__device__ __forceinline__ void pv(f32x16* o, int vb, bf16x8 pa0, bf16x8 pa1, bf16x8 pa2, bf16x8 pa3) {
#pragma unroll
    for (int d0 = 0; d0 < 2; ++d0) { s16x4 lo[4], hi[4];
#pragma unroll
        for (int ks = 0; ks < 4; ++ks) {
            asm volatile("ds_read_b64_tr_b16 %0,%1 offset:%c2" : "=&v"(lo[ks]) : "v"(vb), "i"(d0 * 4096 + ks * 1024) : "memory");
            asm volatile("ds_read_b64_tr_b16 %0,%1 offset:%c2" : "=&v"(hi[ks]) : "v"(vb), "i"(d0 * 4096 + ks * 1024 + 512) : "memory"); }
        asm volatile("s_waitcnt lgkmcnt(0)" ::: "memory"); SBAR();
#define PK(k) (bf16x8){lo[k][0], lo[k][1], lo[k][2], lo[k][3], hi[k][0], hi[k][1], hi[k][2], hi[k][3]}
        o[d0] = __builtin_amdgcn_mfma_f32_32x32x16_bf16(pa0, PK(0), o[d0], 0, 0, 0);
        o[d0] = __builtin_amdgcn_mfma_f32_32x32x16_bf16(pa1, PK(1), o[d0], 0, 0, 0);
        o[d0] = __builtin_amdgcn_mfma_f32_32x32x16_bf16(pa2, PK(2), o[d0], 0, 0, 0);
        o[d0] = __builtin_amdgcn_mfma_f32_32x32x16_bf16(pa3, PK(3), o[d0], 0, 0, 0);
#undef PK
    }
}
#ifndef ATTN_STORE16
#define ATTN_STORE16(p, v) (*(u32x4*)(p) = (v))
#endif
#define MFMA32(a, b, c) __builtin_amdgcn_mfma_f32_32x32x16_bf16(a, b, c, 0, 0, 0)
template <int NKS, bool FOX, int THRL>
__device__ __forceinline__ void attn_unit(int b, int h, int qb, const bf16_t* Qb, const bf16_t* __restrict__ Kb, const bf16_t* __restrict__ Vb, const float* aux, bf16_t* O, int ocol, char* shm, float m0, int tb) {
    constexpr int DK = NKS * 16, NX = NKS * 2 - 8;
    int tid = threadIdx.x; asm volatile("" : "+v"(tid));
    const int lane = tid & 63, r32 = lane & 31, hi = lane >> 5; const int wid = __builtin_amdgcn_readfirstlane(tid >> 6);
    const size_t hb = (size_t)(b * 8 + h) * PR; const int q0 = qb * QB;
    if (wid >= 4) __builtin_amdgcn_s_setprio(1);
    const bf16_t* Kh = Kb + (hb + (size_t)(64 * tb)) * DK; const bf16_t* Vh = Vb + (hb + (size_t)(64 * tb)) * 64;
    const unsigned lds0 = (unsigned)(uintptr_t)shm;
    float* wsf = (float*)(shm + LDS_WS) + wid * 64;
    const bf16_t* ksrc1 = Kh + wid * 512 + lane * 8;
    const bf16_t* ksrc2 = Kh + 4096 + wid * NX * 64 + lane * 8;
    const bf16_t* vsrc = Vh + wid * 512 + lane * 8;
    const unsigned kdst1 = lds0 + LDS_K + wid * 1024, kdst2 = lds0 + LDS_K + 8192 + wid * NX * 128, vdst = lds0 + LDS_V + wid * 1024;
    const bool x2 = lane < NX * 8;
#define DMA_K(t, slot) do { glds16(ksrc1 + (size_t)(t) * KVBLK * DK, (unsigned)__builtin_amdgcn_readfirstlane(kdst1 + (slot))); if (x2) glds16(ksrc2 + (size_t)(t) * KVBLK * DK, (unsigned)__builtin_amdgcn_readfirstlane(kdst2 + (slot))); } while (0)
#define DMA_V(t, slot) glds16(vsrc + (size_t)(t) * KVBLK * 64, (unsigned)__builtin_amdgcn_readfirstlane(vdst + (slot)))
    const int vb0 = (int)(lds0 + LDS_V) + ((lane >> 4) & 1) * 32 + (lane & 3) * 8 + (4 * hi + ((lane & 15) >> 2)) * 64;
    bf16x8 kf[12];
    const lds_cptr shm3 = (lds_cptr)shm; const lds_cptr kp0 = shm3 + LDS_K + hi * 1024 + r32 * 16; const lds_cptr vp0 = shm3 + LDS_V + ((lane >> 4) & 1) * 32 + (lane & 3) * 8 + (4 * hi + ((lane & 15) >> 2)) * 64;
    const int NT = 4 * qb + 5 - tb;
    DMA_K(0, 0); DMA_V(0, 0); DMA_K(1, KSLOT);
    bf16x8 qr[NKS]; float cqv = 0.f;
    { const int prow = 64 + q0 + wid * QBLK + r32; const bf16_t* Qrow = Qb + (hb + prow) * (FOX ? 64 : 96);
      if (FOX) {
#pragma unroll
          for (int d0 = 0; d0 < 4; ++d0) qr[d0] = *(const bf16x8*)(Qrow + d0 * 16 + hi * 8);
          const short one = hi ? (short)0 : (short)0x3f80; qr[NKS - 1] = (bf16x8){one, one, one, 0, 0, 0, 0, 0};
          cqv = aux[hb + prow] * LOG2E;
      } else { const int row = b * T + q0 + wid * QBLK + r32; const float rq = C2M / sqrtf((aux[(size_t)row * 16 + 2 * h] + aux[(size_t)row * 16 + 2 * h + 1]) * (1.f / 96.f) + EPS);
#pragma unroll
          for (int d0 = 0; d0 < NKS; ++d0) { const bf16x8 raw = *(const bf16x8*)(Qrow + d0 * 16 + hi * 8); u32x4 w;
#pragma unroll
              for (int j = 0; j < 4; ++j) w[j] = cvtpk_s(bf2f((bf16_t)raw[2 * j]) * rq, bf2f((bf16_t)raw[2 * j + 1]) * rq);
              qr[d0] = __builtin_bit_cast(bf16x8, w); } } }
    float mhat = 0.f, l_reg = 0.f; f32x16 o[2]; o[0] = f32x16{}; o[1] = f32x16{}; f32x16 negm;
#pragma unroll
    for (int r = 0; r < 16; ++r) negm[r] = cqv;
    asm volatile("" : "+v"(negm));
    const int qrel = wid * QBLK + r32;
#define CMASK(P0, P1, t) do { int jb_ = (t) - (NT - 4); if (jb_ >= 0) cmask(P0, P1, jb_, qrel, hi); } while (0)
    bool resc = false; const bool bounded = m0 < 40.f;
#define RESC() do { if (resc) { asm volatile("s_waitcnt lgkmcnt(0)" ::: "memory"); \
        _Pragma("unroll") for (int d_ = 0; d_ < 2; ++d_) _Pragma("unroll") for (int r = 0; r < 16; ++r) o[d_][r] *= wsf[crow(r, hi)]; } } while (0)
    f32x16 pA0, pA1, pB0, pB1;
    int ks_prev = 3 * KSLOT, ks_cur = 0, ks_next = KSLOT, vs_prev = 2 * VSLOT, vs_cur = 0, vs_next = VSLOT;
#define ROT() do { ks_prev = ks_cur; ks_cur = ks_next; ks_next = (ks_next == (NKSLOT - 1) * KSLOT) ? 0 : ks_next + KSLOT; vs_prev = vs_cur; vs_cur = vs_next; vs_next = (vs_next == (NVSLOT - 1) * VSLOT) ? 0 : vs_next + VSLOT; } while (0)
    DMA_K(2, 2 * KSLOT);
    WAIT_BAR(2);
    { const lds_cptr kb = kp0;
#pragma unroll
      for (int d0 = 0; d0 < NKS; ++d0) { const bf16x8 b0 = LDSV8(kb + d0 * 2048), b1 = LDSV8(kb + d0 * 2048 + 512);
          if (d0 == 0) { pB0 = MFMA32(b0, qr[0], negm); pB1 = MFMA32(b1, qr[0], negm); } else { pB0 = MFMA32(b0, qr[d0], pB0); pB1 = MFMA32(b1, qr[d0], pB1); } }
      if (tb == 0) {
#pragma unroll
          for (int r = 0; r < 16; ++r) pB0[r] = -INFINITY;
#pragma unroll
          for (int r = 0; r < 8; ++r) pB1[r] = -INFINITY; }
      const float rm = bounded ? m0 : rowmax(pB0, pB1); mhat = rm;
#pragma unroll
      for (int r = 0; r < 16; ++r) { pB0[r] = __builtin_amdgcn_exp2f(pB0[r] - rm); pB1[r] = __builtin_amdgcn_exp2f(pB1[r] - rm); }
#pragma unroll
      for (int r = 0; r < 16; ++r) negm[r] = cqv - mhat;
      asm volatile("" : "+v"(negm)); }
    WAIT_BAR(0);
    DMA_K(3, ks_prev); DMA_V(1, vs_next);
    ROT();
    kload2(kf, kp0 + ks_cur, 0); kload2(kf, kp0 + ks_cur, 1);
    s16x4 vlo[8], vhi[8]; u32x4 pw0, pw1, pw2, pw3;
#define PKW(P, B) cvtpk_s(P[B], P[B + 1])
#define PAF(k) __builtin_bit_cast(bf16x8, pw##k)
#define VFR(i) (bf16x8){vlo[i][0], vlo[i][1], vlo[i][2], vlo[i][3], vhi[i][0], vhi[i][1], vhi[i][2], vhi[i][3]}
#define PIN(x) asm volatile("" : "+v"(x))
#define GAPA(MF, A0, A1, A2, A3, W0, W1, PW) do { MF; sacc += A0; sacc += A1; sacc += A2; sacc += A3; PIN(sacc); W0; W1; PIN(PW); SBAR(); } while (0)
#define EX(v) __builtin_amdgcn_exp2f(v)
#define GAPB(MF, X, B) do { MF; X[B] = EX(X[B]); X[B + 1] = EX(X[B + 1]); X[B + 2] = EX(X[B + 2]); X[B + 3] = EX(X[B + 3]); PIN(X); SBAR(); } while (0)
#define VRD(i) do { vlo[i] = vtr(vp_ + (((i) >> 2) * 4096 + ((i) & 3) * 1024)); vhi[i] = vtr(vp_ + (((i) >> 2) * 4096 + ((i) & 3) * 1024 + 512)); } while (0)
#define KRD(G, j) do { if (G) { kload2(kf, kp0 + ks_next, j); SBAR(); } } while (0)
#define KLD(f) do { kf[f] = LDSV8(kx_ + ((f) >> 1) * 2048 + ((f) & 1) * 512); } while (0)
#define STEP(C0, C1, P0, P1, t, GK, GV, GL) do { SBAR(); \
    const lds_cptr vp_ = vp0 + vs_prev; const lds_cptr kx_ = kp0 + ks_cur; \
    VRD(0); KLD(4); SBAR(); float sacc = (P0[0] + P0[1]); \
    GAPA(C0 = MFMA32(kf[0], qr[0], negm), P0[2], P0[3], P0[4], P0[5],     pw0[0] = PKW(P0, 0), pw0[1] = PKW(P0, 2), pw0); \
    VRD(4); KLD(5); SBAR(); GAPA(C1 = MFMA32(kf[1], qr[0], negm), P0[6], P0[7], P0[8], P0[9],     pw0[2] = PKW(P0, 4), pw0[3] = PKW(P0, 6), pw0); \
    VRD(1); KLD(6); SBAR(); GAPA(C0 = MFMA32(kf[2], qr[1], C0),   P0[10], P0[11], P0[12], P0[13], pw1[0] = PKW(P0, 8), pw1[1] = PKW(P0, 10), pw1); \
    VRD(5); KLD(7); SBAR(); GAPA(C1 = MFMA32(kf[3], qr[1], C1),   P0[14], P0[15], P1[0], P1[1],   pw1[2] = PKW(P0, 12), pw1[3] = PKW(P0, 14), pw1); \
    VRD(2); KLD(8); SBAR(); GAPA(C0 = MFMA32(kf[4], qr[2], C0),   P1[2], P1[3], P1[4], P1[5],     pw2[0] = PKW(P1, 0), pw2[1] = PKW(P1, 2), pw2); \
    VRD(6); KLD(9); SBAR(); GAPA(C1 = MFMA32(kf[5], qr[2], C1),   P1[6], P1[7], P1[8], P1[9],     pw2[2] = PKW(P1, 4), pw2[3] = PKW(P1, 6), pw2); \
    VRD(3); if (NKS == 6) KLD(10); SBAR(); GAPA(C0 = MFMA32(kf[6], qr[3], C0),   P1[10], P1[11], P1[12], P1[13], pw3[0] = PKW(P1, 8), pw3[1] = PKW(P1, 10), pw3); \
    VRD(7); if (NKS == 6) KLD(11); SBAR(); GAPA(C1 = MFMA32(kf[7], qr[3], C1),   P1[14], P1[15], 0.f, 0.f,       pw3[2] = PKW(P1, 12), pw3[3] = PKW(P1, 14), pw3); \
    C0 = MFMA32(kf[8], qr[4], C0); C1 = MFMA32(kf[9], qr[4], C1); if (NKS == 6) { C0 = MFMA32(kf[10], qr[NKS - 1], C0); C1 = MFMA32(kf[11], qr[NKS - 1], C1); } \
    l_reg += sacc; \
    if (GK) { DMA_K((t) + 3, ks_prev); } if (GV) { DMA_V((t) + 1, vs_next); } \
    CMASK(C0, C1, t); \
    resc = false; \
    if (!bounded) { float a = MX3(C0[0], C0[1], C1[0]), b_ = MX3(C0[2], C0[3], C1[1]); a = MX3(a, C1[2], C1[3]); \
      _Pragma("unroll") for (int r = 4; r < 16; r += 4) { a = MX3(a, C0[r], C0[r + 1]); b_ = MX3(b_, C0[r + 2], C0[r + 3]); a = MX3(a, C1[r], C1[r + 1]); b_ = MX3(b_, C1[r + 2], C1[r + 3]); } \
      float rm = __builtin_fmaxf(a, b_); { auto rr = __builtin_amdgcn_permlane32_swap(__float_as_uint(rm), __float_as_uint(rm), false, false); rm = __builtin_fmaxf(__uint_as_float(rr[0]), __uint_as_float(rr[1])); } \
      if (__builtin_expect(__any(rm > (float)THRL), 0)) { const float dl = __builtin_fmaxf(rm, 0.f); mhat += dl; \
        _Pragma("unroll") for (int r = 0; r < 16; ++r) { C0[r] -= dl; C1[r] -= dl; } \
        _Pragma("unroll") for (int r = 0; r < 16; ++r) negm[r] = cqv - mhat; asm volatile("" : "+v"(negm)); \
        const float f = __builtin_amdgcn_exp2f(-dl); l_reg *= f; if (hi == 0) wsf[r32] = f; resc = true; } } \
    SBAR(); \
    GAPB(o[0] = MFMA32(PAF(0), VFR(0), o[0]), C0, 0); \
    GAPB(o[1] = MFMA32(PAF(0), VFR(4), o[1]), C0, 4); \
    KRD(GL, 0); GAPB(o[0] = MFMA32(PAF(1), VFR(1), o[0]), C0, 8); \
    KRD(GL, 1); GAPB(o[1] = MFMA32(PAF(1), VFR(5), o[1]), C0, 12); \
    GAPB(o[0] = MFMA32(PAF(2), VFR(2), o[0]), C1, 0); \
    GAPB(o[1] = MFMA32(PAF(2), VFR(6), o[1]), C1, 4); \
    GAPB(o[0] = MFMA32(PAF(3), VFR(3), o[0]), C1, 8); \
    GAPB(o[1] = MFMA32(PAF(3), VFR(7), o[1]), C1, 12); \
    } while (0)
#define ENDW(tt) do { if ((tt) + 3 < NT) { WAIT_BAR(3); } else if ((tt) + 2 < NT) { WAIT_BAR(1); } else { WAIT_BAR(0); } } while (0)
    WAIT_BAR(3);
    STEP(pA0, pA1, pB0, pB1, 1, true, true, true); ENDW(1); RESC(); ROT();
    int t = 2;
#undef CMASK
#define CMASK(P0, P1, t) do { } while (0)
    for (; t + 5 < NT; t += 2) {
        STEP(pB0, pB1, pA0, pA1, t, true, true, true);     WAIT_BAR(3); RESC(); ROT();
        STEP(pA0, pA1, pB0, pB1, t + 1, true, true, true); WAIT_BAR(3); RESC(); ROT();
    }
#undef CMASK
#define CMASK(P0, P1, t) do { int jb_ = (t) - (NT - 4); if (jb_ >= 0) cmask(P0, P1, jb_, qrel, hi); } while (0)
    for (; t + 1 < NT; t += 2) {
        STEP(pB0, pB1, pA0, pA1, t, (t + 3 < NT), (t + 1 < NT), (t + 1 < NT));         ENDW(t);     RESC(); ROT();
        STEP(pA0, pA1, pB0, pB1, t + 1, (t + 4 < NT), (t + 2 < NT), (t + 2 < NT));     ENDW(t + 1); RESC(); ROT();
    }
    STEP(pB0, pB1, pA0, pA1, NT - 1, false, false, false); RESC();
    { float sacc = pB0[0] + pB0[1];
#pragma unroll
      for (int r = 2; r < 16; ++r) sacc += pB0[r];
#pragma unroll
      for (int r = 0; r < 16; ++r) sacc += pB1[r];
      l_reg += sacc;
      pw0 = (u32x4){PKW(pB0, 0), PKW(pB0, 2), PKW(pB0, 4), PKW(pB0, 6)}; pw1 = (u32x4){PKW(pB0, 8), PKW(pB0, 10), PKW(pB0, 12), PKW(pB0, 14)};
      pw2 = (u32x4){PKW(pB1, 0), PKW(pB1, 2), PKW(pB1, 4), PKW(pB1, 6)}; pw3 = (u32x4){PKW(pB1, 8), PKW(pB1, 10), PKW(pB1, 12), PKW(pB1, 14)};
      SBAR(); pv(o, vb0 + vs_cur, PAF(0), PAF(1), PAF(2), PAF(3)); }
#undef PKW
#undef PAF
#undef VFR
#undef PIN
#undef GAPA
#undef GAPB
#undef EX
#undef VRD
#undef KRD
#undef STEP
#undef KLD
#undef ENDW
    { auto rr = __builtin_amdgcn_permlane32_swap(__float_as_uint(l_reg), __float_as_uint(l_reg), false, false); l_reg = __uint_as_float(rr[0]) + __uint_as_float(rr[1]); }
    if (hi == 0) wsf[32 + r32] = l_reg; asm volatile("s_waitcnt lgkmcnt(0)" ::: "memory");
    float rli[16];
#pragma unroll
    for (int r = 0; r < 16; ++r) rli[r] = __builtin_amdgcn_rcpf(wsf[32 + crow(r, hi)]);
    bf16_t* Ow = O + (size_t)(b * T + q0 + wid * QBLK) * D + ocol;
    { bf16_t* stg = (bf16_t*)(shm + LDS_OST) + wid * 2048;
#pragma unroll
      for (int r = 0; r < 16; ++r) { const int orow = crow(r, hi);
#pragma unroll
          for (int d0 = 0; d0 < 2; ++d0) stg[orow * 64 + d0 * 32 + r32] = (bf16_t)f2bf(o[d0][r] * rli[r]); }
      asm volatile("s_waitcnt lgkmcnt(0)" ::: "memory");
#pragma unroll
      for (int i = 0; i < 4; ++i) { const int row = i * 8 + (lane >> 3), ch = lane & 7; const u32x4 v = *(const u32x4*)(stg + row * 64 + ch * 8); ATTN_STORE16(Ow + (size_t)row * D + ch * 8, v); } }
    asm volatile("s_waitcnt lgkmcnt(0)\n\ts_barrier" ::: "memory");
    __builtin_amdgcn_s_setprio(0);
#undef DMA_K
#undef DMA_V
#undef CMASK
#undef RESC
#undef ROT
}
#undef SBAR
#undef WAIT_BAR
#undef MFMA32
#undef MX3
#undef LDSV8
}
constexpr int CW_QATT = 13312, CW_QCONV = CW_QATT + 64 * 8;
__device__ __forceinline__ int wg_dequeue(unsigned* head, volatile __attribute__((address_space(3))) unsigned* slot) {
    __syncthreads();
    if (threadIdx.x == 0) *slot = __hip_atomic_fetch_add(head, 1u, __ATOMIC_RELAXED, __HIP_MEMORY_SCOPE_AGENT);
    __syncthreads();
    return (int)*slot;
}
__device__ __forceinline__ void attn_phase(const Ctx& C, char* shm, unsigned* ctl, unsigned xcc, volatile __attribute__((address_space(3))) unsigned* slot) {
    float m0_mla, m0_fox;
    { const int l = threadIdx.x & 63; float a = fmaxf(fabsf(C.g_q_mla[l]), l < 32 ? fabsf(C.g_q_mla[64 + l]) : 0.f), b2 = fmaxf(fabsf(C.g_k_mla[l]), l < 32 ? fabsf(C.g_k_mla[64 + l]) : 0.f), c = fabsf(C.g_q_fox[l]), d = fabsf(C.g_k_fox[l]);
#pragma unroll
      for (int o = 1; o < 64; o <<= 1) { a = fmaxf(a, __shfl_xor(a, o)); b2 = fmaxf(b2, __shfl_xor(b2, o)); c = fmaxf(c, __shfl_xor(c, o)); d = fmaxf(d, __shfl_xor(d, o)); }
      m0_mla = 9.797958971f * a * b2 * LOG2E * 1.02f; m0_fox = 8.0f * c * d * LOG2E * 1.02f; }
    const float prune = -(2.0f * m0_fox + 40.0f);
    unsigned pre = 128u;
    if (threadIdx.x == 0) pre = __hip_atomic_fetch_add(ctl + CW_QATT + 64 * (int)(xcc & 7u), 1u, __ATOMIC_RELAXED, __HIP_MEMORY_SCOPE_AGENT);
    for (bool own = true;;) {
        __syncthreads();
        if (threadIdx.x == 0) { int grp = (int)(xcc & 7u); unsigned tk = 128u;
            if (own) tk = pre;
            if (tk >= 128u) { unsigned hd[8];
#pragma unroll
                for (int g = 0; g < 8; ++g) hd[g] = __hip_atomic_load(ctl + CW_QATT + 64 * g, __ATOMIC_RELAXED, __HIP_MEMORY_SCOPE_AGENT);
                int pick = -1;
#pragma unroll
                for (int g = 7; g >= 0; --g) { const int gg = (int)((xcc + 1u + (unsigned)g) & 7u); unsigned hv = 0u;
#pragma unroll
                    for (int q = 0; q < 8; ++q) hv = (q == gg) ? hd[q] : hv;
                    if (hv < 128u) pick = gg; }
                if (pick >= 0) { grp = pick; tk = __hip_atomic_fetch_add(ctl + CW_QATT + 64 * grp, 1u, __ATOMIC_RELAXED, __HIP_MEMORY_SCOPE_AGENT); } else tk = 0xffffu; }
            *slot = (tk << 8) | (unsigned)grp; }
        __syncthreads();
        const unsigned sv = *slot; const int grp = (int)(sv & 7u), i = (int)(sv >> 8);
        if (i >= 0xffff) break;
        if (i >= 128) { own = false; continue; }
        if (grp != (int)(xcc & 7u)) own = false;
        if (own && threadIdx.x == 0) pre = __hip_atomic_fetch_add(ctl + CW_QATT + 64 * grp, 1u, __ATOMIC_RELAXED, __HIP_MEMORY_SCOPE_AGENT);
        {
            const int fox = i >> 6, j = i & 63, st = 4 * grp + 2 * (j & 1) + fox, qb = 31 - (j >> 1), bh = st >> 1, b = bh >> 3, h = bh & 7;
            if (!fox) att::attn_unit<6, false, 8>(b, h, qb, C.QM, C.KM, C.VM, C.main.SSQQ, C.O, h * 64, shm, m0_mla, 0);
            else { const int lane = threadIdx.x & 63, cand = 2 * lane; const size_t hb = (size_t)bh * PR;
                bool ok = cand <= 4 * qb;
                if (ok && cand > 0) ok = (C.CUM[hb + 64 + 256 * qb] - C.CUM[hb + 64 * cand - 1]) * LOG2E < prune;
                const unsigned long long m = __ballot(ok); const int tb = 2 * (63 - __builtin_clzll(m));
                att::attn_unit<5, true, 8>(b, h, qb, C.FQ, C.FK, C.FV, C.CUM, C.O, 512 + h * 64, shm, m0_fox, __builtin_amdgcn_readfirstlane(tb)); } } }
    constexpr int NCHUNK = (2 * I_GU + I_DN + 7) / 8;
    for (;;) { const int c = wg_dequeue(ctl + CW_QCONV, slot); if (c >= NCHUNK) break;
        const int w_ = __builtin_amdgcn_readfirstlane(threadIdx.x >> 6); p0_late<1>(C, (float*)shm + w_ * TSCR, c * 8 + w_, NCHUNK * 8, threadIdx.x & 63); }
}
#define LAS __attribute__((address_space(3)))
constexpr int CW_BAR = 1024;
constexpr size_t CTL_ZERO_BYTES = 65536;
constexpr int LDSCTL_OFF = 131072, MISC_OFF = LDSCTL_OFF + 320;
#define XB_TMO      128
#define XB_XCNT(j)  (256  + 64 * (j))
#define XB_XSUB(j)  (1280 + 64 * (j))
#define XB_XGEN(j)  (2304 + 64 * (j))
#define XB_TOP      3328
#define XB_TOPGEN   3392
#define XCD_BAR_WORDS 3456
#define XB_SPIN_CAP (1u << 18)

__device__ __forceinline__ unsigned xb_ld(unsigned* p)              { return __hip_atomic_load(p, __ATOMIC_RELAXED, __HIP_MEMORY_SCOPE_AGENT); }
__device__ __forceinline__ unsigned xb_add(unsigned* p, unsigned v) { return __hip_atomic_fetch_add(p, v, __ATOMIC_RELAXED, __HIP_MEMORY_SCOPE_AGENT); }
__device__ __forceinline__ unsigned xb_xcc_id() { return (unsigned)__builtin_amdgcn_s_getreg((3 << 11) | 20) & 0xFu; }
#define XB_SPIN(cond, bar) do { unsigned _sp = 0; while (cond) { __builtin_amdgcn_s_sleep(1); \
    if ((++_sp & 255u) == 0u) { if (xb_ld(&(bar)[XB_TMO])) break; if (_sp > XB_SPIN_CAP) { atomicAdd(&(bar)[XB_TMO], 1u); break; } } } } while (0)

constexpr int CW_SIDE = 12288;
__device__ __forceinline__ void side_wait(unsigned* w, unsigned target, unsigned* bar) {
    if (threadIdx.x == 0) { XB_SPIN(xb_ld(w) < target, bar); __builtin_amdgcn_fence(__ATOMIC_ACQUIRE, "agent"); asm volatile("s_waitcnt vmcnt(0)" ::: "memory"); }
    __syncthreads();
}
struct XcdBarrier {
    unsigned* bar; unsigned x;
    volatile LAS unsigned* st;
};

__device__ __forceinline__ XcdBarrier xcd_barrier_post(unsigned* bar, volatile LAS unsigned* st) {
    XcdBarrier b; b.bar = bar; b.x = xb_xcc_id(); b.st = st;
    if (threadIdx.x == 0) (void)xb_add(&bar[XB_XCNT(b.x)], 1u);
    return b;
}
__device__ __forceinline__ void xcd_barrier_complete(unsigned* bar, unsigned x, unsigned& nloc, unsigned& nx) {
    const unsigned G = gridDim.x * gridDim.y * gridDim.z;
    unsigned sum, cnt, mine, sp = 0u;
    for (;;) {
        sum = 0u; cnt = 0u; mine = 0u;
#pragma unroll
        for (unsigned j = 0; j < 16; ++j) { const unsigned c = xb_ld(&bar[XB_XCNT(j)]); sum += c; cnt += (c > 0u) ? 1u : 0u; mine = (j == x) ? c : mine; }
        if (sum == G) break;
        __builtin_amdgcn_s_sleep(1);
        if ((++sp & 255u) == 0u) { if (xb_ld(&bar[XB_TMO])) break; if (sp > XB_SPIN_CAP) { atomicAdd(&bar[XB_TMO], 1u); break; } }
    }
    nloc = mine > 0u ? mine : 1u; nx = cnt > 0u ? cnt : 1u;
}

__device__ __forceinline__ void xcd_barrier(const XcdBarrier& b) {
    asm volatile("s_waitcnt vmcnt(0)" ::: "memory");
    __syncthreads();
    if (threadIdx.x == 0) {
        unsigned* bar = b.bar;
        __builtin_amdgcn_s_waitcnt(0);
        unsigned nloc = b.st[0], nx = b.st[1];
        if (nloc == 0u) { xcd_barrier_complete(bar, b.x, nloc, nx); b.st[0] = nloc; b.st[1] = nx; }
        const unsigned old = xb_add(&bar[XB_XSUB(b.x)], 1u);
        const unsigned gen = old / nloc;
        if (old + 1u == (gen + 1u) * nloc) {
            __builtin_amdgcn_fence(__ATOMIC_RELEASE, "agent");
            asm volatile("s_waitcnt vmcnt(0)" ::: "memory");
            const unsigned og = xb_add(&bar[XB_TOP], 1u);
            const unsigned tg = og / nx;
            if (og + 1u == (tg + 1u) * nx) xb_add(&bar[XB_TOPGEN], 1u);
            else XB_SPIN(xb_ld(&bar[XB_TOPGEN]) == tg, bar);
            __builtin_amdgcn_fence(__ATOMIC_ACQUIRE, "agent");
            xb_add(&bar[XB_XGEN(b.x)], 1u);
            asm volatile("s_waitcnt vmcnt(0)" ::: "memory");
        } else {
            XB_SPIN(xb_ld(&bar[XB_XGEN(b.x)]) == gen, bar);
            __builtin_amdgcn_fence(__ATOMIC_ACQUIRE, "agent");
            asm volatile("s_waitcnt vmcnt(0)" ::: "memory");
        }
    }
    __syncthreads();
}

constexpr int NWAVES = 8, LDS_BYTES = 147456;
__device__ __forceinline__ void fk_aug(const Ctx& C, int b, int h, int p, float cum) {
    C.CUM[arow(b, h, p)] = cum;
    const float cc = -cum * LOG2E; const unsigned hi = f2bf(cc); const float r1 = cc - __uint_as_float(hi << 16); const unsigned mid = f2bf(r1); const float r2 = r1 - __uint_as_float(mid << 16); const unsigned lo = f2bf(r2);
    *(u32x4*)(C.FK + kaddr(b, h, p, 64, DFK)) = (u32x4){hi | (mid << 16), lo, 0u, 0u}; *(u32x4*)(C.FK + kaddr(b, h, p, 72, DFK)) = (u32x4){0u, 0u, 0u, 0u};
}
__device__ __forceinline__ void scan_block(const Ctx& C, int bh, float* lds_f, int tid) {
    const int b = bh >> 3, h = bh & 7, lane = tid & 63, w = tid >> 6; constexpr int PER = 16;
    float v[PER]; const int e0 = tid * PER;
#pragma unroll
    for (int i = 0; i < PER; ++i) v[i] = C.main.LOGF[(size_t)(b * T + e0 + i) * 8 + h];
#pragma unroll
    for (int i = 1; i < PER; ++i) v[i] += v[i - 1];
    float s = v[PER - 1];
#pragma unroll
    for (int o = 1; o < 64; o <<= 1) { const float n = __shfl_up(s, o); if (lane >= o) s += n; }
    if (lane == 63) lds_f[w] = s;
    __syncthreads();
    float off = s - v[PER - 1];
#pragma unroll
    for (int j = 0; j < 8; ++j) if (j < w) off += lds_f[j];
#pragma unroll
    for (int i = 0; i < PER; ++i) fk_aug(C, b, h, 64 + e0 + i, off + v[i]);
    if (tid < 16) { float c = 0.f; for (int r = tid + 1; r < 16; ++r) c += C.mt.LOGF[r * 8 + h]; fk_aug(C, b, h, 48 + tid, -c); }
    if (tid >= 256) { const int r = (tid >> 3) & 15, ch = tid & 7;
        if (tid < 384) *(u32x4*)(C.FK + kaddr(b, h, 48 + r, 8 * ch, DFK)) = *(const u32x4*)(C.MFK + (r * 8 + h) * 64 + 8 * ch);
        else *(u32x4*)(C.FV + vaddr(b, h, 48 + r, 8 * ch)) = *(const u32x4*)(C.MFV + (r * 8 + h) * 64 + 8 * ch); }
    if (tid < 48) { const int p = tid; C.CUM[arow(b, h, p)] = 0.f;
        const u32x4 z = {0u, 0u, 0u, 0u};
        for (int j = 0; j < DFK / 8; ++j) *(u32x4*)(C.FK + kaddr(b, h, p, 8 * j, DFK)) = z;
        for (int j = 0; j < DQM / 8; ++j) *(u32x4*)(C.KM + kaddr(b, h, p, 8 * j, DQM)) = z;
        for (int j = 0; j < 8; ++j) { *(u32x4*)(C.FV + vaddr(b, h, p, 8 * j)) = z; *(u32x4*)(C.VM + vaddr(b, h, p, 8 * j)) = z; } }
    __syncthreads();
}
#define GEMM_PHASE(g, E) do { int t_ = threadIdx.x; asm volatile("" : "+v"(t_)); pg8::StaticOrder S_; S_.init((g).M, (g).N, G, (int)blockIdx.x); \
    pg8::gemm_phase<std::remove_cv_t<std::remove_reference_t<decltype(E)>>, pg8::StaticOrder, true, true>(ldsp, g, S_, E, t_); } while (0)
__global__ void __launch_bounds__(NWAVES * 64, 2) mega_fwd(KArgs a) {
    extern __shared__ __attribute__((aligned(16))) unsigned char lds[];
    const Ctx C = make_ctx(a);
    PG8_LAS unsigned char* ldsp = (PG8_LAS unsigned char*)lds;
    const int tid = threadIdx.x, lane = tid & 63, wave = __builtin_amdgcn_readfirstlane(tid >> 6);
    const int G = gridDim.x, gw = blockIdx.x * NWAVES + wave, NGW = G * NWAVES;
    for (int u = tid; u < (LDS_BYTES - LDSCTL_OFF) / 4; u += NWAVES * 64) ((LAS unsigned*)((LAS unsigned char*)lds + LDSCTL_OFF))[u] = 0u;
    __syncthreads();
    PG8_LAS float* const gtab = (PG8_LAS float*)(ldsp + LDSCTL_OFF + 8192);
    if (tid < 320) gtab[tid] = tid < 64 ? C.g_q_fox[tid] : tid < 128 ? C.g_k_fox[tid - 64] : tid < 224 ? C.g_q_mla[tid - 128] : C.g_k_mla[tid - 224];
    __syncthreads();
    unsigned* const ctl = (unsigned*)(a.ws + WS_CTL);
    const XcdBarrier bar = xcd_barrier_post(ctl + CW_BAR, (volatile LAS unsigned*)((LAS unsigned char*)lds + MISC_OFF) + 8);
    p0_prologue(C, (float*)lds + wave * TSCR, gw, wave * G + (int)blockIdx.x, NGW, lane);
    xcd_barrier(bar);
    { const int s_ = (int)blockIdx.x - G / 2, NS = G - G / 2; unsigned* const side = ctl + CW_SIDE;
      const bool dn = s_ >= NS - 16, wn = s_ >= 48 && s_ < 66;
      if (s_ >= 0) {
          for (int t = s_; t < FF / 16; t += NS) { task_gateup(C.mt.XN1, C.W1GU, nullptr, C.mt.HB, t, lane, wave, (float*)lds); __syncthreads(); }
          if (wave == 0) { asm volatile("s_waitcnt vmcnt(0)" ::: "memory"); if (tid == 0) xb_add(side, 1u); } }
      const pg8::Gemm g{C.main.XN1, C.W1GU, M, 2 * FF, D, D}; const pg8::EpiSwiglu E{C.main.HB, nullptr};
      const int cut = dn ? 1 : wn ? 2 : 1 << 20; int nseg = 2; asm volatile("" : "+s"(nseg));
      for (int seg = 0; seg < nseg; ++seg) {
          { int t_ = threadIdx.x; asm volatile("" : "+v"(t_)); pg8::StaticOrder S_; S_.init(g.M, g.N, G, (int)blockIdx.x); S_.off = seg ? cut : 0; S_.cnt = seg ? 1 << 20 : cut;
            pg8::gemm_phase<pg8::EpiSwiglu, pg8::StaticOrder, true, true>(ldsp, g, S_, E, t_); }
          if (seg == 0 && dn) { side_wait(side, NS, ctl + CW_BAR);
              task_down(C.mt.HB, FF, C.W1D, C.mt.base1, C.mt.H, 0.5f, C.mt.XN, C.mt.SSQ1, s_ - (NS - 16), lane, wave, (float*)lds);
              if (wave == 0) { asm volatile("s_waitcnt vmcnt(0)" ::: "memory"); if (tid == 0) xb_add(side + 64, 1u); }
              __syncthreads(); }
          if (seg == 0 && wn) { side_wait(side + 64, 16, ctl + CW_BAR); task_win(C, C.mt, 0, s_ - 48, lane, wave, (float*)lds); __syncthreads(); } }
      if (s_ >= 0 && !dn && !wn) p0_late<0>(C, (float*)lds + wave * TSCR, (s_ < 48 ? s_ : s_ - 18) * NWAVES + wave, (NS - 34) * NWAVES, lane); }
    xcd_barrier(bar);
    { const pg8::Gemm g{C.main.HB, C.W1D, M, D, FF, FF}; const pg8::EpiResid<1, 0> E{C.main.base1, nullptr, C.main.XN, C.main.SSQ1}; GEMM_PHASE(g, E); }
    xcd_barrier(bar);
    { const pg8::Gemm g{C.main.XN, C.WIN, M, 2048, D, D}; PG8_LAS float* rst = (PG8_LAS float*)(ldsp + LDSCTL_OFF + 1024);
      { pg8::StaticOrder S_; S_.init(g.M, g.N, G, (int)blockIdx.x); pg8::rs_table_fill(C.main.SSQ1, S_, rst, tid); }
      const pg8::EpiWin E{C, rst, gtab}; GEMM_PHASE(g, E); }
    xcd_barrier(bar);
    { int k_ = 128; asm volatile("" : "+s"(k_)); const pg8::Gemm g{C.main.CKV, C.WUKV, M, 1024, k_, k_}; const pg8::EpiUkv E{gtab + 224, C.main.SSQCKV, C.main.SSQKPE, C.main.KPE, C.KM, C.VM, C.ROPE}; GEMM_PHASE(g, E); }
    { const int sb = (int)blockIdx.x - (G - 24);
      if (sb >= 0 && sb < 16) scan_block(C, sb, (float*)lds, tid);
      if (sb >= 16) { task_uqkv(C, C.mt, 8 + (sb - 16), lane, wave, (float*)lds); __syncthreads(); } }
    { int k_ = 256; asm volatile("" : "+s"(k_)); const pg8::Gemm g{C.main.CQ, C.WUQ, M, 768, k_, k_}; const pg8::EpiUq E{gtab + 128, C.main.SSQCQ, C.main.SSQQ, C.QM, C.ROPE}; GEMM_PHASE(g, E); }
    xcd_barrier(bar);
    { static_assert(MISC_OFF + 64 <= LDS_BYTES && att::LDS_BYTES <= LDSCTL_OFF, "attention LDS");
      attn_phase(C, (char*)lds, ctl, bar.x, (volatile LAS unsigned*)((LAS unsigned char*)lds + MISC_OFF) + 12); }
    xcd_barrier(bar);
    { const pg8::Gemm g{C.O, C.WOUT, M, D, D, D}; const pg8::EpiResid<0, 1> E{C.main.XN, nullptr, C.main.XN, C.SSQ2}; GEMM_PHASE(g, E); }
    xcd_barrier(bar);
    { const pg8::Gemm g{C.main.XN, C.W2GU, M, 2 * FF, D, D}; PG8_LAS float* rst = (PG8_LAS float*)(ldsp + LDSCTL_OFF + 1024);
      { pg8::StaticOrder S_; S_.init(g.M, g.N, G, (int)blockIdx.x); pg8::rs_table_fill(C.SSQ2, S_, rst, tid); }
      const pg8::EpiSwiglu E{C.main.HB, rst}; GEMM_PHASE(g, E); }
    xcd_barrier(bar);
    { const pg8::Gemm g{C.main.HB, C.W2D, M, D, FF, FF}; const pg8::EpiResid<1, 1> E{C.main.XN, C.out, nullptr, nullptr}; GEMM_PHASE(g, E); }
}

extern "C" void kernel_launch(void* const* d_in, const int* in_sizes, int n_in, void* d_out, int out_size, void* d_ws, size_t ws_size, hipStream_t stream) {
    static int grid = 0;
    if (grid == 0) {
        if (n_in != 22 || in_sizes[0] != M * D || out_size != M * D || ws_size < WS_END) { fprintf(stderr, "kernel_launch: unexpected shapes (n_in %d, in0 %d, out %d, ws %zu)\n", n_in, n_in > 0 ? in_sizes[0] : -1, out_size, ws_size); grid = -1; return; }
        int dev = 0, cus = 0, per_cu = 0;
        if (hipGetDevice(&dev) != hipSuccess || hipDeviceGetAttribute(&cus, hipDeviceAttributeMultiprocessorCount, dev) != hipSuccess) { grid = -1; return; }
        if (hipFuncSetAttribute((const void*)mega_fwd, hipFuncAttributeMaxDynamicSharedMemorySize, LDS_BYTES) != hipSuccess) { fprintf(stderr, "kernel_launch: hipFuncSetAttribute failed\n"); grid = -1; return; }
        if (hipOccupancyMaxActiveBlocksPerMultiprocessor(&per_cu, (const void*)mega_fwd, NWAVES * 64, LDS_BYTES) != hipSuccess || per_cu < 1) { fprintf(stderr, "kernel_launch: occupancy query reports %d blocks per CU\n", per_cu); grid = -1; return; }
        grid = cus;
    }
    if (grid < 0) return;
    if (hipMemsetAsync((char*)d_ws + WS_CTL, 0, CTL_ZERO_BYTES, stream) != hipSuccess) { fprintf(stderr, "kernel_launch: hipMemsetAsync of the control words failed\n"); return; }
    KArgs a{}; for (int i = 0; i < 22; ++i) a.in[i] = (const float*)d_in[i]; a.out = (float*)d_out; a.ws = (unsigned char*)d_ws;
    void* args[] = {&a};
    const hipError_t e = hipLaunchCooperativeKernel((const void*)mega_fwd, dim3(grid), dim3(NWAVES * 64), args, LDS_BYTES, stream);
    if (e != hipSuccess) fprintf(stderr, "kernel_launch: cooperative launch failed: %s (grid %d)\n", hipGetErrorString(e), grid);
}
```

```cpp
#include <hip/hip_runtime.h>
#include <cstdint>
#include <cstdio>
#include <type_traits>

typedef unsigned short bf16_t;
typedef short bf16x8 __attribute__((ext_vector_type(8)));
typedef float f32x4 __attribute__((ext_vector_type(4)));
typedef unsigned u32x4 __attribute__((ext_vector_type(4)));
typedef unsigned u32x2 __attribute__((ext_vector_type(2)));

constexpr int NB = 2, T = 8192, D = 1024, FF = 2816, M = NB * T, NMETA = 16;
constexpr int PR = 64 + T;
constexpr int NPOS = 16 + T;
constexpr int DQM = 96, DFK = 80, DV = 64;
constexpr float EPS = 1e-6f;
constexpr float LOG2E = 1.4426950408889634f;
constexpr float C2F = 0.125f * LOG2E;
constexpr float C2M = 0.10206207261596577f * LOG2E;

constexpr size_t KiB = 1024, MiB = 1u << 20;
constexpr size_t WS_CTL = 0;
constexpr size_t WS_W1GU = 1 * MiB, WS_W1D = 12 * MiB, WS_W2GU = 18 * MiB, WS_W2D = 29 * MiB, WS_WIN = 35 * MiB, WS_WOUT = 39 * MiB;
constexpr size_t WS_WUQ = 41 * MiB, WS_WUKV = 41 * MiB + 512 * KiB, WS_ROPE = 42 * MiB;
constexpr size_t WS_META = 43 * MiB + 512 * KiB;
constexpr size_t WS_XN = 44 * MiB, WS_CQ = 76 * MiB, WS_CKV = 84 * MiB, WS_KPE = 88 * MiB, WS_LOGF = 90 * MiB, WS_CUM = 90 * MiB + 512 * KiB;
constexpr size_t WS_SSQ1 = 91 * MiB + 256 * KiB, WS_SSQ2 = 92 * MiB + 256 * KiB, WS_SSQCQ = 93 * MiB + 256 * KiB, WS_SSQCKV = 93 * MiB + 512 * KiB, WS_SSQKPE = 93 * MiB + 768 * KiB, WS_SSQQ = 94 * MiB;
constexpr size_t WS_HB = 95 * MiB;
constexpr size_t WS_FQ = 95 * MiB, WS_FK = 111 * MiB + 256 * KiB, WS_FV = 131 * MiB + 512 * KiB, WS_QM = 147 * MiB + 768 * KiB, WS_KM = 172 * MiB, WS_VM = 196 * MiB + 256 * KiB, WS_O = 212 * MiB + 512 * KiB;
constexpr size_t WS_END = 256 * MiB;
static_assert(WS_FQ + (size_t)NB * 8 * PR * 64 * 2 <= WS_FK && WS_FK + (size_t)NB * 8 * PR * DFK * 2 <= WS_FV && WS_FV + (size_t)NB * 8 * PR * 64 * 2 <= WS_QM, "ws map 1");
static_assert(WS_QM + (size_t)NB * 8 * PR * DQM * 2 <= WS_KM && WS_KM + (size_t)NB * 8 * PR * DQM * 2 <= WS_VM && WS_VM + (size_t)NB * 8 * PR * 64 * 2 <= WS_O && WS_O + (size_t)M * D * 2 <= WS_END, "ws map 2");
static_assert(WS_ROPE + (size_t)NPOS * 16 * 8 <= WS_META && WS_CUM + (size_t)NB * 8 * PR * 4 <= WS_SSQ1 && WS_HB + (size_t)M * FF * 2 <= WS_END, "ws map 3");
constexpr size_t MO_XNM = 0, MO_HB = 32 * KiB, MO_H = 128 * KiB, MO_XN = 192 * KiB, MO_SSQ1 = 224 * KiB, MO_CQ = 228 * KiB, MO_SSQCQ = 236 * KiB, MO_CKV = 237 * KiB, MO_SSQCKV = 241 * KiB,
                 MO_KPE = 242 * KiB, MO_SSQKPE = 244 * KiB, MO_LOGF = 245 * KiB, MO_SSQQ = 246 * KiB, MO_FKS = 256 * KiB, MO_FVS = 272 * KiB, MO_FOXTB = 288 * KiB;

__device__ __forceinline__ float bf2f(bf16_t v) { return __uint_as_float((unsigned)v << 16); }
__device__ __forceinline__ unsigned f2bf(float f) { unsigned u = __float_as_uint(f); return (u + 0x7fffu + ((u >> 16) & 1u)) >> 16; }
__device__ __forceinline__ unsigned pk2(float lo, float hi) { return f2bf(lo) | (f2bf(hi) << 16); }
__device__ __forceinline__ float rsum16(float v) { v += __shfl_xor(v, 1); v += __shfl_xor(v, 2); v += __shfl_xor(v, 4); v += __shfl_xor(v, 8); return v; }
__device__ __forceinline__ float wave_sum(float v) {
#pragma unroll
    for (int o = 1; o < 64; o <<= 1) v += __shfl_xor(v, o);
    return v;
}
__device__ __forceinline__ float sum16f(const float* p) { const f32x4 a = ((const f32x4*)p)[0], b = ((const f32x4*)p)[1], c = ((const f32x4*)p)[2], d = ((const f32x4*)p)[3];
    return ((a[0] + a[1]) + (a[2] + a[3])) + ((b[0] + b[1]) + (b[2] + b[3])) + ((c[0] + c[1]) + (c[2] + c[3])) + ((d[0] + d[1]) + (d[2] + d[3])); }
__device__ __forceinline__ float sum4f(const float* p) { const f32x4 a = *(const f32x4*)p; return (a[0] + a[1]) + (a[2] + a[3]); }
__device__ __forceinline__ float silu_mul(float g, float u) { return g / (1.0f + __expf(-g)) * u; }
__device__ __forceinline__ float log_sigmoid(float x) { return fminf(x, 0.f) - 0.6931471805599453f * __builtin_amdgcn_logf(1.0f + __builtin_amdgcn_exp2f(-LOG2E * fabsf(x))); }

__host__ __device__ __forceinline__ int gu_row_gate(int c) { return 256 * (c >> 7) + (c & 127); }
__host__ __device__ __forceinline__ int rope_slot(int dd) { return 8 * ((dd & 15) >> 2) + 4 * (dd >> 4) + (dd & 3); }
__host__ __device__ __forceinline__ int win_row(int s) {
    if (s < 256) return s;
    if (s < 384) return 256 + (s - 256);
    if (s < 416) return 256 + 128 + rope_slot(s - 384);
    if (s < 1952) { const int i = s - 416, which = i >> 9, head = (i & 511) >> 6, d = i & 63; return 256 * (2 + which * 2 + (head >> 2)) + 128 * (d >> 5) + 32 * (head & 3) + (d & 31); }
    return 256 + 160 + (s - 1952);
}
__host__ __device__ __forceinline__ int wuq_row(int s) { const int h = s / 96, d = s % 96;
    if (d < 64) return 256 * (h >> 2) + 128 * (d >> 5) + 32 * (h & 3) + (d & 31);
    return 512 + 128 * (h & 1) + 32 * (h >> 1) + rope_slot(d - 64); }
__host__ __device__ __forceinline__ int wukv_row(int s) { const int h = s >> 7, d = s & 127;
    if (d < 64) return 256 * (h >> 2) + 128 * (d >> 5) + 32 * (h & 3) + (d & 31);
    const int e = d - 64; return 256 * (2 + (h >> 2)) + 128 * (e >> 5) + 32 * (h & 3) + (e & 31); }

struct KArgs { const float* in[22]; float* out; unsigned char* ws; };
struct RowSet {
    int nrows, meta;
    const bf16_t* XN1; const float* base1; bf16_t* HB; float* H; bf16_t* XN; float* SSQ1;
    bf16_t* CQ; float* SSQCQ; bf16_t* CKV; float* SSQCKV; float* KPE; float* SSQKPE; float* LOGF; float* SSQQ;
};
struct Ctx {
    const float *x, *meta, *g_ffn1, *w1g, *w1u, *w1d, *g_mix, *w_in, *g_cq, *w_uq, *g_ckv, *w_ukv, *g_q_mla, *g_k_mla, *b_forget, *g_q_fox, *g_k_fox, *w_out, *g_ffn2, *w2g, *w2u, *w2d;
    float* out; unsigned char* ws;
    bf16_t *W1GU, *W1D, *W2GU, *W2D, *WIN, *WOUT, *WUQ, *WUKV; float* ROPE;
    bf16_t *FQ, *FK, *FV, *QM, *KM, *VM, *O; float* CUM; float* SSQ2; bf16_t *MFK, *MFV; int* FOXTB;
    RowSet main, mt;
};
__device__ __forceinline__ Ctx make_ctx(const KArgs& a) {
    Ctx c;
    c.x = a.in[0]; c.meta = a.in[1]; c.g_ffn1 = a.in[2]; c.w1g = a.in[3]; c.w1u = a.in[4]; c.w1d = a.in[5]; c.g_mix = a.in[6]; c.w_in = a.in[7]; c.g_cq = a.in[8]; c.w_uq = a.in[9]; c.g_ckv = a.in[10];
    c.w_ukv = a.in[11]; c.g_q_mla = a.in[12]; c.g_k_mla = a.in[13]; c.b_forget = a.in[14]; c.g_q_fox = a.in[15]; c.g_k_fox = a.in[16]; c.w_out = a.in[17]; c.g_ffn2 = a.in[18]; c.w2g = a.in[19]; c.w2u = a.in[20]; c.w2d = a.in[21];
    c.out = a.out; c.ws = a.ws; unsigned char* ws = a.ws;
    c.W1GU = (bf16_t*)(ws + WS_W1GU); c.W1D = (bf16_t*)(ws + WS_W1D); c.W2GU = (bf16_t*)(ws + WS_W2GU); c.W2D = (bf16_t*)(ws + WS_W2D); c.WIN = (bf16_t*)(ws + WS_WIN); c.WOUT = (bf16_t*)(ws + WS_WOUT);
    c.WUQ = (bf16_t*)(ws + WS_WUQ); c.WUKV = (bf16_t*)(ws + WS_WUKV); c.ROPE = (float*)(ws + WS_ROPE);
    c.FQ = (bf16_t*)(ws + WS_FQ); c.FK = (bf16_t*)(ws + WS_FK); c.FV = (bf16_t*)(ws + WS_FV); c.QM = (bf16_t*)(ws + WS_QM); c.KM = (bf16_t*)(ws + WS_KM); c.VM = (bf16_t*)(ws + WS_VM); c.O = (bf16_t*)(ws + WS_O);
    c.CUM = (float*)(ws + WS_CUM); c.SSQ2 = (float*)(ws + WS_SSQ2);
    RowSet& m = c.main; m.nrows = M; m.meta = 0; m.XN1 = (bf16_t*)(ws + WS_XN); m.base1 = c.x; m.HB = (bf16_t*)(ws + WS_HB); m.H = a.out; m.XN = (bf16_t*)(ws + WS_XN); m.SSQ1 = (float*)(ws + WS_SSQ1);
    m.CQ = (bf16_t*)(ws + WS_CQ); m.SSQCQ = (float*)(ws + WS_SSQCQ); m.CKV = (bf16_t*)(ws + WS_CKV); m.SSQCKV = (float*)(ws + WS_SSQCKV); m.KPE = (float*)(ws + WS_KPE); m.SSQKPE = (float*)(ws + WS_SSQKPE);
    m.LOGF = (float*)(ws + WS_LOGF); m.SSQQ = (float*)(ws + WS_SSQQ);
    unsigned char* mw = ws + WS_META; RowSet& t = c.mt; t.nrows = NMETA; t.meta = 1; t.XN1 = (bf16_t*)(mw + MO_XNM); t.base1 = c.meta; t.HB = (bf16_t*)(mw + MO_HB); t.H = (float*)(mw + MO_H); t.XN = (bf16_t*)(mw + MO_XN);
    t.SSQ1 = (float*)(mw + MO_SSQ1); t.CQ = (bf16_t*)(mw + MO_CQ); t.SSQCQ = (float*)(mw + MO_SSQCQ); t.CKV = (bf16_t*)(mw + MO_CKV); t.SSQCKV = (float*)(mw + MO_SSQCKV); t.KPE = (float*)(mw + MO_KPE);
    t.SSQKPE = (float*)(mw + MO_SSQKPE); t.LOGF = (float*)(mw + MO_LOGF); t.SSQQ = (float*)(mw + MO_SSQQ);
    c.MFK = (bf16_t*)(mw + MO_FKS); c.MFV = (bf16_t*)(mw + MO_FVS); c.FOXTB = (int*)(mw + MO_FOXTB);
    return c;
}
__device__ __forceinline__ size_t arow(int b, int h, int p) { return (size_t)((b * 8 + h) * PR + p); }
__device__ __forceinline__ size_t kaddr(int b, int h, int p, int d, int DK) { return ((size_t)((b * 8 + h) * PR + (p & ~63))) * DK + (size_t)((d >> 3) * 512 + (p & 63) * 8 + (d & 7)); }
__device__ __forceinline__ size_t vaddr(int b, int h, int p, int d) { return ((size_t)((b * 8 + h) * PR + (p & ~63))) * 64 + (size_t)((d >> 5) * 2048 + (p & 63) * 32 + (d & 31)); }

constexpr int TSCR = 32 * 68;
__device__ __forceinline__ void st_wt(bf16_t* p, bf16_t v) { __hip_atomic_store(p, v, __ATOMIC_RELAXED, __HIP_MEMORY_SCOPE_AGENT); }
__device__ __forceinline__ void st_wt(float* p, float v) { __hip_atomic_store(p, v, __ATOMIC_RELAXED, __HIP_MEMORY_SCOPE_AGENT); }
template <class MapF>
__device__ __forceinline__ void p0_transpose_item(const float* W, int K, int N, const float* gain, bf16_t* WT, MapF map, float* scr_, int item, int lane) {
    asm volatile("" : "+v"(lane));
    unsigned* scr = (unsigned*)scr_;
    const int nblk = (N + 63) / 64, kb = item / nblk, nb = item % nblk, k0 = 64 * kb, n0 = 64 * nb;
    const int x = lane & 15, kr = lane >> 4, nq = n0 + 4 * x;
    f32x4 e[8], o[8];
#pragma unroll
    for (int j = 0; j < 8; ++j) { const int k = k0 + 8 * j + 2 * kr;
        if (nq < N) { e[j] = *(const f32x4*)(W + (size_t)k * N + nq); o[j] = *(const f32x4*)(W + (size_t)(k + 1) * N + nq); } else { e[j] = (f32x4){0.f, 0.f, 0.f, 0.f}; o[j] = e[j]; } }
#pragma unroll
    for (int j = 0; j < 8; ++j) { const int k = k0 + 8 * j + 2 * kr; float ge = 1.f, go = 1.f; if (gain) { ge = gain[k]; go = gain[k + 1]; }
        u32x4 p; p.x = pk2(e[j].x * ge, o[j].x * go); p.y = pk2(e[j].y * ge, o[j].y * go); p.z = pk2(e[j].z * ge, o[j].z * go); p.w = pk2(e[j].w * ge, o[j].w * go);
        *(u32x4*)(scr + (4 * j + kr) * 68 + 4 * x) = p; }
    asm volatile("s_waitcnt lgkmcnt(0)" ::: "memory");
    const int c = lane >> 3;
#pragma unroll
    for (int j = 0; j < 8; ++j) { const int n = (lane & 7) + 8 * j; if (n0 + n < N) { const unsigned* t = scr + (4 * c) * 68 + n;
        const u32x4 v = {t[0], t[68], t[136], t[204]};
        *(u32x4*)(WT + (size_t)map(n0 + n) * K + k0 + 8 * c) = v; } }
    asm volatile("s_waitcnt lgkmcnt(0)" ::: "memory");
}
struct MapId { __device__ int operator()(int n) const { return n; } };
struct MapGate { __device__ int operator()(int n) const { return gu_row_gate(n); } };
struct MapUp { __device__ int operator()(int n) const { return gu_row_gate(n) + 128; } };
struct MapWin { __device__ int operator()(int n) const { return win_row(n); } };
struct MapWuq { __device__ int operator()(int n) const { return wuq_row(n); } };
struct MapWukv { __device__ int operator()(int n) const { return wukv_row(n); } };

__device__ __constant__ double INV_FREQ[16] = {1.0, 0.5623413251903491, 0.31622776601683794, 0.1778279410038923, 0.1, 0.05623413251903491, 0.03162277660168379, 0.01778279410038923,
                                               0.01, 0.005623413251903491, 0.0031622776601683794, 0.0017782794100389228, 0.001, 0.0005623413251903491, 0.00031622776601683794, 0.00017782794100389227};
__device__ __forceinline__ void sincos_d(double x, float& s, float& c) {
    const double k = rint(x * 0.15915494309189535); const double r = fma(-k, 6.283185307179586, x) - k * 2.4492935982947064e-16; const double r2 = r * r;
    double ss = 1.0 / 15511210043330985984000000.0, cc = 1.0 / 620448401733239439360000.0;
    const double sf[12] = {1.0 / 25852016738884976640000.0, 1.0 / 51090942171709440000.0, 1.0 / 121645100408832000.0, 1.0 / 355687428096000.0, 1.0 / 1307674368000.0, 1.0 / 6227020800.0, 1.0 / 39916800.0,
                           1.0 / 362880.0, 1.0 / 5040.0, 1.0 / 120.0, 1.0 / 6.0, 1.0};
    const double cf[12] = {1.0 / 1124000727777607680000.0, 1.0 / 2432902008176640000.0, 1.0 / 6402373705728000.0, 1.0 / 20922789888000.0, 1.0 / 87178291200.0, 1.0 / 479001600.0, 1.0 / 3628800.0,
                           1.0 / 40320.0, 1.0 / 720.0, 1.0 / 24.0, 1.0 / 2.0, 1.0};
#pragma unroll
    for (int i = 0; i < 12; ++i) { ss = fma(-ss, r2, sf[i]); cc = fma(-cc, r2, cf[i]); }
    s = (float)(ss * r); c = (float)cc;
}
__device__ __forceinline__ void rms_row_to_bf16(const float* xrow, bf16_t* orow, int lane) {
    const f32x4* xr = (const f32x4*)xrow + lane; f32x4 v[4]; float s = 0.f;
#pragma unroll
    for (int j = 0; j < 4; ++j) { v[j] = xr[64 * j]; s += (v[j].x * v[j].x + v[j].y * v[j].y) + (v[j].z * v[j].z + v[j].w * v[j].w); }
    const float rstd = 1.0f / sqrtf(wave_sum(s) * (1.f / D) + EPS);
    unsigned long long* o8 = (unsigned long long*)orow + lane;
#pragma unroll
    for (int j = 0; j < 4; ++j) o8[64 * j] = (unsigned long long)pk2(v[j].x * rstd, v[j].y * rstd) | ((unsigned long long)pk2(v[j].z * rstd, v[j].w * rstd) << 32);
}
__device__ __forceinline__ void rms_row2_to_bf16(const float* x0, const float* x1, bf16_t* o0, bf16_t* o1, int lane) {
    const f32x4* xa = (const f32x4*)x0 + lane; const f32x4* xb = (const f32x4*)x1 + lane; f32x4 va[4], vb[4]; float sa = 0.f, sb = 0.f;
#pragma unroll
    for (int j = 0; j < 4; ++j) { va[j] = xa[64 * j]; vb[j] = xb[64 * j]; }
#pragma unroll
    for (int j = 0; j < 4; ++j) { sa += (va[j].x * va[j].x + va[j].y * va[j].y) + (va[j].z * va[j].z + va[j].w * va[j].w); sb += (vb[j].x * vb[j].x + vb[j].y * vb[j].y) + (vb[j].z * vb[j].z + vb[j].w * vb[j].w); }
    const float ra = 1.0f / sqrtf(wave_sum(sa) * (1.f / D) + EPS), rb = 1.0f / sqrtf(wave_sum(sb) * (1.f / D) + EPS);
    unsigned long long* pa = (unsigned long long*)o0 + lane; unsigned long long* pb = (unsigned long long*)o1 + lane;
#pragma unroll
    for (int j = 0; j < 4; ++j) { pa[64 * j] = (unsigned long long)pk2(va[j].x * ra, va[j].y * ra) | ((unsigned long long)pk2(va[j].z * ra, va[j].w * ra) << 32);
                                  pb[64 * j] = (unsigned long long)pk2(vb[j].x * rb, vb[j].y * rb) | ((unsigned long long)pk2(vb[j].z * rb, vb[j].w * rb) << 32); }
}
template <int NR> __device__ __forceinline__ void rms_rows_load(const float* x, const int (&r)[NR], f32x4 (&v)[NR][4], int lane) {
#pragma unroll
    for (int i = 0; i < NR; ++i) { const f32x4* p = (const f32x4*)(x + (size_t)r[i] * D) + lane;
#pragma unroll
        for (int j = 0; j < 4; ++j) v[i][j] = p[64 * j]; }
}
template <int NR> __device__ __forceinline__ void rms_rows_finish(bf16_t* out, const int (&r)[NR], const f32x4 (&v)[NR][4], int lane) {
#pragma unroll
    for (int i = 0; i < NR; ++i) { float s = 0.f;
#pragma unroll
        for (int j = 0; j < 4; ++j) s += (v[i][j].x * v[i][j].x + v[i][j].y * v[i][j].y) + (v[i][j].z * v[i][j].z + v[i][j].w * v[i][j].w);
        const float rs = 1.0f / sqrtf(wave_sum(s) * (1.f / D) + EPS); unsigned long long* po = (unsigned long long*)(out + (size_t)r[i] * D) + lane;
#pragma unroll
        for (int j = 0; j < 4; ++j) po[64 * j] = (unsigned long long)pk2(v[i][j].x * rs, v[i][j].y * rs) | ((unsigned long long)pk2(v[i][j].z * rs, v[i][j].w * rs) << 32); }
}
constexpr int I_GU = (D / 64) * (FF / 64), I_DN = (FF / 64) * (D / 64), I_IN = (D / 64) * ((1960 + 63) / 64), I_OUT = (D / 64) * (D / 64), I_UQ = (256 / 64) * (768 / 64), I_UKV = (128 / 64) * (1024 / 64);
__device__ __forceinline__ void p0_prologue(const Ctx& C, float* scr, int gw, int gwi, int NGW, int lane) {
    const bool fast = NGW * 8 == M;
    f32x4 va[2][4]; const int ra[2] = {gw, gw + M / 2};
    if (fast) rms_rows_load<2>(C.x, ra, va, lane);
    for (int it = gwi; it < 2 * I_GU + I_DN + I_IN; it += NGW) {
        int r = it;
        if (r < I_GU) { p0_transpose_item(C.w1g, D, FF, C.g_ffn1, C.W1GU, MapGate(), scr, r, lane); continue; } r -= I_GU;
        if (r < I_GU) { p0_transpose_item(C.w1u, D, FF, C.g_ffn1, C.W1GU, MapUp(), scr, r, lane); continue; } r -= I_GU;
        if (r < I_DN) { p0_transpose_item(C.w1d, FF, D, nullptr, C.W1D, MapId(), scr, r, lane); continue; } r -= I_DN;
        p0_transpose_item(C.w_in, D, 1960, C.g_mix, C.WIN, MapWin(), scr, r, lane);
    }
    for (int i = gw * 64 + lane; i < 88 * 128; i += NGW * 64) { const int row = 256 + 168 + i / 128, ch = i % 128; *(u32x4*)(C.WIN + (size_t)row * D + ch * 8) = (u32x4){0u, 0u, 0u, 0u}; }
    if (fast) { f32x4 vb[4][4], vc[2][4]; const int rb[4] = {gw + NGW, gw + NGW + M / 2, gw + 2 * NGW, gw + 2 * NGW + M / 2}, rc[2] = {gw + 3 * NGW, gw + 3 * NGW + M / 2};
        rms_rows_load<4>(C.x, rb, vb, lane); rms_rows_finish<2>((bf16_t*)C.main.XN1, ra, va, lane);
        rms_rows_load<2>(C.x, rc, vc, lane); rms_rows_finish<4>((bf16_t*)C.main.XN1, rb, vb, lane); rms_rows_finish<2>((bf16_t*)C.main.XN1, rc, vc, lane); }
    else for (int m = gw; m < M / 2; m += NGW) rms_row2_to_bf16(C.x + (size_t)m * D, C.x + (size_t)(m + M / 2) * D, (bf16_t*)C.main.XN1 + (size_t)m * D, (bf16_t*)C.main.XN1 + (size_t)(m + M / 2) * D, lane);
    for (int m = gw; m < NMETA; m += NGW) rms_row_to_bf16(C.meta + (size_t)m * D, (bf16_t*)C.mt.XN1 + (size_t)m * D, lane);
    for (int i = gw * 64 + lane; i < NPOS * 16; i += NGW * 64) { const int pos = i >> 4, f = i & 15; float s, c; sincos_d((double)pos * INV_FREQ[f], s, c); C.ROPE[2 * i] = c; C.ROPE[2 * i + 1] = s; }
}
template <int PART> __device__ __forceinline__ void p0_late(const Ctx& C, float* scr, int gw, int NGW, int lane) {
    if (PART == 0) {
        for (int it = gw; it < I_OUT + I_UQ + I_UKV; it += NGW) {
            int r = it;
            if (r < I_OUT) { p0_transpose_item(C.w_out, D, D, nullptr, C.WOUT, MapId(), scr, r, lane); continue; } r -= I_OUT;
            if (r < I_UQ) { p0_transpose_item(C.w_uq, 256, 768, C.g_cq, C.WUQ, MapWuq(), scr, r, lane); continue; } r -= I_UQ;
            p0_transpose_item(C.w_ukv, 128, 1024, C.g_ckv, C.WUKV, MapWukv(), scr, r, lane);
        }
    } else {
        for (int it = gw; it < 2 * I_GU + I_DN; it += NGW) {
            int r = it;
            if (r < I_GU) { p0_transpose_item(C.w2g, D, FF, C.g_ffn2, C.W2GU, MapGate(), scr, r, lane); continue; } r -= I_GU;
            if (r < I_GU) { p0_transpose_item(C.w2u, D, FF, C.g_ffn2, C.W2GU, MapUp(), scr, r, lane); continue; } r -= I_GU;
            p0_transpose_item(C.w2d, FF, D, nullptr, C.W2D, MapId(), scr, r, lane);
        }
    }
}

template <int NT, int UNR>
__device__ __forceinline__ void wg_gemm16_steps(const bf16_t* ap, const bf16_t* const (&bp)[NT], int k0, f32x4 (&acc)[NT]) {
    bf16x8 a[UNR], b[UNR][NT];
#pragma unroll
    for (int u = 0; u < UNR; ++u) { a[u] = *(const bf16x8*)(ap + k0 + 32 * u);
#pragma unroll
        for (int t = 0; t < NT; ++t) b[u][t] = *(const bf16x8*)(bp[t] + k0 + 32 * u); }
#pragma unroll
    for (int u = 0; u < UNR; ++u)
#pragma unroll
        for (int t = 0; t < NT; ++t) acc[t] = __builtin_amdgcn_mfma_f32_16x16x32_bf16(a[u], b[u][t], acc[t], 0, 0, 0);
}
template <int NT, int NSPLIT, int UNR>
__device__ __forceinline__ void wg_gemm16(const bf16_t* ap, const bf16_t* const (&bp)[NT], int K, f32x4 (&acc)[NT], int wave, int lane, float* red) {
    const int ksl = K / NSPLIT, kb = wave * ksl, ke = kb + ksl;
    if (wave < NSPLIT) {
        int k0 = kb;
        for (; k0 + 32 * UNR <= ke; k0 += 32 * UNR) wg_gemm16_steps<NT, UNR>(ap, bp, k0, acc);
        { const int r = (ke - k0) >> 5;
          if (UNR > 3 && r == 3) wg_gemm16_steps<NT, 3>(ap, bp, k0, acc); else if (UNR > 2 && r == 2) wg_gemm16_steps<NT, 2>(ap, bp, k0, acc); else for (; k0 < ke; k0 += 32) wg_gemm16_steps<NT, 1>(ap, bp, k0, acc); }
#pragma unroll
        for (int t = 0; t < NT; ++t) *(f32x4*)(red + (size_t)((wave * NT + t) * 64 + lane) * 4) = acc[t];
    }
    __syncthreads();
    if (wave == 0) {
#pragma unroll
        for (int t = 0; t < NT; ++t) { f32x4 sum = *(const f32x4*)(red + (size_t)(t * 64 + lane) * 4);
#pragma unroll
            for (int w = 1; w < NSPLIT; ++w) sum += *(const f32x4*)(red + (size_t)((w * NT + t) * 64 + lane) * 4);
            acc[t] = sum; asm volatile("" ::: "memory"); }
    }
}
__device__ __forceinline__ void task_gateup(const bf16_t* A, const bf16_t* Wgu, const float* ssq, bf16_t* HB, int task, int lane, int wave, float* red) {
    asm volatile("" : "+v"(lane));
    const int ncb = FF / 16, rg = task / ncb, cb = task % ncb, c = lane & 15, q = lane >> 4, hc = cb * 16 + c;
    const bf16_t* ap = A + (size_t)(rg * 16 + c) * D + 8 * q;
    const bf16_t* g0 = Wgu + (size_t)gu_row_gate(hc) * D + 8 * q;
    const bf16_t* const bp[2] = {g0, g0 + (size_t)128 * D};
    f32x4 acc[2]; acc[0] = (f32x4){0.f, 0.f, 0.f, 0.f}; acc[1] = acc[0];
    wg_gemm16<2, 8, 4>(ap, bp, D, acc, wave, lane, red); if (wave != 0) return;
#pragma unroll
    for (int i = 0; i < 4; ++i) { const int row = rg * 16 + 4 * q + i; const float rs = ssq ? 1.0f / sqrtf(sum16f(ssq + (size_t)row * 16) * (1.f / D) + EPS) : 1.f;
        st_wt(HB + (size_t)row * FF + hc, (bf16_t)f2bf(silu_mul(acc[0][i] * rs, acc[1][i] * rs))); }
}
__device__ __forceinline__ void task_down(const bf16_t* A, int K, const bf16_t* Wt, const float* base, float* out, float scale, bf16_t* XN, float* SSQ, int task, int lane, int wave, float* red) {
    asm volatile("" : "+v"(lane));
    const int rg = task >> 4, cb = task & 15, c = lane & 15, q = lane >> 4;
    const bf16_t* ap = A + (size_t)(rg * 16 + c) * K + 8 * q;
    const bf16_t* b0 = Wt + (size_t)(cb * 64 + c) * K + 8 * q;
    const bf16_t* const bp[4] = {b0, b0 + (size_t)16 * K, b0 + (size_t)32 * K, b0 + (size_t)48 * K};
    f32x4 acc[4];
#pragma unroll
    for (int t = 0; t < 4; ++t) acc[t] = (f32x4){0.f, 0.f, 0.f, 0.f};
    wg_gemm16<4, 8, 4>(ap, bp, K, acc, wave, lane, red); if (wave != 0) return;
#pragma unroll
    for (int i = 0; i < 4; ++i) { const int row = rg * 16 + 4 * q + i; float sq = 0.f;
#pragma unroll
        for (int t = 0; t < 4; ++t) { const size_t o = (size_t)row * D + cb * 64 + t * 16 + c; const float v = base[o] + scale * acc[t][i]; st_wt(out + o, v); if (XN) st_wt(XN + o, (bf16_t)f2bf(v)); sq += v * v; }
        sq = rsum16(sq); if (SSQ && c == 0) st_wt(SSQ + (size_t)row * 16 + cb, sq); }
}
__device__ __forceinline__ void task_win(const Ctx& C, const RowSet& R, int rg, int job, int lane, int wave, float* red) {
    asm volatile("" : "+v"(lane));
    const int c = lane & 15, q = lane >> 4;
    const bf16_t* ap = R.XN + (size_t)(rg * 16 + c) * D + 8 * q;
    if (job == 0) {
        const bf16_t* bp[8];
#pragma unroll
        for (int t = 0; t < 8; ++t) bp[t] = C.WIN + (size_t)win_row(256 + 16 * t + c) * D + 8 * q;
        f32x4 acc[8];
#pragma unroll
        for (int t = 0; t < 8; ++t) acc[t] = (f32x4){0.f, 0.f, 0.f, 0.f};
        wg_gemm16<8, 8, 2>(ap, bp, D, acc, wave, lane, red); if (wave != 0) return;
#pragma unroll
        for (int i = 0; i < 4; ++i) { const int row = rg * 16 + 4 * q + i; const float rs = 1.0f / sqrtf(sum16f(R.SSQ1 + (size_t)row * 16) * (1.f / D) + EPS); float sq = 0.f;
#pragma unroll
            for (int t = 0; t < 8; ++t) { const float v = acc[t][i] * rs; sq += v * v; R.CKV[(size_t)row * 128 + 16 * t + c] = (bf16_t)f2bf(v); }
            sq = rsum16(sq); if (c == 0) *(f32x4*)(R.SSQCKV + (size_t)row * 4) = (f32x4){sq, 0.f, 0.f, 0.f}; }
    } else if (job == 1) {
        const bf16_t* bp[3];
#pragma unroll
        for (int t = 0; t < 2; ++t) bp[t] = C.WIN + (size_t)win_row(384 + 16 * t + c) * D + 8 * q;
        bp[2] = C.WIN + (size_t)(c < 8 ? win_row(1952 + c) : 256 + 168 + c) * D + 8 * q;
        f32x4 acc[3];
#pragma unroll
        for (int t = 0; t < 3; ++t) acc[t] = (f32x4){0.f, 0.f, 0.f, 0.f};
        wg_gemm16<3, 8, 4>(ap, bp, D, acc, wave, lane, red); if (wave != 0) return;
#pragma unroll
        for (int i = 0; i < 4; ++i) { const int row = rg * 16 + 4 * q + i; const float rs = 1.0f / sqrtf(sum16f(R.SSQ1 + (size_t)row * 16) * (1.f / D) + EPS); float sp = 0.f;
#pragma unroll
            for (int t = 0; t < 2; ++t) { const float v = acc[t][i] * rs; sp += v * v; R.KPE[(size_t)row * 32 + 16 * t + c] = v; }
            sp = rsum16(sp); if (c == 0) R.SSQKPE[row] = sp;
            if (c < 8) R.LOGF[(size_t)row * 8 + c] = log_sigmoid(acc[2][i] * rs + C.b_forget[c]); }
    } else {
        const int which = 1 + ((job - 2) >> 3), h = (job - 2) & 7;
        const bf16_t* bp[4];
#pragma unroll
        for (int t = 0; t < 4; ++t) bp[t] = C.WIN + (size_t)win_row(416 + which * 512 + h * 64 + 16 * t + c) * D + 8 * q;
        f32x4 acc[4];
#pragma unroll
        for (int t = 0; t < 4; ++t) acc[t] = (f32x4){0.f, 0.f, 0.f, 0.f};
        wg_gemm16<4, 8, 4>(ap, bp, D, acc, wave, lane, red); if (wave != 0) return;
#pragma unroll
        for (int i = 0; i < 4; ++i) { const int row = rg * 16 + 4 * q + i; const float rs = 1.0f / sqrtf(sum16f(R.SSQ1 + (size_t)row * 16) * (1.f / D) + EPS); float sq = 0.f; float v[4];
#pragma unroll
            for (int t = 0; t < 4; ++t) { v[t] = acc[t][i] * rs; sq += v[t] * v[t]; }
            sq = rsum16(sq); const float r = 1.0f / sqrtf(sq * (1.f / 64.f) + EPS);
#pragma unroll
            for (int t = 0; t < 4; ++t) { const int d = 16 * t + c;
                if (which == 1) C.MFK[(row * 8 + h) * 64 + d] = (bf16_t)f2bf(v[t] * r * C.g_k_fox[d]);
                else C.MFV[(row * 8 + h) * 64 + d] = (bf16_t)f2bf(v[t]); } }
    }
}
__device__ __forceinline__ void task_uqkv(const Ctx& C, const RowSet& R, int task, int lane, int wave, float* red) {
    asm volatile("" : "+v"(lane));
    const int rg = task >> 4, job = task & 15, h = job & 7, c = lane & 15, q = lane >> 4;
    int rows[4];
#pragma unroll
    for (int i = 0; i < 4; ++i) rows[i] = rg * 16 + 4 * q + i;
    {
        const bf16_t* ap = R.CKV + (size_t)(rg * 16 + c) * 128 + 8 * q;
        const bf16_t* bp[8];
#pragma unroll
        for (int t = 0; t < 8; ++t) bp[t] = C.WUKV + (size_t)wukv_row(h * 128 + 16 * t + c) * 128 + 8 * q;
        f32x4 acc[8];
#pragma unroll
        for (int t = 0; t < 8; ++t) acc[t] = (f32x4){0.f, 0.f, 0.f, 0.f};
        wg_gemm16<8, 4, 1>(ap, bp, 128, acc, wave, lane, red); if (wave != 0) return;
#pragma unroll
        for (int i = 0; i < 4; ++i) { const int row = rows[i]; const float rs = 1.0f / sqrtf(sum4f(R.SSQCKV + (size_t)row * 4) * (1.f / 128.f) + EPS);
            float v[8], s0 = 0.f;
#pragma unroll
            for (int t = 0; t < 8; ++t) { v[t] = acc[t][i] * rs; if (t < 4) s0 += v[t] * v[t]; }
            s0 = rsum16(s0); const float rk = 1.0f / sqrtf((s0 + R.SSQKPE[row]) * (1.f / 96.f) + EPS);
            const int p = R.meta ? 48 + row : 64 + (row & (T - 1)); const int b0 = R.meta ? 0 : row >> 13, b1 = R.meta ? 2 : b0 + 1;
            const float cs = C.ROPE[(size_t)(p - 48) * 32 + 2 * c], sn = C.ROPE[(size_t)(p - 48) * 32 + 2 * c + 1];
            const float x1 = R.KPE[(size_t)row * 32 + c] * rk * C.g_k_mla[64 + c], x2 = R.KPE[(size_t)row * 32 + 16 + c] * rk * C.g_k_mla[80 + c];
            for (int b = b0; b < b1; ++b) {
#pragma unroll
                for (int t = 0; t < 4; ++t) { C.KM[kaddr(b, h, p, 16 * t + c, DQM)] = (bf16_t)f2bf(v[t] * rk * C.g_k_mla[16 * t + c]); C.VM[vaddr(b, h, p, 16 * t + c)] = (bf16_t)f2bf(v[4 + t]); }
                C.KM[kaddr(b, h, p, 64 + c, DQM)] = (bf16_t)f2bf(x1 * cs - x2 * sn); C.KM[kaddr(b, h, p, 80 + c, DQM)] = (bf16_t)f2bf(x2 * cs + x1 * sn); } }
    }
}


namespace pg8 {
#define PG8_LAS __attribute__((address_space(3)))
typedef unsigned short bf16_t;
typedef short bf16x8 __attribute__((ext_vector_type(8)));
typedef float f32x4 __attribute__((ext_vector_type(4)));
typedef unsigned u32x4 __attribute__((ext_vector_type(4)));
constexpr int BM = 256, BK = 64, HALF = 128, HTB = HALF * BK * 2  , STAGE_BYTES = 8 * HTB, NXCD = 8, WGM = 8;

__host__ __device__ __forceinline__ int lds_byte(int r, int c) { const int st = (r >> 4) * 2 + (c >> 5), rr = r & 15, cc = c & 31, ob = rr * 64 + cc * 2; return st * 1024 + (ob ^ (((ob >> 9) & 1) << 5)); }
__host__ __device__ __forceinline__ void stage_rc(int b, int& R, int& C) { const int st = b / 1024, sb = b % 1024, swz = sb ^ (((sb >> 9) & 1) << 5); R = (st >> 1) * 16 + swz / 64; C = (st & 1) * 32 + (swz % 64) / 2; }
__host__ __device__ __forceinline__ int perm32(int rho) { const int n = rho >> 4, i = rho & 15; return 8 * (i >> 2) + 4 * n + (i & 3); }

struct Unit { int pm, pn, idx; };
struct Gemm { const bf16_t* A; const bf16_t* Bt; int M, N, K, lda; };

struct StaticOrder {
    int nM, nN, nwg, G, c, off, cnt;
    __host__ __device__ void init(int M, int N, int G_, int c_) { nM = M / BM; nN = N / BM; nwg = nM * nN; G = G_; c = c_; off = 0; cnt = 1 << 20; }
    __host__ __device__ bool next(int i, Unit& u) const {
        if (i >= cnt) return false; i += off;
        const long L = (long)i * G + c; if (L >= nwg) return false;
        int wgid = (int)L; { const int q = nwg / NXCD, r = nwg % NXCD, xcd = wgid % NXCD, off = wgid / NXCD; wgid = (xcd < r ? xcd * (q + 1) : r * (q + 1) + (xcd - r) * q) + off; }
        const int nig = WGM * nN, gid = wgid / nig, fm = gid * WGM, gsz = (nM - fm) < WGM ? (nM - fm) : WGM;
        u.pm = fm + ((wgid % nig) % gsz); u.pn = (wgid % nig) / gsz; u.idx = i; return true;
    }
    __device__ __forceinline__ void a_ready(const Unit&) const {}
    __device__ __forceinline__ void done(const Unit&) const {}
};
__device__ __forceinline__ unsigned cvt_pk_bf16(float lo, float hi) { unsigned r; asm volatile("v_cvt_pk_bf16_f32 %0, %1, %2" : "=v"(r) : "v"(lo), "v"(hi)); return r; }
typedef float f32x2 __attribute__((ext_vector_type(2)));
template <class Epi, class Sched, bool ALIGN_EPI = false, bool SP2 = false>
__device__ __forceinline__ void gemm_phase(PG8_LAS unsigned char* lds, const Gemm g, const Sched& S, const Epi& E, const int tid) {
    const int wid = __builtin_amdgcn_readfirstlane(tid >> 6), lane = tid & 63, wr = wid >> 2, wc = wid & 3, fr = lane & 15, fq = lane >> 4;
    const int K = g.K, nt = K / BK;
    unsigned voffA[2], voffB[2];
#pragma unroll
    for (int i = 0; i < 2; ++i) { int R, C; stage_rc(tid * 16 + i * 8192, R, C); const int Rb = Epi::PERM ? ((R & ~31) + perm32(R & 31)) : R;
        voffA[i] = (unsigned)(R * g.lda + C) * 2u; voffB[i] = (unsigned)(Rb * K + C) * 2u; }
    const size_t kstep = (size_t)(BK * 2);
    const size_t hstep = (size_t)HALF * K * 2, hstepA = (size_t)HALF * g.lda * 2;
    const size_t tstep = 2 * hstep, tstepA = 2 * hstepA;
    const unsigned ldsw = (unsigned)wid * 1024u;
    const int aoff = lds_byte(wr * 64 + fr, fq * 8), boff = lds_byte(wc * 32 + fr, fq * 8);
#define PG8_SA(b, h) (((b) * 2 + (h)) * HTB)
#define PG8_SB(b, h) ((4 + (b) * 2 + (h)) * HTB)
#define PG8_STAGE(bufoff, gbase, voff) do { _Pragma("unroll") for (int _i = 0; _i < 2; ++_i) \
        __builtin_amdgcn_global_load_lds((const unsigned*)((const char*)(gbase) + (voff)[_i]), (PG8_LAS unsigned*)(lds + (bufoff) + ldsw + _i * 8192), 16, 0, 0); } while (0)
#define PG8_LDA(dst, b, h) do { _Pragma("unroll") for (int m = 0; m < 4; ++m) _Pragma("unroll") for (int k = 0; k < 2; ++k) dst[m][k] = *(const PG8_LAS bf16x8*)(lds + PG8_SA(b, h) + aoff + m * 2048 + k * 1024); } while (0)
#define PG8_LDB(dst, b, h) do { _Pragma("unroll") for (int n = 0; n < 2; ++n) _Pragma("unroll") for (int k = 0; k < 2; ++k) dst[n][k] = *(const PG8_LAS bf16x8*)(lds + PG8_SB(b, h) + boff + n * 2048 + k * 1024); } while (0)
#define PG8_MMA(ai, bj, At, Bt) do { __builtin_amdgcn_s_setprio(1); _Pragma("unroll") for (int m = 0; m < 4; ++m) _Pragma("unroll") for (int n = 0; n < 2; ++n) _Pragma("unroll") for (int k = 0; k < 2; ++k) \
        acc[ai][bj][m][n] = __builtin_amdgcn_mfma_f32_16x16x32_bf16(Bt[n][k], At[m][k], acc[ai][bj][m][n], 0, 0, 0); __builtin_amdgcn_s_setprio(0); } while (0)
#define PG8_WAIT_V(n) asm volatile("s_waitcnt vmcnt(" #n ")" ::: "memory")
#define PG8_WAIT_L(n) asm volatile("s_waitcnt lgkmcnt(" #n ")" ::: "memory")
#define PG8_BAR __builtin_amdgcn_s_barrier()
#define PG8_SCHED __builtin_amdgcn_sched_barrier(0)
    Unit cur, nxt; int ui = 0;
    if (!S.next(0, cur)) return;
    f32x4 acc[2][2][4][2];
#pragma unroll
    for (int a = 0; a < 2; ++a)
#pragma unroll
        for (int b = 0; b < 2; ++b)
#pragma unroll
            for (int m = 0; m < 4; ++m)
#pragma unroll
                for (int n = 0; n < 2; ++n) acc[a][b][m][n] = (f32x4){0.f, 0.f, 0.f, 0.f};
    if constexpr (Epi::HAS_INIT) E.init(acc, cur, wr, wc, fr, fq);
    bf16x8 At[4][2], B0[2][2], B1[2][2];
    const char* cA = (const char*)g.A + (size_t)cur.pm * tstepA; const char* cB = (const char*)g.Bt + (size_t)cur.pn * tstep;
    S.a_ready(cur);
    if constexpr (SP2) {
        PG8_STAGE(PG8_SB(0, 0), cB, voffB); PG8_STAGE(PG8_SB(0, 1), cB + hstep, voffB); PG8_STAGE(PG8_SA(0, 0), cA, voffA); PG8_STAGE(PG8_SA(0, 1), cA + hstepA, voffA);
        if (wr == 1) PG8_BAR;
        PG8_WAIT_V(2); PG8_BAR;
        PG8_STAGE(PG8_SB(1, 0), cB + kstep, voffB); PG8_STAGE(PG8_SA(1, 0), cA + kstep, voffA); PG8_STAGE(PG8_SB(1, 1), cB + hstep + kstep, voffB);
        PG8_WAIT_V(6); PG8_BAR;
    } else {
        PG8_STAGE(PG8_SB(0, 0), cB, voffB); PG8_STAGE(PG8_SA(0, 0), cA, voffA); PG8_STAGE(PG8_SB(0, 1), cB + hstep, voffB); PG8_STAGE(PG8_SA(0, 1), cA + hstepA, voffA);
        if (wr == 1) PG8_BAR;
        PG8_WAIT_V(4); PG8_BAR;
        PG8_STAGE(PG8_SB(1, 0), cB + kstep, voffB); PG8_STAGE(PG8_SA(1, 0), cA + kstep, voffA); PG8_STAGE(PG8_SB(1, 1), cB + hstep + kstep, voffB);
        PG8_WAIT_V(6); PG8_BAR;
    }
    for (;;) {
        const bool has_next = S.next(ui + 1, nxt);
        const char* nA = has_next ? (const char*)g.A + (size_t)nxt.pm * tstepA : cA; const char* nB = has_next ? (const char*)g.Bt + (size_t)nxt.pn * tstep : cB;
        for (int t = 0; t < nt; t += 2) {
            const bool last = (t == nt - 2);
            const char* a1 = cA + (size_t)(t + 1) * kstep;
            const char* a2 = last ? nA : cA + (size_t)(t + 2) * kstep; const char* b2 = last ? nB : cB + (size_t)(t + 2) * kstep;
            const char* a3 = a2 + kstep; const char* b3 = b2 + kstep;
            if (last && has_next) S.a_ready(nxt);
            if constexpr (SP2) {
            PG8_LDB(B0, 0, 0); PG8_LDB(B1, 0, 1); PG8_SCHED; PG8_LDA(At, 0, 0); PG8_STAGE(PG8_SA(1, 1), a1 + hstepA, voffA);
            PG8_WAIT_V(8); PG8_WAIT_L(0); PG8_BAR; PG8_MMA(0, 0, At, B0); PG8_MMA(0, 1, At, B1); PG8_BAR; PG8_SCHED;
            PG8_LDA(At, 0, 1); PG8_STAGE(PG8_SB(0, 0), b2, voffB); PG8_STAGE(PG8_SB(0, 1), b2 + hstep, voffB); PG8_STAGE(PG8_SA(0, 0), a2, voffA);
            PG8_WAIT_V(8); PG8_WAIT_L(0); PG8_BAR; PG8_MMA(1, 0, At, B0); PG8_MMA(1, 1, At, B1); PG8_BAR; PG8_SCHED;
            PG8_LDB(B0, 1, 0); PG8_LDB(B1, 1, 1); PG8_SCHED; PG8_LDA(At, 1, 0); PG8_STAGE(PG8_SA(0, 1), a2 + hstepA, voffA);
            PG8_WAIT_V(8); PG8_WAIT_L(0); PG8_BAR; PG8_MMA(0, 0, At, B0); PG8_MMA(0, 1, At, B1); PG8_BAR; PG8_SCHED;
            PG8_LDA(At, 1, 1); PG8_STAGE(PG8_SB(1, 0), b3, voffB); PG8_STAGE(PG8_SB(1, 1), b3 + hstep, voffB); PG8_STAGE(PG8_SA(1, 0), a3, voffA);
            PG8_WAIT_V(8); PG8_WAIT_L(0); PG8_BAR; PG8_MMA(1, 0, At, B0); PG8_MMA(1, 1, At, B1); PG8_BAR; PG8_SCHED;
            } else {
            PG8_LDB(B0, 0, 0); PG8_SCHED; PG8_LDA(At, 0, 0); PG8_STAGE(PG8_SA(1, 1), a1 + hstepA, voffA);
            PG8_WAIT_L(8); PG8_BAR; PG8_WAIT_L(0); PG8_MMA(0, 0, At, B0); PG8_BAR; PG8_SCHED;
            PG8_LDB(B1, 0, 1); PG8_STAGE(PG8_SB(0, 0), b2, voffB);
            PG8_BAR; PG8_WAIT_L(0); PG8_MMA(0, 1, At, B1); PG8_BAR;
            PG8_LDA(At, 0, 1); PG8_STAGE(PG8_SA(0, 0), a2, voffA);
            PG8_BAR; PG8_WAIT_L(0); PG8_MMA(1, 0, At, B0); PG8_BAR; PG8_SCHED;
            PG8_STAGE(PG8_SB(0, 1), b2 + hstep, voffB);
            PG8_WAIT_V(6); PG8_BAR; PG8_MMA(1, 1, At, B1); PG8_BAR;
            PG8_LDB(B0, 1, 0); PG8_SCHED; PG8_LDA(At, 1, 0); PG8_STAGE(PG8_SA(0, 1), a2 + hstepA, voffA);
            PG8_WAIT_L(8); PG8_BAR; PG8_WAIT_L(0); PG8_MMA(0, 0, At, B0); PG8_BAR; PG8_SCHED;
            PG8_LDB(B1, 1, 1); PG8_STAGE(PG8_SB(1, 0), b3, voffB);
            PG8_BAR; PG8_WAIT_L(0); PG8_MMA(0, 1, At, B1); PG8_BAR;
            PG8_LDA(At, 1, 1); PG8_STAGE(PG8_SA(1, 0), a3, voffA);
            PG8_BAR; PG8_WAIT_L(0); PG8_MMA(1, 0, At, B0); PG8_BAR; PG8_SCHED;
            PG8_STAGE(PG8_SB(1, 1), b3 + hstep, voffB);
            PG8_WAIT_V(6); PG8_BAR; PG8_MMA(1, 1, At, B1); PG8_BAR;
            }
        }
        if constexpr (ALIGN_EPI) { if (wr == 0) PG8_BAR; }
        if constexpr (!Epi::AFTER_DRAIN) { E(acc, cur, wr, wc, fr, fq); S.done(cur); }
        if (!has_next) break;
#pragma unroll
        for (int a = 0; a < 2; ++a)
#pragma unroll
            for (int b = 0; b < 2; ++b)
#pragma unroll
                for (int m = 0; m < 4; ++m)
#pragma unroll
                    for (int n = 0; n < 2; ++n) acc[a][b][m][n] = (f32x4){0.f, 0.f, 0.f, 0.f};
        if constexpr (Epi::HAS_INIT) E.init(acc, nxt, wr, wc, fr, fq);
        cur = nxt; cA = nA; cB = nB; ++ui;
        if constexpr (ALIGN_EPI) { if (wr == 1) PG8_BAR; }
    }
    PG8_WAIT_V(0);
    if constexpr (!ALIGN_EPI) { if (wr == 0) PG8_BAR; }
    PG8_BAR;
    if constexpr (Epi::AFTER_DRAIN) { E.fused(acc, cur, wr, wc, fr, fq, lds, wid, lane); S.done(cur);
        PG8_WAIT_L(0); PG8_BAR; }
#undef PG8_SA
#undef PG8_SB
#undef PG8_STAGE
#undef PG8_LDA
#undef PG8_LDB
#undef PG8_MMA
#undef PG8_WAIT_V
#undef PG8_WAIT_L
#undef PG8_BAR
#undef PG8_SCHED
}
}

namespace pg8 {
__device__ __forceinline__ float fq_sum(float v) { v += __shfl_xor(v, 16); v += __shfl_xor(v, 32); return v; }
__device__ __forceinline__ u32x4 pack8(const f32x4& a, const f32x4& b) { u32x4 w; w.x = cvt_pk_bf16(a[0], a[1]); w.y = cvt_pk_bf16(a[2], a[3]); w.z = cvt_pk_bf16(b[0], b[1]); w.w = cvt_pk_bf16(b[2], b[3]); return w; }
__device__ __forceinline__ f32x4 silu4(const f32x4& g, const f32x4& u) { f32x4 o;
#pragma unroll
    for (int j = 0; j < 4; ++j) o[j] = g[j] * __builtin_amdgcn_rcpf(1.0f + __builtin_amdgcn_exp2f(-LOG2E * g[j])) * u[j];
    return o; }

template <int NP> __device__ __forceinline__ void rs_rows(const float* ssq, int row0, int fq, float inv_n, float (&rs)[2][4]) {
    f32x4 t[2][4];
#pragma unroll
    for (int ai = 0; ai < 2; ++ai)
#pragma unroll
        for (int m = 0; m < 4; ++m) t[ai][m] = *(const f32x4*)(ssq + (size_t)(row0 + ai * HALF + m * 16) * NP + (NP == 16 ? 4 * fq : 0));
#pragma unroll
    for (int ai = 0; ai < 2; ++ai)
#pragma unroll
        for (int m = 0; m < 4; ++m) { float v = (t[ai][m][0] + t[ai][m][1]) + (t[ai][m][2] + t[ai][m][3]); if (NP == 16) v = fq_sum(v); rs[ai][m] = __builtin_amdgcn_rsqf(v * inv_n + EPS); }
}
struct EpiSwiglu {
    static constexpr bool PERM = true, AFTER_DRAIN = false, HAS_INIT = false;
    bf16_t* HB; const PG8_LAS float* rs_lds;
    __device__ __forceinline__ void operator()(const f32x4 (&acc)[2][2][4][2], const Unit& u, int wr, int wc, int fr, int fq) const {
        const int col0 = u.pn * 128 + wc * 32 + 8 * fq, row0 = u.pm * BM + wr * 64 + fr;
        float rs[2][4];
#pragma unroll
        for (int ai = 0; ai < 2; ++ai)
#pragma unroll
            for (int m = 0; m < 4; ++m) rs[ai][m] = rs_lds ? rs_lds[u.idx * BM + ai * HALF + wr * 64 + m * 16 + fr] : 1.f;
#pragma unroll
        for (int ai = 0; ai < 2; ++ai)
#pragma unroll
            for (int m = 0; m < 4; ++m) { const int row = row0 + ai * HALF + m * 16; const float r = rs[ai][m];
                const f32x4 h0 = silu4(acc[ai][0][m][0] * r, acc[ai][1][m][0] * r), h1 = silu4(acc[ai][0][m][1] * r, acc[ai][1][m][1] * r);
                *(u32x4*)(HB + (size_t)row * FF + col0) = pack8(h0, h1); }
    }
};
template <class Sched> __device__ __forceinline__ void rs_table_fill(const float* ssq, const Sched& S, PG8_LAS float* table, int tid) {
    Unit u; int n = 0; while (S.next(n, u)) ++n;
    for (int e = tid; e < n * BM; e += 512) { S.next(e >> 8, u); table[e] = 1.0f / sqrtf(sum16f(ssq + (size_t)(u.pm * BM + (e & 255)) * 16) * (1.f / D) + EPS); }
    __syncthreads();
}
template <int HALF_SCALE, int BASE_BF16> struct EpiResid {
    static constexpr bool PERM = true, AFTER_DRAIN = false, HAS_INIT = true;
    const void* base; float* out; bf16_t* XN; float* SSQ;
    __device__ __forceinline__ void init(f32x4 (&acc)[2][2][4][2], const Unit& u, int wr, int wc, int fr, int fq) const {
        const int col0 = u.pn * BM + wc * 32 + 8 * fq; const float inv = HALF_SCALE ? 2.0f : 1.0f;
#pragma unroll
        for (int ai = 0; ai < 2; ++ai)
#pragma unroll
            for (int m = 0; m < 4; ++m) { const int row = u.pm * BM + ai * HALF + wr * 64 + m * 16 + fr;
#pragma unroll
                for (int bj = 0; bj < 2; ++bj) { const size_t o = (size_t)row * D + col0 + bj * HALF;
                    if (BASE_BF16) { const u32x4 w = *(const u32x4*)((const bf16_t*)base + o);
                        acc[ai][bj][m][0] = (f32x4){__uint_as_float(w.x << 16), __uint_as_float(w.x & 0xffff0000u), __uint_as_float(w.y << 16), __uint_as_float(w.y & 0xffff0000u)} * inv;
                        acc[ai][bj][m][1] = (f32x4){__uint_as_float(w.z << 16), __uint_as_float(w.z & 0xffff0000u), __uint_as_float(w.w << 16), __uint_as_float(w.w & 0xffff0000u)} * inv; }
                    else { acc[ai][bj][m][0] = *(const f32x4*)((const float*)base + o) * inv; acc[ai][bj][m][1] = *(const f32x4*)((const float*)base + o + 4) * inv; } } }
    }
    __device__ __forceinline__ void operator()(const f32x4 (&acc)[2][2][4][2], const Unit& u, int wr, int wc, int fr, int fq) const {
        const int col0 = u.pn * BM + wc * 32 + 8 * fq; const float scale = HALF_SCALE ? 0.5f : 1.0f;
#pragma unroll
        for (int ai = 0; ai < 2; ++ai)
#pragma unroll
            for (int m = 0; m < 4; ++m) { const int row = u.pm * BM + ai * HALF + wr * 64 + m * 16 + fr; float sq = 0.f;
#pragma unroll
                for (int bj = 0; bj < 2; ++bj) { const size_t o = (size_t)row * D + col0 + bj * HALF;
                    const f32x4 v0 = acc[ai][bj][m][0] * scale, v1 = acc[ai][bj][m][1] * scale;
                    if (out) { *(f32x4*)(out + o) = v0; *(f32x4*)(out + o + 4) = v1; }
                    if (XN) *(u32x4*)(XN + o) = pack8(v0, v1);
                    sq += (v0[0] * v0[0] + v0[1] * v0[1]) + (v0[2] * v0[2] + v0[3] * v0[3]) + (v1[0] * v1[0] + v1[1] * v1[1]) + (v1[2] * v1[2] + v1[3] * v1[3]); }
                if (SSQ) { sq = fq_sum(sq); if (fq == 0) SSQ[(size_t)row * 16 + u.pn * 4 + wc] = sq; } }
    }
};
struct EpiWin {
    static constexpr bool PERM = true, AFTER_DRAIN = false, HAS_INIT = false;
    Ctx C; const PG8_LAS float* rs_lds; const PG8_LAS float* gt;
    __device__ __forceinline__ void operator()(const f32x4 (&acc)[2][2][4][2], const Unit& u, int wr, int wc, int fr, int fq) const {
        const RowSet& R = C.main; const int pn = u.pn;
        f32x4 bfg[2]; if (pn == 1) { bfg[0] = *(const f32x4*)(C.b_forget); bfg[1] = *(const f32x4*)(C.b_forget + 4); }
        float rsr[2][4];
#pragma unroll
        for (int ai = 0; ai < 2; ++ai)
#pragma unroll
            for (int m = 0; m < 4; ++m) rsr[ai][m] = rs_lds[u.idx * BM + ai * HALF + wr * 64 + m * 16 + fr];
#pragma unroll
        for (int ai = 0; ai < 2; ++ai)
#pragma unroll
            for (int m = 0; m < 4; ++m) { const int row = u.pm * BM + ai * HALF + wr * 64 + m * 16 + fr; const float rs = rsr[ai][m];
                f32x4 v[2][2];
#pragma unroll
                for (int bj = 0; bj < 2; ++bj)
#pragma unroll
                    for (int n = 0; n < 2; ++n) v[bj][n] = acc[ai][bj][m][n] * rs;
                float sq[2];
#pragma unroll
                for (int bj = 0; bj < 2; ++bj) sq[bj] = (v[bj][0][0] * v[bj][0][0] + v[bj][0][1] * v[bj][0][1]) + (v[bj][0][2] * v[bj][0][2] + v[bj][0][3] * v[bj][0][3]) +
                                                        (v[bj][1][0] * v[bj][1][0] + v[bj][1][1] * v[bj][1][1]) + (v[bj][1][2] * v[bj][1][2] + v[bj][1][3] * v[bj][1][3]);
                if (pn == 0) {
#pragma unroll
                    for (int bj = 0; bj < 2; ++bj) *(u32x4*)(R.CQ + (size_t)row * 256 + bj * HALF + wc * 32 + 8 * fq) = pack8(v[bj][0], v[bj][1]);
                    const float s = fq_sum(sq[0] + sq[1]); if (fq == 0) R.SSQCQ[(size_t)row * 4 + wc] = s;
                } else if (pn == 1) {
                    *(u32x4*)(R.CKV + (size_t)row * 128 + wc * 32 + 8 * fq) = pack8(v[0][0], v[0][1]);
                    const float s = fq_sum(sq[0]); if (fq == 0) R.SSQCKV[(size_t)row * 4 + wc] = s;
                    if (wc == 0) { *(f32x4*)(R.KPE + (size_t)row * 32 + 4 * fq) = v[1][0]; *(f32x4*)(R.KPE + (size_t)row * 32 + 16 + 4 * fq) = v[1][1];
                        const float sp = fq_sum(sq[1]); if (fq == 0) R.SSQKPE[row] = sp; }
                    if (wc == 1 && fq == 0) { f32x4 l0, l1;
#pragma unroll
                        for (int j = 0; j < 4; ++j) { l0[j] = log_sigmoid(v[1][0][j] + bfg[0][j]); l1[j] = log_sigmoid(v[1][1][j] + bfg[1][j]); }
                        *(f32x4*)(R.LOGF + (size_t)row * 8) = l0; *(f32x4*)(R.LOGF + (size_t)row * 8 + 4) = l1; }
                } else {
                    const int which = (pn - 2) >> 1, h = ((pn - 2) & 1) * 4 + wc; const int b = row >> 13, p = 64 + (row & (T - 1));
                    if (which < 2) { const float r = __builtin_amdgcn_rsqf(fq_sum(sq[0] + sq[1]) * (1.f / 64.f) + EPS) * (which == 0 ? C2F : 1.f); const PG8_LAS float* g = gt + (which == 0 ? 0 : 64);
#pragma unroll
                        for (int bj = 0; bj < 2; ++bj) { v[bj][0] = v[bj][0] * *(const PG8_LAS f32x4*)(g + 32 * bj + 8 * fq) * r; v[bj][1] = v[bj][1] * *(const PG8_LAS f32x4*)(g + 32 * bj + 8 * fq + 4) * r; } }
#pragma unroll
                    for (int bj = 0; bj < 2; ++bj) { bf16_t* dst = (which == 0) ? C.FQ + arow(b, h, p) * 64 + 32 * bj + 8 * fq : (which == 1) ? C.FK + kaddr(b, h, p, 32 * bj + 8 * fq, DFK) : C.FV + vaddr(b, h, p, 32 * bj + 8 * fq);
                        *(u32x4*)dst = pack8(v[bj][0], v[bj][1]); }
                }
                if (m & 1) asm volatile("" ::: "memory"); }
    }
};
struct EpiUq {
    static constexpr bool PERM = true, AFTER_DRAIN = false, HAS_INIT = false;
    const PG8_LAS float* g_q_mla; const float* SSQCQ; float* SSQQ; bf16_t* QM; const float* ROPE;
    __device__ __forceinline__ void operator()(const f32x4 (&acc)[2][2][4][2], const Unit& u, int wr, int wc, int fr, int fq) const {
        const int pn = u.pn;
        float rsr[2][4]; rs_rows<4>(SSQCQ, u.pm * BM + wr * 64 + fr, fq, 1.f / 256.f, rsr);
#pragma unroll
        for (int ai = 0; ai < 2; ++ai)
#pragma unroll
            for (int m = 0; m < 4; ++m) { const int row = u.pm * BM + ai * HALF + wr * 64 + m * 16 + fr; const float rs = rsr[ai][m];
                const int b = row >> 13, p = 64 + (row & (T - 1));
                if (pn < 2) { const int h = pn * 4 + wc; bf16_t* dst = QM + arow(b, h, p) * DQM; float sq = 0.f;
#pragma unroll
                    for (int bj = 0; bj < 2; ++bj) { const f32x4 v0 = acc[ai][bj][m][0] * rs, v1 = acc[ai][bj][m][1] * rs;
                        sq += (v0[0] * v0[0] + v0[1] * v0[1]) + (v0[2] * v0[2] + v0[3] * v0[3]) + (v1[0] * v1[0] + v1[1] * v1[1]) + (v1[2] * v1[2] + v1[3] * v1[3]);
                        const f32x4 g0 = *(const PG8_LAS f32x4*)(g_q_mla + 32 * bj + 8 * fq), g1 = *(const PG8_LAS f32x4*)(g_q_mla + 32 * bj + 8 * fq + 4);
                        *(u32x4*)(dst + 32 * bj + 8 * fq) = pack8(v0 * g0, v1 * g1); }
                    sq = fq_sum(sq); if (fq == 0) SSQQ[(size_t)row * 16 + 2 * h] = sq;
                } else { const float* rp = ROPE + ((size_t)(p - 48) * 16 + 4 * fq) * 2; const f32x4 t0 = *(const f32x4*)rp, t1 = *(const f32x4*)(rp + 4);
                    const f32x4 cs = {t0[0], t0[2], t1[0], t1[2]}, sn = {t0[1], t0[3], t1[1], t1[3]};
                    const f32x4 g0 = *(const PG8_LAS f32x4*)(g_q_mla + 64 + 4 * fq), g1 = *(const PG8_LAS f32x4*)(g_q_mla + 80 + 4 * fq);
#pragma unroll
                    for (int bj = 0; bj < 2; ++bj) { const int h = 2 * wc + bj; const f32x4 v0 = acc[ai][bj][m][0] * rs, v1 = acc[ai][bj][m][1] * rs;
                        float sq = (v0[0] * v0[0] + v0[1] * v0[1]) + (v0[2] * v0[2] + v0[3] * v0[3]) + (v1[0] * v1[0] + v1[1] * v1[1]) + (v1[2] * v1[2] + v1[3] * v1[3]);
                        sq = fq_sum(sq); if (fq == 0) SSQQ[(size_t)row * 16 + 2 * h + 1] = sq;
                        const f32x4 y1 = v0 * g0, y2 = v1 * g1; const f32x4 o1 = y1 * cs - y2 * sn, o2 = y2 * cs + y1 * sn;
                        bf16_t* dst = QM + arow(b, h, p) * DQM; u32x2 w1, w2; w1.x = cvt_pk_bf16(o1[0], o1[1]); w1.y = cvt_pk_bf16(o1[2], o1[3]); w2.x = cvt_pk_bf16(o2[0], o2[1]); w2.y = cvt_pk_bf16(o2[2], o2[3]);
                        *(u32x2*)(dst + 64 + 4 * fq) = w1; *(u32x2*)(dst + 80 + 4 * fq) = w2; } }
                if (m & 1) asm volatile("" ::: "memory"); }
    }
};
struct EpiUkv {
    static constexpr bool PERM = true, AFTER_DRAIN = false, HAS_INIT = false;
    const PG8_LAS float* g_k_mla; const float* SSQCKV; const float* SSQKPE; const float* KPE; bf16_t* KM; bf16_t* VM; const float* ROPE;
    __device__ __forceinline__ void operator()(const f32x4 (&acc)[2][2][4][2], const Unit& u, int wr, int wc, int fr, int fq) const {
        const int pn = u.pn, h = (pn & 1) * 4 + wc;
        float rsr[2][4]; rs_rows<4>(SSQCKV, u.pm * BM + wr * 64 + fr, fq, 1.f / 128.f, rsr);
#pragma unroll
        for (int ai = 0; ai < 2; ++ai)
#pragma unroll
            for (int m = 0; m < 4; ++m) { const int row = u.pm * BM + ai * HALF + wr * 64 + m * 16 + fr; const float rs = rsr[ai][m];
                const int b = row >> 13, p = 64 + (row & (T - 1));
                if (pn < 2) { float sq = 0.f;
#pragma unroll
                    for (int bj = 0; bj < 2; ++bj)
#pragma unroll
                        for (int n = 0; n < 2; ++n) { const f32x4 v = acc[ai][bj][m][n] * rs; sq += (v[0] * v[0] + v[1] * v[1]) + (v[2] * v[2] + v[3] * v[3]); }
                    const float rk = __builtin_amdgcn_rsqf((fq_sum(sq) + SSQKPE[row]) * (1.f / 96.f) + EPS); const float rr = rs * rk;
#pragma unroll
                    for (int bj = 0; bj < 2; ++bj) { const f32x4 g0 = *(const PG8_LAS f32x4*)(g_k_mla + 32 * bj + 8 * fq), g1 = *(const PG8_LAS f32x4*)(g_k_mla + 32 * bj + 8 * fq + 4);
                        *(u32x4*)(KM + kaddr(b, h, p, 32 * bj + 8 * fq, DQM)) = pack8(acc[ai][bj][m][0] * g0 * rr, acc[ai][bj][m][1] * g1 * rr); }
                    const float* rp = ROPE + ((size_t)(p - 48) * 16 + 4 * fq) * 2; const f32x4 t0 = *(const f32x4*)rp, t1 = *(const f32x4*)(rp + 4);
                    const f32x4 cs = {t0[0], t0[2], t1[0], t1[2]}, sn = {t0[1], t0[3], t1[1], t1[3]};
                    const f32x4 y1 = *(const f32x4*)(KPE + (size_t)row * 32 + 4 * fq) * *(const PG8_LAS f32x4*)(g_k_mla + 64 + 4 * fq) * rk, y2 = *(const f32x4*)(KPE + (size_t)row * 32 + 16 + 4 * fq) * *(const PG8_LAS f32x4*)(g_k_mla + 80 + 4 * fq) * rk;
                    const f32x4 o1 = y1 * cs - y2 * sn, o2 = y2 * cs + y1 * sn; u32x2 w1, w2; w1.x = cvt_pk_bf16(o1[0], o1[1]); w1.y = cvt_pk_bf16(o1[2], o1[3]); w2.x = cvt_pk_bf16(o2[0], o2[1]); w2.y = cvt_pk_bf16(o2[2], o2[3]);
                    *(u32x2*)(KM + kaddr(b, h, p, 64 + 4 * fq, DQM)) = w1; *(u32x2*)(KM + kaddr(b, h, p, 80 + 4 * fq, DQM)) = w2;
                } else {
#pragma unroll
                    for (int bj = 0; bj < 2; ++bj) *(u32x4*)(VM + vaddr(b, h, p, 32 * bj + 8 * fq)) = pack8(acc[ai][bj][m][0] * rs, acc[ai][bj][m][1] * rs); }
                if (m & 1) asm volatile("" ::: "memory"); }
    }
};
}

namespace pg8 {
constexpr int FS_ROWF = 36;
__device__ __forceinline__ void fused_stage(PG8_LAS unsigned char* lds, const float* ssq4, float inv_n, const float* ssqkpe, const float* kpe, const float* rope, int row0, bool want_rope, int wid, int lane) {
    PG8_LAS float* RS = (PG8_LAS float*)lds; PG8_LAS float* SK = RS + 256; PG8_LAS float* KP = RS + 512; PG8_LAS float* RP = KP + 256 * FS_ROWF;
    const int tid = wid * 64 + lane, r = tid >> 1, hf = tid & 1, row = row0 + r, p = 64 + (row & (T - 1));
    f32x4 a[4], c[4]; f32x4 q4 = {0.f, 0.f, 0.f, 0.f}; float sk = 0.f;
#pragma unroll
    for (int i = 0; i < 4; ++i) { a[i] = (f32x4){0.f, 0.f, 0.f, 0.f}; c[i] = a[i]; }
    if (want_rope) {
#pragma unroll
        for (int i = 0; i < 4; ++i) { c[i] = *(const f32x4*)(rope + (size_t)(p - 48) * 32 + 16 * hf + 4 * i); if (kpe) a[i] = *(const f32x4*)(kpe + (size_t)row * 32 + 16 * hf + 4 * i); } }
    if (hf == 0) { q4 = *(const f32x4*)(ssq4 + (size_t)row * 4); if (ssqkpe) sk = ssqkpe[row]; }
    if (want_rope) {
#pragma unroll
        for (int i = 0; i < 4; ++i) { *(PG8_LAS f32x4*)(RP + r * FS_ROWF + 16 * hf + 4 * i) = c[i]; if (kpe) *(PG8_LAS f32x4*)(KP + r * FS_ROWF + 16 * hf + 4 * i) = a[i]; } }
    if (hf == 0) { RS[r] = __builtin_amdgcn_rsqf(((q4[0] + q4[1]) + (q4[2] + q4[3])) * inv_n + EPS); SK[r] = sk; }
    asm volatile("s_waitcnt vmcnt(0) lgkmcnt(0)" ::: "memory"); __builtin_amdgcn_s_barrier(); asm volatile("" ::: "memory");
}
struct EpiUkvF {
    static constexpr bool PERM = true, AFTER_DRAIN = true, HAS_INIT = false;
    const PG8_LAS float* g_k_mla; const float* SSQCKV; const float* SSQKPE; const float* KPE; bf16_t* KM; bf16_t* VM; const float* ROPE;
    __device__ __forceinline__ void fused(const f32x4 (&acc)[2][2][4][2], const Unit& u, int wr, int wc, int fr, int fq, PG8_LAS unsigned char* lds, int wid, int lane) const {
        const int pn = u.pn, h = (pn & 1) * 4 + wc;
        fused_stage(lds, SSQCKV, 1.f / 128.f, SSQKPE, KPE, ROPE, u.pm * BM, pn < 2, wid, lane);
        const PG8_LAS float* RS = (const PG8_LAS float*)lds; const PG8_LAS float* SK = RS + 256; const PG8_LAS float* KP = RS + 512; const PG8_LAS float* RP = KP + 256 * FS_ROWF;
#pragma unroll
        for (int ai = 0; ai < 2; ++ai)
#pragma unroll
            for (int m = 0; m < 4; ++m) { const int rr = ai * HALF + wr * 64 + m * 16 + fr, row = u.pm * BM + rr; const float rs = RS[rr];
                const int b = row >> 13, p = 64 + (row & (T - 1));
                if (pn < 2) { float sq = 0.f;
#pragma unroll
                    for (int bj = 0; bj < 2; ++bj)
#pragma unroll
                        for (int n = 0; n < 2; ++n) { const f32x4 v = acc[ai][bj][m][n] * rs; sq += (v[0] * v[0] + v[1] * v[1]) + (v[2] * v[2] + v[3] * v[3]); }
                    const float rk = __builtin_amdgcn_rsqf((fq_sum(sq) + SK[rr]) * (1.f / 96.f) + EPS); const float rrk = rs * rk;
#pragma unroll
                    for (int bj = 0; bj < 2; ++bj) { const f32x4 g0 = *(const PG8_LAS f32x4*)(g_k_mla + 32 * bj + 8 * fq), g1 = *(const PG8_LAS f32x4*)(g_k_mla + 32 * bj + 8 * fq + 4);
                        *(u32x4*)(KM + kaddr(b, h, p, 32 * bj + 8 * fq, DQM)) = pack8(acc[ai][bj][m][0] * g0 * rrk, acc[ai][bj][m][1] * g1 * rrk); }
                    const f32x4 t0 = *(const PG8_LAS f32x4*)(RP + rr * FS_ROWF + 8 * fq), t1 = *(const PG8_LAS f32x4*)(RP + rr * FS_ROWF + 8 * fq + 4);
                    const f32x4 cs = {t0[0], t0[2], t1[0], t1[2]}, sn = {t0[1], t0[3], t1[1], t1[3]};
                    const f32x4 y1 = *(const PG8_LAS f32x4*)(KP + rr * FS_ROWF + 4 * fq) * *(const PG8_LAS f32x4*)(g_k_mla + 64 + 4 * fq) * rk, y2 = *(const PG8_LAS f32x4*)(KP + rr * FS_ROWF + 16 + 4 * fq) * *(const PG8_LAS f32x4*)(g_k_mla + 80 + 4 * fq) * rk;
                    const f32x4 o1 = y1 * cs - y2 * sn, o2 = y2 * cs + y1 * sn; u32x2 w1, w2; w1.x = cvt_pk_bf16(o1[0], o1[1]); w1.y = cvt_pk_bf16(o1[2], o1[3]); w2.x = cvt_pk_bf16(o2[0], o2[1]); w2.y = cvt_pk_bf16(o2[2], o2[3]);
                    *(u32x2*)(KM + kaddr(b, h, p, 64 + 4 * fq, DQM)) = w1; *(u32x2*)(KM + kaddr(b, h, p, 80 + 4 * fq, DQM)) = w2;
                } else {
#pragma unroll
                    for (int bj = 0; bj < 2; ++bj) *(u32x4*)(VM + vaddr(b, h, p, 32 * bj + 8 * fq)) = pack8(acc[ai][bj][m][0] * rs, acc[ai][bj][m][1] * rs); }
                if (m & 1) asm volatile("" ::: "memory"); }
    }
};
struct EpiUqF {
    static constexpr bool PERM = true, AFTER_DRAIN = true, HAS_INIT = false;
    const PG8_LAS float* g_q_mla; const float* SSQCQ; float* SSQQ; bf16_t* QM; const float* ROPE;
    __device__ __forceinline__ void fused(const f32x4 (&acc)[2][2][4][2], const Unit& u, int wr, int wc, int fr, int fq, PG8_LAS unsigned char* lds, int wid, int lane) const {
        const int pn = u.pn;
        fused_stage(lds, SSQCQ, 1.f / 256.f, nullptr, nullptr, ROPE, u.pm * BM, pn == 2, wid, lane);
        const PG8_LAS float* RS = (const PG8_LAS float*)lds; const PG8_LAS float* RP = RS + 512 + 256 * FS_ROWF;
#pragma unroll
        for (int ai = 0; ai < 2; ++ai)
#pragma unroll
            for (int m = 0; m < 4; ++m) { const int rr = ai * HALF + wr * 64 + m * 16 + fr, row = u.pm * BM + rr; const float rs = RS[rr];
                const int b = row >> 13, p = 64 + (row & (T - 1));
                if (pn < 2) { const int h = pn * 4 + wc; bf16_t* dst = QM + arow(b, h, p) * DQM; float sq = 0.f;
#pragma unroll
                    for (int bj = 0; bj < 2; ++bj) { const f32x4 v0 = acc[ai][bj][m][0] * rs, v1 = acc[ai][bj][m][1] * rs;
                        sq += (v0[0] * v0[0] + v0[1] * v0[1]) + (v0[2] * v0[2] + v0[3] * v0[3]) + (v1[0] * v1[0] + v1[1] * v1[1]) + (v1[2] * v1[2] + v1[3] * v1[3]);
                        const f32x4 g0 = *(const PG8_LAS f32x4*)(g_q_mla + 32 * bj + 8 * fq), g1 = *(const PG8_LAS f32x4*)(g_q_mla + 32 * bj + 8 * fq + 4);
                        *(u32x4*)(dst + 32 * bj + 8 * fq) = pack8(v0 * g0, v1 * g1); }
                    sq = fq_sum(sq); if (fq == 0) SSQQ[(size_t)row * 16 + 2 * h] = sq;
                } else { const f32x4 t0 = *(const PG8_LAS f32x4*)(RP + rr * FS_ROWF + 8 * fq), t1 = *(const PG8_LAS f32x4*)(RP + rr * FS_ROWF + 8 * fq + 4);
                    const f32x4 cs = {t0[0], t0[2], t1[0], t1[2]}, sn = {t0[1], t0[3], t1[1], t1[3]};
                    const f32x4 g0 = *(const PG8_LAS f32x4*)(g_q_mla + 64 + 4 * fq), g1 = *(const PG8_LAS f32x4*)(g_q_mla + 80 + 4 * fq);
#pragma unroll
                    for (int bj = 0; bj < 2; ++bj) { const int h = 2 * wc + bj; const f32x4 v0 = acc[ai][bj][m][0] * rs, v1 = acc[ai][bj][m][1] * rs;
                        float sq = (v0[0] * v0[0] + v0[1] * v0[1]) + (v0[2] * v0[2] + v0[3] * v0[3]) + (v1[0] * v1[0] + v1[1] * v1[1]) + (v1[2] * v1[2] + v1[3] * v1[3]);
                        sq = fq_sum(sq); if (fq == 0) SSQQ[(size_t)row * 16 + 2 * h + 1] = sq;
                        const f32x4 y1 = v0 * g0, y2 = v1 * g1; const f32x4 o1 = y1 * cs - y2 * sn, o2 = y2 * cs + y1 * sn;
                        bf16_t* dst = QM + arow(b, h, p) * DQM; u32x2 w1, w2; w1.x = cvt_pk_bf16(o1[0], o1[1]); w1.y = cvt_pk_bf16(o1[2], o1[3]); w2.x = cvt_pk_bf16(o2[0], o2[1]); w2.y = cvt_pk_bf16(o2[2], o2[3]);
                        *(u32x2*)(dst + 64 + 4 * fq) = w1; *(u32x2*)(dst + 80 + 4 * fq) = w2; } }
                if (m & 1) asm volatile("" ::: "memory"); }
    }
};
}


namespace att {
typedef short s16x4 __attribute__((ext_vector_type(4)));
typedef float f32x16 __attribute__((ext_vector_type(16)));
constexpr int NW = 8, QBLK = 32, QB = QBLK * NW, KVBLK = 64;
constexpr int KSLOT = 12288, NKSLOT = 4, VSLOT = 8192, NVSLOT = 3;
constexpr int LDS_K = 0, LDS_V = NKSLOT * KSLOT, LDS_WS = LDS_V + NVSLOT * VSLOT, LDS_OST = LDS_WS + NW * 256, LDS_BYTES = LDS_OST + NW * 4096;
__device__ __forceinline__ int crow(int r, int hi) { return (r & 3) + 8 * (r >> 2) + 4 * hi; }
#define SBAR() __builtin_amdgcn_sched_barrier(0)
__device__ __forceinline__ void cmask(f32x16& p0, f32x16& p1, int jb, int qrel, int hi) {
    const float NEG = -INFINITY; const int kb = 64 * jb + 4 * hi;
#pragma unroll
    for (int r = 0; r < 16; ++r) { const int kv = kb + (r & 3) + 8 * (r >> 2); if (kv > qrel) p0[r] = NEG; if (kv + 32 > qrel) p1[r] = NEG; }
}
__device__ __forceinline__ void glds16(const void* gsrc, unsigned lds_dst) { unsigned keep;
    asm volatile("s_mov_b32 %0, m0\n\ts_mov_b32 m0, %2\n\ts_nop 0\n\tglobal_load_lds_dwordx4 %1, off\n\ts_mov_b32 m0, %0" : "=&s"(keep) : "v"(gsrc), "s"(lds_dst) : "memory"); }
typedef float f32x2_t __attribute__((ext_vector_type(2))); typedef __bf16 bf16x2_t __attribute__((ext_vector_type(2)));
__device__ __forceinline__ unsigned cvtpk_s(float lo, float hi) { f32x2_t v = {lo, hi}; bf16x2_t b = __builtin_convertvector(v, bf16x2_t); return __builtin_bit_cast(unsigned, b); }
#define WAIT_BAR(N) asm volatile("s_waitcnt vmcnt(" #N ") lgkmcnt(0)\n\ts_barrier" ::: "memory")
typedef __attribute__((address_space(3))) const char* lds_cptr;
typedef short v4i16_t __attribute__((ext_vector_type(4)));
#define LDSV8(p) (*(const __attribute__((address_space(3))) bf16x8*)(p))
__device__ __forceinline__ void kload2(bf16x8* kf, lds_cptr kp, int j) { kf[2 * j] = LDSV8(kp + j * 2048); kf[2 * j + 1] = LDSV8(kp + j * 2048 + 512); }
__device__ __forceinline__ s16x4 vtr(lds_cptr p) { return __builtin_bit_cast(s16x4, __builtin_amdgcn_ds_read_tr16_b64_v4i16((__attribute__((address_space(3))) v4i16_t*)p)); }
#define MX3(a, b, c) __builtin_fmaxf(__builtin_fmaxf((a), (b)), (c))
__device__ __forceinline__ float rowmax(const f32x16& p0, const f32x16& p1) {
    float a = MX3(p0[0], p0[1], p1[0]), b = MX3(p0[2], p0[3], p1[1]); a = MX3(a, p1[2], p1[3]);
#pragma unroll
    for (int r = 4; r < 16; r += 4) { a = MX3(a, p0[r], p0[r + 1]); b = MX3(b, p0[r + 2], p0[r + 3]); a = MX3(a, p1[r], p1[r + 1]); b = MX3(b, p1[r + 2], p1[r + 3]); }
    float m = __builtin_fmaxf(a, b); auto rr = __builtin_amdgcn_permlane32_swap(__float_as_uint(m), __float_as_uint(m), false, false);
    return __builtin_fmaxf(__uint_as_float(rr[0]), __uint_as_float(rr[1])); }
__device__ __forceinline__ void pv(f32x16* o, int vb, bf16x8 pa0, bf16x8 pa1, bf16x8 pa2, bf16x8 pa3) {
#pragma unroll
    for (int d0 = 0; d0 < 2; ++d0) { s16x4 lo[4], hi[4];
#pragma unroll
        for (int ks = 0; ks < 4; ++ks) {
            asm volatile("ds_read_b64_tr_b16 %0,%1 offset:%c2" : "=&v"(lo[ks]) : "v"(vb), "i"(d0 * 4096 + ks * 1024) : "memory");
            asm volatile("ds_read_b64_tr_b16 %0,%1 offset:%c2" : "=&v"(hi[ks]) : "v"(vb), "i"(d0 * 4096 + ks * 1024 + 512) : "memory"); }
        asm volatile("s_waitcnt lgkmcnt(0)" ::: "memory"); SBAR();
#define PK(k) (bf16x8){lo[k][0], lo[k][1], lo[k][2], lo[k][3], hi[k][0], hi[k][1], hi[k][2], hi[k][3]}
        o[d0] = __builtin_amdgcn_mfma_f32_32x32x16_bf16(pa0, PK(0), o[d0], 0, 0, 0);
        o[d0] = __builtin_amdgcn_mfma_f32_32x32x16_bf16(pa1, PK(1), o[d0], 0, 0, 0);
        o[d0] = __builtin_amdgcn_mfma_f32_32x32x16_bf16(pa2, PK(2), o[d0], 0, 0, 0);
        o[d0] = __builtin_amdgcn_mfma_f32_32x32x16_bf16(pa3, PK(3), o[d0], 0, 0, 0);
#undef PK
    }
}
#ifndef ATTN_STORE16
#define ATTN_STORE16(p, v) (*(u32x4*)(p) = (v))
#endif
#define MFMA32(a, b, c) __builtin_amdgcn_mfma_f32_32x32x16_bf16(a, b, c, 0, 0, 0)
template <int NKS, bool FOX, int THRL>
__device__ __forceinline__ void attn_unit(int b, int h, int qb, const bf16_t* Qb, const bf16_t* __restrict__ Kb, const bf16_t* __restrict__ Vb, const float* aux, bf16_t* O, int ocol, char* shm, float m0, int tb, unsigned* qhead, unsigned& pre) {
    constexpr int DK = NKS * 16, NX = NKS * 2 - 8;
    int tid = threadIdx.x; asm volatile("" : "+v"(tid));
    const int lane = tid & 63, r32 = lane & 31, hi = lane >> 5; const int wid = __builtin_amdgcn_readfirstlane(tid >> 6);
    const size_t hb = (size_t)(b * 8 + h) * PR; const int q0 = qb * QB;
    if (wid >= 4) __builtin_amdgcn_s_setprio(1);
    const bf16_t* Kh = Kb + (hb + (size_t)(64 * tb)) * DK; const bf16_t* Vh = Vb + (hb + (size_t)(64 * tb)) * 64;
    const unsigned lds0 = (unsigned)(uintptr_t)shm;
    float* wsf = (float*)(shm + LDS_WS) + wid * 64;
    const bf16_t* ksrc1 = Kh + wid * 512 + lane * 8;
    const bf16_t* ksrc2 = Kh + 4096 + wid * NX * 64 + lane * 8;
    const bf16_t* vsrc = Vh + wid * 512 + lane * 8;
    const unsigned kdst1 = lds0 + LDS_K + wid * 1024, kdst2 = lds0 + LDS_K + 8192 + wid * NX * 128, vdst = lds0 + LDS_V + wid * 1024;
    const bool x2 = lane < NX * 8;
#define DMA_K(t, slot) do { glds16(ksrc1 + (size_t)(t) * KVBLK * DK, (unsigned)__builtin_amdgcn_readfirstlane(kdst1 + (slot))); if (x2) glds16(ksrc2 + (size_t)(t) * KVBLK * DK, (unsigned)__builtin_amdgcn_readfirstlane(kdst2 + (slot))); } while (0)
#define DMA_V(t, slot) glds16(vsrc + (size_t)(t) * KVBLK * 64, (unsigned)__builtin_amdgcn_readfirstlane(vdst + (slot)))
    const int vb0 = (int)(lds0 + LDS_V) + ((lane >> 4) & 1) * 32 + (lane & 3) * 8 + (4 * hi + ((lane & 15) >> 2)) * 64;
    bf16x8 kf[12];
    const lds_cptr shm3 = (lds_cptr)shm; const lds_cptr kp0 = shm3 + LDS_K + hi * 1024 + r32 * 16; const lds_cptr vp0 = shm3 + LDS_V + ((lane >> 4) & 1) * 32 + (lane & 3) * 8 + (4 * hi + ((lane & 15) >> 2)) * 64;
    const int NT = 4 * qb + 5 - tb;
    DMA_K(0, 0); DMA_V(0, 0); DMA_K(1, KSLOT);
    bf16x8 qr[NKS]; float cqv = 0.f;
    { const int prow = 64 + q0 + wid * QBLK + r32; const bf16_t* Qrow = Qb + (hb + prow) * (FOX ? 64 : 96);
      if (FOX) {
#pragma unroll
          for (int d0 = 0; d0 < 4; ++d0) qr[d0] = *(const bf16x8*)(Qrow + d0 * 16 + hi * 8);
          const short one = hi ? (short)0 : (short)0x3f80; qr[NKS - 1] = (bf16x8){one, one, one, 0, 0, 0, 0, 0};
          cqv = aux[hb + prow] * LOG2E;
      } else { const int row = b * T + q0 + wid * QBLK + r32; const float rq = C2M / sqrtf((aux[(size_t)row * 16 + 2 * h] + aux[(size_t)row * 16 + 2 * h + 1]) * (1.f / 96.f) + EPS);
#pragma unroll
          for (int d0 = 0; d0 < NKS; ++d0) { const bf16x8 raw = *(const bf16x8*)(Qrow + d0 * 16 + hi * 8); u32x4 w;
#pragma unroll
              for (int j = 0; j < 4; ++j) w[j] = cvtpk_s(bf2f((bf16_t)raw[2 * j]) * rq, bf2f((bf16_t)raw[2 * j + 1]) * rq);
              qr[d0] = __builtin_bit_cast(bf16x8, w); } } }
    float mhat = 0.f, l_reg = 0.f; f32x16 o[2]; o[0] = f32x16{}; o[1] = f32x16{}; f32x16 negm;
#pragma unroll
    for (int r = 0; r < 16; ++r) negm[r] = cqv;
    asm volatile("" : "+v"(negm));
    const int qrel = wid * QBLK + r32;
#define CMASK(P0, P1, t) do { int jb_ = (t) - (NT - 4); if (jb_ >= 0) cmask(P0, P1, jb_, qrel, hi); } while (0)
    bool resc = false; const bool bounded = m0 < 40.f;
#define RESC() do { if (resc) { asm volatile("s_waitcnt lgkmcnt(0)" ::: "memory"); \
        _Pragma("unroll") for (int d_ = 0; d_ < 2; ++d_) _Pragma("unroll") for (int r = 0; r < 16; ++r) o[d_][r] *= wsf[crow(r, hi)]; } } while (0)
    f32x16 pA0, pA1, pB0, pB1;
    int ks_prev = 3 * KSLOT, ks_cur = 0, ks_next = KSLOT, vs_prev = 2 * VSLOT, vs_cur = 0, vs_next = VSLOT;
#define ROT() do { ks_prev = ks_cur; ks_cur = ks_next; ks_next = (ks_next == (NKSLOT - 1) * KSLOT) ? 0 : ks_next + KSLOT; vs_prev = vs_cur; vs_cur = vs_next; vs_next = (vs_next == (NVSLOT - 1) * VSLOT) ? 0 : vs_next + VSLOT; } while (0)
    DMA_K(2, 2 * KSLOT);
    WAIT_BAR(2);
    { const lds_cptr kb = kp0;
#pragma unroll
      for (int d0 = 0; d0 < NKS; ++d0) { const bf16x8 b0 = LDSV8(kb + d0 * 2048), b1 = LDSV8(kb + d0 * 2048 + 512);
          if (d0 == 0) { pB0 = MFMA32(b0, qr[0], negm); pB1 = MFMA32(b1, qr[0], negm); } else { pB0 = MFMA32(b0, qr[d0], pB0); pB1 = MFMA32(b1, qr[d0], pB1); } }
      if (tb == 0) {
#pragma unroll
          for (int r = 0; r < 16; ++r) pB0[r] = -INFINITY;
#pragma unroll
          for (int r = 0; r < 8; ++r) pB1[r] = -INFINITY; }
      const float rm = bounded ? m0 : rowmax(pB0, pB1); mhat = rm;
#pragma unroll
      for (int r = 0; r < 16; ++r) { pB0[r] = __builtin_amdgcn_exp2f(pB0[r] - rm); pB1[r] = __builtin_amdgcn_exp2f(pB1[r] - rm); }
#pragma unroll
      for (int r = 0; r < 16; ++r) negm[r] = cqv - mhat;
      asm volatile("" : "+v"(negm)); }
    WAIT_BAR(0);
    DMA_K(3, ks_prev); DMA_V(1, vs_next);
    ROT();
    kload2(kf, kp0 + ks_cur, 0); kload2(kf, kp0 + ks_cur, 1);
    s16x4 vlo[8], vhi[8]; u32x4 pw0, pw1, pw2, pw3;
#define PKW(P, B) cvtpk_s(P[B], P[B + 1])
#define PAF(k) __builtin_bit_cast(bf16x8, pw##k)
#define VFR(i) (bf16x8){vlo[i][0], vlo[i][1], vlo[i][2], vlo[i][3], vhi[i][0], vhi[i][1], vhi[i][2], vhi[i][3]}
#define PIN(x) asm volatile("" : "+v"(x))
#define GAPA(MF, A0, A1, A2, A3, W0, W1, PW) do { MF; sacc += A0; sacc += A1; sacc += A2; sacc += A3; PIN(sacc); W0; W1; PIN(PW); SBAR(); } while (0)
#define EX(v) __builtin_amdgcn_exp2f(v)
#define GAPB(MF, X, B) do { MF; X[B] = EX(X[B]); X[B + 1] = EX(X[B + 1]); X[B + 2] = EX(X[B + 2]); X[B + 3] = EX(X[B + 3]); PIN(X); SBAR(); } while (0)
#define VRD(i) do { vlo[i] = vtr(vp_ + (((i) >> 2) * 4096 + ((i) & 3) * 1024)); vhi[i] = vtr(vp_ + (((i) >> 2) * 4096 + ((i) & 3) * 1024 + 512)); } while (0)
#define KRD(G, j) do { if (G) { kload2(kf, kp0 + ks_next, j); SBAR(); } } while (0)
#define KLD(f) do { kf[f] = LDSV8(kx_ + ((f) >> 1) * 2048 + ((f) & 1) * 512); } while (0)
#define STEP(C0, C1, P0, P1, t, GK, GV, GL) do { SBAR(); \
    const lds_cptr vp_ = vp0 + vs_prev; const lds_cptr kx_ = kp0 + ks_cur; \
    VRD(0); KLD(4); SBAR(); float sacc = (P0[0] + P0[1]); \
    GAPA(C0 = MFMA32(kf[0], qr[0], negm), P0[2], P0[3], P0[4], P0[5],     pw0[0] = PKW(P0, 0), pw0[1] = PKW(P0, 2), pw0); \
    VRD(4); KLD(5); SBAR(); GAPA(C1 = MFMA32(kf[1], qr[0], negm), P0[6], P0[7], P0[8], P0[9],     pw0[2] = PKW(P0, 4), pw0[3] = PKW(P0, 6), pw0); \
    VRD(1); KLD(6); SBAR(); GAPA(C0 = MFMA32(kf[2], qr[1], C0),   P0[10], P0[11], P0[12], P0[13], pw1[0] = PKW(P0, 8), pw1[1] = PKW(P0, 10), pw1); \
    VRD(5); KLD(7); SBAR(); GAPA(C1 = MFMA32(kf[3], qr[1], C1),   P0[14], P0[15], P1[0], P1[1],   pw1[2] = PKW(P0, 12), pw1[3] = PKW(P0, 14), pw1); \
    VRD(2); KLD(8); SBAR(); GAPA(C0 = MFMA32(kf[4], qr[2], C0),   P1[2], P1[3], P1[4], P1[5],     pw2[0] = PKW(P1, 0), pw2[1] = PKW(P1, 2), pw2); \
    VRD(6); KLD(9); SBAR(); GAPA(C1 = MFMA32(kf[5], qr[2], C1),   P1[6], P1[7], P1[8], P1[9],     pw2[2] = PKW(P1, 4), pw2[3] = PKW(P1, 6), pw2); \
    VRD(3); if (NKS == 6) KLD(10); SBAR(); GAPA(C0 = MFMA32(kf[6], qr[3], C0),   P1[10], P1[11], P1[12], P1[13], pw3[0] = PKW(P1, 8), pw3[1] = PKW(P1, 10), pw3); \
    VRD(7); if (NKS == 6) KLD(11); SBAR(); GAPA(C1 = MFMA32(kf[7], qr[3], C1),   P1[14], P1[15], 0.f, 0.f,       pw3[2] = PKW(P1, 12), pw3[3] = PKW(P1, 14), pw3); \
    C0 = MFMA32(kf[8], qr[4], C0); C1 = MFMA32(kf[9], qr[4], C1); if (NKS == 6) { C0 = MFMA32(kf[10], qr[NKS - 1], C0); C1 = MFMA32(kf[11], qr[NKS - 1], C1); } \
    l_reg += sacc; \
    if (GK) { DMA_K((t) + 3, ks_prev); } if (GV) { DMA_V((t) + 1, vs_next); } \
    CMASK(C0, C1, t); \
    resc = false; \
    if (!bounded) { float a = MX3(C0[0], C0[1], C1[0]), b_ = MX3(C0[2], C0[3], C1[1]); a = MX3(a, C1[2], C1[3]); \
      _Pragma("unroll") for (int r = 4; r < 16; r += 4) { a = MX3(a, C0[r], C0[r + 1]); b_ = MX3(b_, C0[r + 2], C0[r + 3]); a = MX3(a, C1[r], C1[r + 1]); b_ = MX3(b_, C1[r + 2], C1[r + 3]); } \
      float rm = __builtin_fmaxf(a, b_); { auto rr = __builtin_amdgcn_permlane32_swap(__float_as_uint(rm), __float_as_uint(rm), false, false); rm = __builtin_fmaxf(__uint_as_float(rr[0]), __uint_as_float(rr[1])); } \
      if (__builtin_expect(__any(rm > (float)THRL), 0)) { const float dl = __builtin_fmaxf(rm, 0.f); mhat += dl; \
        _Pragma("unroll") for (int r = 0; r < 16; ++r) { C0[r] -= dl; C1[r] -= dl; } \
        _Pragma("unroll") for (int r = 0; r < 16; ++r) negm[r] = cqv - mhat; asm volatile("" : "+v"(negm)); \
        const float f = __builtin_amdgcn_exp2f(-dl); l_reg *= f; if (hi == 0) wsf[r32] = f; resc = true; } } \
    SBAR(); \
    GAPB(o[0] = MFMA32(PAF(0), VFR(0), o[0]), C0, 0); \
    GAPB(o[1] = MFMA32(PAF(0), VFR(4), o[1]), C0, 4); \
    KRD(GL, 0); GAPB(o[0] = MFMA32(PAF(1), VFR(1), o[0]), C0, 8); \
    KRD(GL, 1); GAPB(o[1] = MFMA32(PAF(1), VFR(5), o[1]), C0, 12); \
    GAPB(o[0] = MFMA32(PAF(2), VFR(2), o[0]), C1, 0); \
    GAPB(o[1] = MFMA32(PAF(2), VFR(6), o[1]), C1, 4); \
    GAPB(o[0] = MFMA32(PAF(3), VFR(3), o[0]), C1, 8); \
    GAPB(o[1] = MFMA32(PAF(3), VFR(7), o[1]), C1, 12); \
    } while (0)
#define ENDW(tt) do { if ((tt) + 3 < NT) { WAIT_BAR(3); } else if ((tt) + 2 < NT) { WAIT_BAR(1); } else { WAIT_BAR(0); } } while (0)
    WAIT_BAR(3);
    STEP(pA0, pA1, pB0, pB1, 1, true, true, true); ENDW(1); RESC(); ROT();
    int t = 2;
#undef CMASK
#define CMASK(P0, P1, t) do { } while (0)
    for (; t + 5 < NT; t += 2) {
        STEP(pB0, pB1, pA0, pA1, t, true, true, true);     WAIT_BAR(3); RESC(); ROT();
        STEP(pA0, pA1, pB0, pB1, t + 1, true, true, true); WAIT_BAR(3); RESC(); ROT();
    }
    if (qhead != nullptr && threadIdx.x == 0) pre = __hip_atomic_fetch_add(qhead, 1u, __ATOMIC_RELAXED, __HIP_MEMORY_SCOPE_AGENT);
#undef CMASK
#define CMASK(P0, P1, t) do { int jb_ = (t) - (NT - 4); if (jb_ >= 0) cmask(P0, P1, jb_, qrel, hi); } while (0)
    for (; t + 1 < NT; t += 2) {
        STEP(pB0, pB1, pA0, pA1, t, (t + 3 < NT), (t + 1 < NT), (t + 1 < NT));         ENDW(t);     RESC(); ROT();
        STEP(pA0, pA1, pB0, pB1, t + 1, (t + 4 < NT), (t + 2 < NT), (t + 2 < NT));     ENDW(t + 1); RESC(); ROT();
    }
    STEP(pB0, pB1, pA0, pA1, NT - 1, false, false, false); RESC();
    { float sacc = pB0[0] + pB0[1];
#pragma unroll
      for (int r = 2; r < 16; ++r) sacc += pB0[r];
#pragma unroll
      for (int r = 0; r < 16; ++r) sacc += pB1[r];
      l_reg += sacc;
      pw0 = (u32x4){PKW(pB0, 0), PKW(pB0, 2), PKW(pB0, 4), PKW(pB0, 6)}; pw1 = (u32x4){PKW(pB0, 8), PKW(pB0, 10), PKW(pB0, 12), PKW(pB0, 14)};
      pw2 = (u32x4){PKW(pB1, 0), PKW(pB1, 2), PKW(pB1, 4), PKW(pB1, 6)}; pw3 = (u32x4){PKW(pB1, 8), PKW(pB1, 10), PKW(pB1, 12), PKW(pB1, 14)};
      SBAR(); pv(o, vb0 + vs_cur, PAF(0), PAF(1), PAF(2), PAF(3)); }
#undef PKW
#undef PAF
#undef VFR
#undef PIN
#undef GAPA
#undef GAPB
#undef EX
#undef VRD
#undef KRD
#undef STEP
#undef KLD
#undef ENDW
    { auto rr = __builtin_amdgcn_permlane32_swap(__float_as_uint(l_reg), __float_as_uint(l_reg), false, false); l_reg = __uint_as_float(rr[0]) + __uint_as_float(rr[1]); }
    if (hi == 0) wsf[32 + r32] = l_reg; asm volatile("s_waitcnt lgkmcnt(0)" ::: "memory");
    float rli[16];
#pragma unroll
    for (int r = 0; r < 16; ++r) rli[r] = __builtin_amdgcn_rcpf(wsf[32 + crow(r, hi)]);
    bf16_t* Ow = O + (size_t)(b * T + q0 + wid * QBLK) * D + ocol;
    { bf16_t* stg = (bf16_t*)(shm + LDS_OST) + wid * 2048;
#pragma unroll
      for (int r = 0; r < 16; ++r) { const int orow = crow(r, hi);
#pragma unroll
          for (int d0 = 0; d0 < 2; ++d0) stg[orow * 64 + d0 * 32 + r32] = (bf16_t)f2bf(o[d0][r] * rli[r]); }
      asm volatile("s_waitcnt lgkmcnt(0)" ::: "memory");
#pragma unroll
      for (int i = 0; i < 4; ++i) { const int row = i * 8 + (lane >> 3), ch = lane & 7; const u32x4 v = *(const u32x4*)(stg + row * 64 + ch * 8); ATTN_STORE16(Ow + (size_t)row * D + ch * 8, v); } }
    asm volatile("s_waitcnt lgkmcnt(0)\n\ts_barrier" ::: "memory");
    __builtin_amdgcn_s_setprio(0);
#undef DMA_K
#undef DMA_V
#undef CMASK
#undef RESC
#undef ROT
}
#undef SBAR
#undef WAIT_BAR
#undef MFMA32
#undef MX3
#undef LDSV8
}
__device__ __forceinline__ float fox_bound(const Ctx& C) {
    const int l = threadIdx.x & 63; float c = fabsf(C.g_q_fox[l]), d = fabsf(C.g_k_fox[l]);
#pragma unroll
    for (int o = 1; o < 64; o <<= 1) { c = fmaxf(c, __shfl_xor(c, o)); d = fmaxf(d, __shfl_xor(d, o)); }
    return 8.0f * c * d * LOG2E * 1.02f;
}
__device__ __forceinline__ int fox_first_tile(const Ctx& C, int bh, int qb, float prune) {
    const int lane = threadIdx.x & 63, cand = 2 * lane; const size_t hb = (size_t)bh * PR;
    bool ok = cand <= 4 * qb;
    if (ok && cand > 0) ok = (C.CUM[hb + 64 + 256 * qb] - C.CUM[hb + 64 * cand - 1]) * LOG2E < prune;
    const unsigned long long m = __ballot(ok); return __builtin_amdgcn_readfirstlane(2 * (63 - __builtin_clzll(m)));
}
constexpr int CW_QATT = 13312, CW_QCONV = CW_QATT + 64 * 8;
__device__ __forceinline__ int wg_dequeue(unsigned* head, volatile __attribute__((address_space(3))) unsigned* slot) {
    __syncthreads();
    if (threadIdx.x == 0) *slot = __hip_atomic_fetch_add(head, 1u, __ATOMIC_RELAXED, __HIP_MEMORY_SCOPE_AGENT);
    __syncthreads();
    return (int)*slot;
}
__device__ __forceinline__ void attn_phase(const Ctx& C, char* shm, unsigned* ctl, unsigned xcc, volatile __attribute__((address_space(3))) unsigned* slot) {
    float m0_mla, m0_fox;
    { const int l = threadIdx.x & 63; float a = fmaxf(fabsf(C.g_q_mla[l]), l < 32 ? fabsf(C.g_q_mla[64 + l]) : 0.f), b2 = fmaxf(fabsf(C.g_k_mla[l]), l < 32 ? fabsf(C.g_k_mla[64 + l]) : 0.f), c = fabsf(C.g_q_fox[l]), d = fabsf(C.g_k_fox[l]);
#pragma unroll
      for (int o = 1; o < 64; o <<= 1) { a = fmaxf(a, __shfl_xor(a, o)); b2 = fmaxf(b2, __shfl_xor(b2, o)); c = fmaxf(c, __shfl_xor(c, o)); d = fmaxf(d, __shfl_xor(d, o)); }
      m0_mla = 9.797958971f * a * b2 * LOG2E * 1.02f; m0_fox = 8.0f * c * d * LOG2E * 1.02f; }
    unsigned short* const qkey = (unsigned short*)(shm + 122880); unsigned char* const qord = (unsigned char*)(shm + 122880 + 2048);
    static_assert(att::LDS_BYTES <= 122880 && 122880 + 2048 + 1024 <= 131072, "order tables");
    for (int e = threadIdx.x; e < 1024; e += 512) { const int g = e >> 7, i = e & 127, fox = i >> 6, j = i & 63, st = 4 * g + 2 * (j & 1) + fox, qb = 31 - (j >> 1);
        qkey[e] = (unsigned short)(fox ? 9 * (4 * qb + 5 - C.FOXTB[(st >> 1) * 32 + qb]) : 10 * (4 * qb + 5)); }
    __syncthreads();
    for (int e = threadIdx.x; e < 1024; e += 512) { const int g = e >> 7, i = e & 127; const unsigned mine = qkey[e]; int r = 0;
        for (int k = 0; k < 128; ++k) { const unsigned o = qkey[g * 128 + k]; r += (o > mine || (o == mine && k < i)) ? 1 : 0; }
        qord[g * 128 + r] = (unsigned char)i; }
    __syncthreads();
    unsigned pre = 128u;
    if (threadIdx.x == 0) pre = __hip_atomic_fetch_add(ctl + CW_QATT + 64 * (int)(xcc & 7u), 1u, __ATOMIC_RELAXED, __HIP_MEMORY_SCOPE_AGENT);
    for (bool own = true;;) {
        __syncthreads();
        if (threadIdx.x == 0) { int grp = (int)(xcc & 7u); unsigned tk = 128u;
            if (own) tk = pre;
            if (tk >= 128u) { unsigned hd[8];
#pragma unroll
                for (int g = 0; g < 8; ++g) hd[g] = __hip_atomic_load(ctl + CW_QATT + 64 * g, __ATOMIC_RELAXED, __HIP_MEMORY_SCOPE_AGENT);
                int pick = -1;
#pragma unroll
                for (int g = 7; g >= 0; --g) { const int gg = (int)((xcc + 1u + (unsigned)g) & 7u); unsigned hv = 0u;
#pragma unroll
                    for (int q = 0; q < 8; ++q) hv = (q == gg) ? hd[q] : hv;
                    if (hv < 128u) pick = gg; }
                if (pick >= 0) { grp = pick; tk = __hip_atomic_fetch_add(ctl + CW_QATT + 64 * grp, 1u, __ATOMIC_RELAXED, __HIP_MEMORY_SCOPE_AGENT); } else tk = 0xffffu; }
            *slot = (tk << 8) | (unsigned)grp; }
        __syncthreads();
        const unsigned sv = *slot; const int grp = (int)(sv & 7u); int i = (int)(sv >> 8);
        if (i >= 0xffff) break;
        if (i >= 128) { own = false; continue; }
        if (grp != (int)(xcc & 7u)) own = false;
        unsigned* const qhead = own ? ctl + CW_QATT + 64 * grp : nullptr;
        {
            i = qord[grp * 128 + i];
            const int fox = i >> 6, j = i & 63, st = 4 * grp + 2 * (j & 1) + fox, qb = 31 - (j >> 1), bh = st >> 1, b = bh >> 3, h = bh & 7;
            if (!fox) att::attn_unit<6, false, 8>(b, h, qb, C.QM, C.KM, C.VM, C.main.SSQQ, C.O, h * 64, shm, m0_mla, 0, qhead, pre);
            else att::attn_unit<5, true, 8>(b, h, qb, C.FQ, C.FK, C.FV, C.CUM, C.O, 512 + h * 64, shm, m0_fox, __builtin_amdgcn_readfirstlane(C.FOXTB[bh * 32 + qb]), qhead, pre); } }
    constexpr int NCHUNK = (2 * I_GU + I_DN + 7) / 8;
    for (;;) { const int c = wg_dequeue(ctl + CW_QCONV, slot); if (c >= NCHUNK) break;
        const int w_ = __builtin_amdgcn_readfirstlane(threadIdx.x >> 6); p0_late<1>(C, (float*)shm + w_ * TSCR, c * 8 + w_, NCHUNK * 8, threadIdx.x & 63); }
}
#define LAS __attribute__((address_space(3)))
constexpr int CW_BAR = 1024;
constexpr size_t CTL_ZERO_BYTES = 65536;
constexpr int LDSCTL_OFF = 131072, MISC_OFF = LDSCTL_OFF + 320;
#define XB_TMO      128
#define XB_XCNT(j)  (256  + 64 * (j))
#define XB_XSUB(j)  (1280 + 64 * (j))
#define XB_XGEN(j)  (2304 + 64 * (j))
#define XB_TOP      3328
#define XB_TOPGEN   3392
#define XCD_BAR_WORDS 3456
#define XB_SPIN_CAP (1u << 18)

__device__ __forceinline__ unsigned xb_ld(unsigned* p)              { return __hip_atomic_load(p, __ATOMIC_RELAXED, __HIP_MEMORY_SCOPE_AGENT); }
__device__ __forceinline__ unsigned xb_add(unsigned* p, unsigned v) { return __hip_atomic_fetch_add(p, v, __ATOMIC_RELAXED, __HIP_MEMORY_SCOPE_AGENT); }
__device__ __forceinline__ unsigned xb_xcc_id() { return (unsigned)__builtin_amdgcn_s_getreg((3 << 11) | 20) & 0xFu; }
#define XB_SPIN(cond, bar) do { unsigned _sp = 0; while (cond) { __builtin_amdgcn_s_sleep(1); \
    if ((++_sp & 255u) == 0u) { if (xb_ld(&(bar)[XB_TMO])) break; if (_sp > XB_SPIN_CAP) { atomicAdd(&(bar)[XB_TMO], 1u); break; } } } } while (0)

constexpr int CW_SIDE = 12288;
__device__ __forceinline__ void side_wait(unsigned* w, unsigned target, unsigned* bar) {
    if (threadIdx.x == 0) { XB_SPIN(xb_ld(w) < target, bar); __builtin_amdgcn_fence(__ATOMIC_ACQUIRE, "agent"); asm volatile("s_waitcnt vmcnt(0)" ::: "memory"); }
    __syncthreads();
}
struct XcdBarrier {
    unsigned* bar; unsigned x;
    volatile LAS unsigned* st;
};

__device__ __forceinline__ XcdBarrier xcd_barrier_post(unsigned* bar, volatile LAS unsigned* st) {
    XcdBarrier b; b.bar = bar; b.x = xb_xcc_id(); b.st = st;
    if (threadIdx.x == 0) st[2] = xb_add(&bar[XB_XCNT(b.x)], 1u);
    return b;
}
__device__ __forceinline__ void xcd_barrier_complete(unsigned* bar, unsigned x, unsigned& nloc, unsigned& nx, unsigned& even) {
    const unsigned G = gridDim.x * gridDim.y * gridDim.z;
    unsigned sum, cnt, mine, mx, hi, sp = 0u;
    for (;;) {
        sum = 0u; cnt = 0u; mine = 0u; mx = 0u; hi = 0u;
#pragma unroll
        for (unsigned j = 0; j < 16; ++j) { const unsigned c = xb_ld(&bar[XB_XCNT(j)]); sum += c; cnt += (c > 0u) ? 1u : 0u; mine = (j == x) ? c : mine; mx = c > mx ? c : mx; hi += (j >= 8u) ? c : 0u; }
        if (sum == G) break;
        __builtin_amdgcn_s_sleep(1);
        if ((++sp & 255u) == 0u) { if (xb_ld(&bar[XB_TMO])) break; if (sp > XB_SPIN_CAP) { atomicAdd(&bar[XB_TMO], 1u); break; } }
    }
    nloc = mine > 0u ? mine : 1u; nx = cnt > 0u ? cnt : 1u; even = (sum == G && cnt == 8u && mx * 8u == G && hi == 0u) ? 1u : 0u;
}

__device__ __forceinline__ void xcd_barrier(const XcdBarrier& b) {
    asm volatile("s_waitcnt vmcnt(0)" ::: "memory");
    __syncthreads();
    if (threadIdx.x == 0) {
        unsigned* bar = b.bar;
        __builtin_amdgcn_s_waitcnt(0);
        unsigned nloc = b.st[0], nx = b.st[1];
        if (nloc == 0u) { unsigned even; xcd_barrier_complete(bar, b.x, nloc, nx, even); b.st[0] = nloc; b.st[1] = nx; b.st[3] = even; }
        const unsigned old = xb_add(&bar[XB_XSUB(b.x)], 1u);
        const unsigned gen = old / nloc;
        if (old + 1u == (gen + 1u) * nloc) {
            __builtin_amdgcn_fence(__ATOMIC_RELEASE, "agent");
            asm volatile("s_waitcnt vmcnt(0)" ::: "memory");
            const unsigned og = xb_add(&bar[XB_TOP], 1u);
            const unsigned tg = og / nx;
            if (og + 1u == (tg + 1u) * nx) xb_add(&bar[XB_TOPGEN], 1u);
            else XB_SPIN(xb_ld(&bar[XB_TOPGEN]) == tg, bar);
            __builtin_amdgcn_fence(__ATOMIC_ACQUIRE, "agent");
            xb_add(&bar[XB_XGEN(b.x)], 1u);
            asm volatile("s_waitcnt vmcnt(0)" ::: "memory");
        } else {
            XB_SPIN(xb_ld(&bar[XB_XGEN(b.x)]) == gen, bar);
            __builtin_amdgcn_fence(__ATOMIC_ACQUIRE, "agent");
            asm volatile("s_waitcnt vmcnt(0)" ::: "memory");
        }
    }
    __syncthreads();
}

__device__ __forceinline__ void xcc_local_barrier(const XcdBarrier& b) {
    asm volatile("s_waitcnt vmcnt(0)" ::: "memory");
    __syncthreads();
    if (threadIdx.x == 0) {
        unsigned* bar = b.bar; const unsigned nloc = b.st[0];
        const unsigned old = xb_add(&bar[XB_XSUB(b.x)], 1u), gen = old / nloc;
        if (old + 1u == (gen + 1u) * nloc) xb_add(&bar[XB_XGEN(b.x)], 1u); else XB_SPIN(xb_ld(&bar[XB_XGEN(b.x)]) == gen, bar);
        __builtin_amdgcn_fence(__ATOMIC_ACQUIRE, "agent");
        asm volatile("s_waitcnt vmcnt(0)" ::: "memory");
    }
    __syncthreads();
}
constexpr int NWAVES = 8, LDS_BYTES = 147456;
__device__ __forceinline__ void fk_aug(const Ctx& C, int b, int h, int p, float cum) {
    C.CUM[arow(b, h, p)] = cum;
    const float cc = -cum * LOG2E; const unsigned hi = f2bf(cc); const float r1 = cc - __uint_as_float(hi << 16); const unsigned mid = f2bf(r1); const float r2 = r1 - __uint_as_float(mid << 16); const unsigned lo = f2bf(r2);
    *(u32x4*)(C.FK + kaddr(b, h, p, 64, DFK)) = (u32x4){hi | (mid << 16), lo, 0u, 0u}; *(u32x4*)(C.FK + kaddr(b, h, p, 72, DFK)) = (u32x4){0u, 0u, 0u, 0u};
}
__device__ __forceinline__ void scan_block(const Ctx& C, int bh, float* lds_f, int tid) {
    const int b = bh >> 3, h = bh & 7, lane = tid & 63, w = tid >> 6; constexpr int PER = 16;
    float v[PER]; const int e0 = tid * PER;
    float* const cl = lds_f + 1024;
#pragma unroll
    for (int k = 0; k < PER; ++k) cl[tid + 512 * k] = C.main.LOGF[(size_t)(b * T + tid + 512 * k) * 8 + h];
    __syncthreads();
#pragma unroll
    for (int j = 0; j < PER / 4; ++j) { const f32x4 q = *(const f32x4*)(cl + e0 + 4 * j); v[4 * j] = q[0]; v[4 * j + 1] = q[1]; v[4 * j + 2] = q[2]; v[4 * j + 3] = q[3]; }
#pragma unroll
    for (int i = 1; i < PER; ++i) v[i] += v[i - 1];
    float s = v[PER - 1];
#pragma unroll
    for (int o = 1; o < 64; o <<= 1) { const float n = __shfl_up(s, o); if (lane >= o) s += n; }
    if (lane == 63) lds_f[w] = s;
    __syncthreads();
    float off = s - v[PER - 1];
#pragma unroll
    for (int j = 0; j < 8; ++j) if (j < w) off += lds_f[j];
#pragma unroll
    for (int j = 0; j < PER / 4; ++j) *(f32x4*)(cl + e0 + 4 * j) = (f32x4){off + v[4 * j], off + v[4 * j + 1], off + v[4 * j + 2], off + v[4 * j + 3]};
    __syncthreads();
#pragma unroll
    for (int k = 0; k < PER; ++k) fk_aug(C, b, h, 64 + tid + 512 * k, cl[tid + 512 * k]);
    if (tid < 16) { float c = 0.f; for (int r = tid + 1; r < 16; ++r) c += C.mt.LOGF[r * 8 + h]; fk_aug(C, b, h, 48 + tid, -c); }
    if (tid >= 256) { const int r = (tid >> 3) & 15, ch = tid & 7;
        if (tid < 384) *(u32x4*)(C.FK + kaddr(b, h, 48 + r, 8 * ch, DFK)) = *(const u32x4*)(C.MFK + (r * 8 + h) * 64 + 8 * ch);
        else *(u32x4*)(C.FV + vaddr(b, h, 48 + r, 8 * ch)) = *(const u32x4*)(C.MFV + (r * 8 + h) * 64 + 8 * ch); }
    if (tid < 48) { const int p = tid; C.CUM[arow(b, h, p)] = 0.f;
        const u32x4 z = {0u, 0u, 0u, 0u};
        for (int j = 0; j < DFK / 8; ++j) *(u32x4*)(C.FK + kaddr(b, h, p, 8 * j, DFK)) = z;
        for (int j = 0; j < DQM / 8; ++j) *(u32x4*)(C.KM + kaddr(b, h, p, 8 * j, DQM)) = z;
        for (int j = 0; j < 8; ++j) { *(u32x4*)(C.FV + vaddr(b, h, p, 8 * j)) = z; *(u32x4*)(C.VM + vaddr(b, h, p, 8 * j)) = z; } }
    __syncthreads();
    { const float prune = -(2.0f * fox_bound(C) + 40.0f);
      for (int qb = w; qb < 32; qb += 8) {
          const int cand = 2 * lane; bool ok = cand <= 4 * qb;
          if (ok && cand > 0) ok = (cl[256 * qb] - cl[64 * cand - 65]) * LOG2E < prune;
          const unsigned long long m = __ballot(ok); if (lane == 0) C.FOXTB[bh * 32 + qb] = 2 * (63 - __builtin_clzll(m)); } }
    __syncthreads();
}
#define GEMM_PHASE(g, E) GEMM_PHASE_ID(g, E, (int)blockIdx.x)
#define GEMM_PHASE_ID(g, E, id) do { int t_ = threadIdx.x; asm volatile("" : "+v"(t_)); pg8::StaticOrder S_; S_.init((g).M, (g).N, G, (id)); \
    pg8::gemm_phase<std::remove_cv_t<std::remove_reference_t<decltype(E)>>, pg8::StaticOrder, true, true>(ldsp, g, S_, E, t_); } while (0)
__global__ void __launch_bounds__(NWAVES * 64, 2) mega_fwd(KArgs a) {
    extern __shared__ __attribute__((aligned(16))) unsigned char lds[];
    const Ctx C = make_ctx(a);
    PG8_LAS unsigned char* ldsp = (PG8_LAS unsigned char*)lds;
    const int tid = threadIdx.x, lane = tid & 63, wave = __builtin_amdgcn_readfirstlane(tid >> 6);
    const int G = gridDim.x, gw = blockIdx.x * NWAVES + wave, NGW = G * NWAVES;
    for (int u = tid; u < (LDS_BYTES - LDSCTL_OFF) / 4; u += NWAVES * 64) ((LAS unsigned*)((LAS unsigned char*)lds + LDSCTL_OFF))[u] = 0u;
    __syncthreads();
    PG8_LAS float* const gtab = (PG8_LAS float*)(ldsp + LDSCTL_OFF + 8192);
    if (tid < 320) gtab[tid] = tid < 64 ? C.g_q_fox[tid] : tid < 128 ? C.g_k_fox[tid - 64] : tid < 224 ? C.g_q_mla[tid - 128] : C.g_k_mla[tid - 224];
    __syncthreads();
    unsigned* const ctl = (unsigned*)(a.ws + WS_CTL);
    const XcdBarrier bar = xcd_barrier_post(ctl + CW_BAR, (volatile LAS unsigned*)((LAS unsigned char*)lds + MISC_OFF) + 8);
    p0_prologue(C, (float*)lds + wave * TSCR, gw, wave * G + (int)blockIdx.x, NGW, lane);
    xcd_barrier(bar);
    volatile LAS unsigned* const bst = (volatile LAS unsigned*)((LAS unsigned char*)lds + MISC_OFF) + 8;
    const bool byxcc = bst[3] != 0u && G == 256; const int pid = byxcc ? (int)(bst[2] * 8u + bar.x) : (int)blockIdx.x;
    { const int s_ = pid - G / 2, NS = G - G / 2; unsigned* const side = ctl + CW_SIDE;
      const bool dn = s_ >= NS - 16, wn = s_ >= 48 && s_ < 66;
      if (s_ >= 0) {
          if (!dn && !wn)
              for (int t = s_ < 48 ? s_ : s_ - 18; t < FF / 16; t += NS - 34) { task_gateup(C.mt.XN1, C.W1GU, nullptr, C.mt.HB, t, lane, wave, (float*)lds); __syncthreads(); }
          if (wave == 0) { asm volatile("s_waitcnt vmcnt(0)" ::: "memory"); if (tid == 0) xb_add(side, 1u); } }
      const pg8::Gemm g{C.main.XN1, C.W1GU, M, 2 * FF, D, D}; const pg8::EpiSwiglu E{C.main.HB, nullptr};
      const int cut = dn ? 1 : wn ? 2 : 1 << 20; int nseg = 2; asm volatile("" : "+s"(nseg));
      for (int seg = 0; seg < nseg; ++seg) {
          { int t_ = threadIdx.x; asm volatile("" : "+v"(t_)); pg8::StaticOrder S_; S_.init(g.M, g.N, G, pid); S_.off = seg ? cut : 0; S_.cnt = seg ? 1 << 20 : cut;
            pg8::gemm_phase<pg8::EpiSwiglu, pg8::StaticOrder, true, true>(ldsp, g, S_, E, t_); }
          if (seg == 0 && dn) { side_wait(side, NS, ctl + CW_BAR);
              task_down(C.mt.HB, FF, C.W1D, C.mt.base1, C.mt.H, 0.5f, C.mt.XN, C.mt.SSQ1, s_ - (NS - 16), lane, wave, (float*)lds);
              if (wave == 0) { asm volatile("s_waitcnt vmcnt(0)" ::: "memory"); if (tid == 0) xb_add(side + 64, 1u); }
              __syncthreads(); }
          if (seg == 0 && wn) { side_wait(side + 64, 16, ctl + CW_BAR); task_win(C, C.mt, 0, s_ - 48, lane, wave, (float*)lds); __syncthreads(); } }
      if (s_ >= 0 && !dn && !wn) p0_late<0>(C, (float*)lds + wave * TSCR, (s_ < 48 ? s_ : s_ - 18) * NWAVES + wave, (NS - 34) * NWAVES, lane); }
    if (byxcc) xcc_local_barrier(bar); else xcd_barrier(bar);
    { const pg8::Gemm g{C.main.HB, C.W1D, M, D, FF, FF}; const pg8::EpiResid<1, 0> E{C.main.base1, nullptr, C.main.XN, C.main.SSQ1}; GEMM_PHASE_ID(g, E, pid); }
    if (byxcc) xcc_local_barrier(bar); else xcd_barrier(bar);
    { const pg8::Gemm g{C.main.XN, C.WIN, M, 2048, D, D}; PG8_LAS float* rst = (PG8_LAS float*)(ldsp + LDSCTL_OFF + 1024);
      { pg8::StaticOrder S_; S_.init(g.M, g.N, G, pid); pg8::rs_table_fill(C.main.SSQ1, S_, rst, tid); }
      const pg8::EpiWin E{C, rst, gtab}; GEMM_PHASE_ID(g, E, pid); }
    xcd_barrier(bar);
    { int k_ = 128; asm volatile("" : "+s"(k_)); const pg8::Gemm g{C.main.CKV, C.WUKV, M, 1024, k_, k_};
      if (G >= 256) { const pg8::EpiUkvF E{gtab + 224, C.main.SSQCKV, C.main.SSQKPE, C.main.KPE, C.KM, C.VM, C.ROPE}; GEMM_PHASE(g, E); }
      else { const pg8::EpiUkv E{gtab + 224, C.main.SSQCKV, C.main.SSQKPE, C.main.KPE, C.KM, C.VM, C.ROPE}; GEMM_PHASE(g, E); } }
    { const int sb = (int)blockIdx.x - (G - 24);
      if (sb >= 0 && sb < 16) scan_block(C, sb, (float*)lds, tid);
      if (sb >= 16) { task_uqkv(C, C.mt, 8 + (sb - 16), lane, wave, (float*)lds); __syncthreads(); } }
    { int k_ = 256; asm volatile("" : "+s"(k_)); const pg8::Gemm g{C.main.CQ, C.WUQ, M, 768, k_, k_};
      if (G >= 192) { const pg8::EpiUqF E{gtab + 128, C.main.SSQCQ, C.main.SSQQ, C.QM, C.ROPE}; GEMM_PHASE(g, E); }
      else { const pg8::EpiUq E{gtab + 128, C.main.SSQCQ, C.main.SSQQ, C.QM, C.ROPE}; GEMM_PHASE(g, E); } }
    xcd_barrier(bar);
    { static_assert(MISC_OFF + 64 <= LDS_BYTES && att::LDS_BYTES <= LDSCTL_OFF, "attention LDS");
      attn_phase(C, (char*)lds, ctl, bar.x, (volatile LAS unsigned*)((LAS unsigned char*)lds + MISC_OFF) + 12); }
    xcd_barrier(bar);
    { const pg8::Gemm g{C.O, C.WOUT, M, D, D, D}; const pg8::EpiResid<0, 1> E{C.main.XN, nullptr, C.main.XN, C.SSQ2}; GEMM_PHASE_ID(g, E, pid); }
    if (byxcc) xcc_local_barrier(bar); else xcd_barrier(bar);
    { const pg8::Gemm g{C.main.XN, C.W2GU, M, 2 * FF, D, D}; PG8_LAS float* rst = (PG8_LAS float*)(ldsp + LDSCTL_OFF + 1024);
      { pg8::StaticOrder S_; S_.init(g.M, g.N, G, pid); pg8::rs_table_fill(C.SSQ2, S_, rst, tid); }
      const pg8::EpiSwiglu E{C.main.HB, rst}; GEMM_PHASE_ID(g, E, pid); }
    if (byxcc) xcc_local_barrier(bar); else xcd_barrier(bar);
    { const pg8::Gemm g{C.main.HB, C.W2D, M, D, FF, FF}; const pg8::EpiResid<1, 1> E{C.main.XN, C.out, nullptr, nullptr}; GEMM_PHASE_ID(g, E, pid); }
}

extern "C" void kernel_launch(void* const* d_in, const int* in_sizes, int n_in, void* d_out, int out_size, void* d_ws, size_t ws_size, hipStream_t stream) {
    static int grid = 0;
    if (grid == 0) {
        if (n_in != 22 || in_sizes[0] != M * D || out_size != M * D || ws_size < WS_END) { fprintf(stderr, "kernel_launch: unexpected shapes (n_in %d, in0 %d, out %d, ws %zu)\n", n_in, n_in > 0 ? in_sizes[0] : -1, out_size, ws_size); grid = -1; return; }
        int dev = 0, cus = 0, per_cu = 0;
        if (hipGetDevice(&dev) != hipSuccess || hipDeviceGetAttribute(&cus, hipDeviceAttributeMultiprocessorCount, dev) != hipSuccess) { grid = -1; return; }
        if (hipFuncSetAttribute((const void*)mega_fwd, hipFuncAttributeMaxDynamicSharedMemorySize, LDS_BYTES) != hipSuccess) { fprintf(stderr, "kernel_launch: hipFuncSetAttribute failed\n"); grid = -1; return; }
        if (hipOccupancyMaxActiveBlocksPerMultiprocessor(&per_cu, (const void*)mega_fwd, NWAVES * 64, LDS_BYTES) != hipSuccess || per_cu < 1) { fprintf(stderr, "kernel_launch: occupancy query reports %d blocks per CU\n", per_cu); grid = -1; return; }
        grid = cus;
    }
    if (grid < 0) return;
    if (hipMemsetAsync((char*)d_ws + WS_CTL, 0, CTL_ZERO_BYTES, stream) != hipSuccess) { fprintf(stderr, "kernel_launch: hipMemsetAsync of the control words failed\n"); return; }
    KArgs a{}; for (int i = 0; i < 22; ++i) a.in[i] = (const float*)d_in[i]; a.out = (float*)d_out; a.ws = (unsigned char*)d_ws;
    void* args[] = {&a};
    const hipError_t e = hipLaunchCooperativeKernel((const void*)mega_fwd, dim3(grid), dim3(NWAVES * 64), args, LDS_BYTES, stream);
    if (e != hipSuccess) fprintf(stderr, "kernel_launch: cooperative launch failed: %s (grid %d)\n", hipGetErrorString(e), grid);
}
```
